# Optimizing an MI355X kernel written in HIP

```python
import jax, jax.numpy as jnp
from jax import lax
import numpy as np

D_MODEL = 2048
BATCH = 2
SEQ = 4096
DEPTH = 2

GRID_W = 64
CTX_LEN = 256
HEAD_DIM = 128
SWA_HEADS = 4
SWA_KV_HEADS = 2
SWA_WINDOW = 128
SWA_BLOCK = 128
RET_HEADS = 4
RET_DK = 128
RET_DV = 128
RET_CHUNK = 128
MLA_HEADS = 4
MLA_Q_RANK = 384
MLA_KV_RANK = 128
MLA_NOPE = 128
MLA_ROPE = 64
MLA_V = 128
MLA_QBLOCK = 128
HGRN_HEADS = 4
HGRN_DK = 128
HGRN_DV = 128
HGRN_CHUNK = 16
MIX_WIDTH = SWA_HEADS * HEAD_DIM + RET_HEADS * RET_DV + MLA_HEADS * MLA_V + HGRN_HEADS * HGRN_DV
IN_WIDTHS = (SWA_HEADS * HEAD_DIM, SWA_KV_HEADS * HEAD_DIM, SWA_KV_HEADS * HEAD_DIM,
             RET_HEADS * RET_DK, RET_HEADS * RET_DK, RET_HEADS * RET_DV, RET_HEADS * RET_DV,
             MLA_Q_RANK, MLA_KV_RANK, MLA_ROPE,
             HGRN_HEADS * HGRN_DK, HGRN_HEADS * HGRN_DK, HGRN_HEADS * HGRN_DK, HGRN_HEADS * HGRN_DV, HGRN_HEADS * HGRN_DV)
IN_COLS = sum(IN_WIDTHS)
N_GROUPS = 4
EXPERTS_PER_GROUP = 8
N_EXPERTS = N_GROUPS * EXPERTS_PER_GROUP
TOP_K = 2
EXPERT_FF = 512
MOE_BLOCK = 128
ROPE_BASE = 10000.0
EPS = 1e-6
DEEPNORM_ALPHA = (2 * DEPTH) ** 0.25
DEEPNORM_BETA = (8 * DEPTH) ** -0.25

kernel_name = "hybrid_parallel_heads_dit_moe"

F32 = jnp.float32


def _layer_norm(x, g=None, b=None):
    xf = x.astype(F32)
    xc = xf - jnp.mean(xf, -1, keepdims=True)
    y = xc * lax.rsqrt(jnp.mean(xc * xc, -1, keepdims=True) + EPS)
    if g is not None:
        y = y * g.astype(F32) + b.astype(F32)
    return y.astype(x.dtype)


def _rms_norm(x, g):
    xf = x.astype(F32)
    y = xf * lax.rsqrt(jnp.mean(xf * xf, -1, keepdims=True) + EPS)
    return (y * g.astype(F32)).astype(x.dtype)


def _modulate(x, shift, scale):
    return _layer_norm(x) * (1.0 + scale) + shift


def _heads(a, h):
    return a.reshape(a.shape[:-1] + (h, a.shape[-1] // h))


def _bhtd(a, h):
    return jnp.swapaxes(_heads(a, h), 1, 2)


def _axial_angles(row, col, rot_dim):
    n_freq = rot_dim // 4
    inv = ROPE_BASE ** (-jnp.arange(n_freq, dtype=F32) / n_freq)
    return jnp.concatenate([row.astype(F32)[:, None] * inv, col.astype(F32)[:, None] * inv], -1)


def _rope(x, ang):
    half = x.shape[-1] // 2
    x1, x2 = x[..., :half], x[..., half:]
    cos, sin = jnp.cos(ang).astype(x.dtype), jnp.sin(ang).astype(x.dtype)
    return jnp.concatenate([x1 * cos - x2 * sin, x2 * cos + x1 * sin], -1)


def _swa(q, k, v, qc, kc, vc, sink, need_ctx):
    B, T, _, dh = q.shape
    L = kc.shape[1]
    nb = T // SWA_BLOCK
    g = SWA_HEADS // SWA_KV_HEADS
    scale = dh ** -0.5
    qb = q.reshape(B, nb, SWA_BLOCK, SWA_KV_HEADS, g, dh)
    pad = ((0, 0), (SWA_BLOCK, SWA_BLOCK), (0, 0), (0, 0))
    kb = jnp.pad(k, pad).reshape(B, nb + 2, SWA_BLOCK, SWA_KV_HEADS, dh)
    vb = jnp.pad(v, pad).reshape(B, nb + 2, SWA_BLOCK, SWA_KV_HEADS, dh)
    band = lambda a: jnp.concatenate([a[:, :-2], a[:, 1:-1], a[:, 2:]], axis=2)
    kband, vband = band(kb), band(vb)
    s_loc = jnp.einsum('bnqhgd,bnkhd->bnhgqk', qb, kband).astype(F32) * scale
    qi = jnp.arange(SWA_BLOCK)[:, None]
    ki = jnp.arange(3 * SWA_BLOCK)[None, :] - SWA_BLOCK
    kabs = jnp.arange(nb)[:, None, None] * SWA_BLOCK + ki[None]
    mask = (jnp.abs(ki - qi) <= SWA_WINDOW)[None] & (kabs >= 0) & (kabs < T)
    s_loc = jnp.where(mask[None, :, None, None], s_loc, -jnp.inf)
    s_ctx = jnp.einsum('bnqhgd,blhd->bnhgql', qb, kc).astype(F32) * scale
    sink_f = sink.astype(F32).reshape(1, 1, SWA_KV_HEADS, g, 1, 1)
    s_sink = jnp.broadcast_to(sink_f, s_loc.shape[:-1] + (1,))
    p = jax.nn.softmax(jnp.concatenate([s_loc, s_ctx, s_sink], -1), axis=-1)
    nk = 3 * SWA_BLOCK
    o = (jnp.einsum('bnhgqk,bnkhd->bnqhgd', p[..., :nk].astype(v.dtype), vband)
         + jnp.einsum('bnhgql,blhd->bnqhgd', p[..., nk:nk + L].astype(v.dtype), vc))
    o_lat = o.reshape(B, T, SWA_HEADS * dh)
    o_ctx = None
    if need_ctx:
        qcg = qc.reshape(B, L, SWA_KV_HEADS, g, dh)
        sc = jnp.einsum('blhgd,bmhd->bhglm', qcg, kc).astype(F32) * scale
        sc_sink = jnp.broadcast_to(sink.astype(F32).reshape(1, SWA_KV_HEADS, g, 1, 1), sc.shape[:-1] + (1,))
        pc = jax.nn.softmax(jnp.concatenate([sc, sc_sink], -1), axis=-1)
        o_ctx = jnp.einsum('bhglm,bmhd->blhgd', pc[..., :L].astype(vc.dtype), vc).reshape(B, L, SWA_HEADS * dh)
    return o_lat, o_ctx


def _chunk_scan(q, k, v, g, s0, chunk, per_dim):
    dt = v.dtype
    q, k, v, g, s0 = (a.astype(F32) for a in (q, k, v, g, s0))
    B, H, T, _ = q.shape
    nc = T // chunk
    rs = lambda a: a.reshape(B, H, nc, chunk, a.shape[-1])
    q, k, v, g = rs(q), rs(k), rs(v), rs(g)
    b = jnp.cumsum(g, axis=3)
    b_last = b[:, :, :, -1:, :]
    causal = jnp.tril(jnp.ones((chunk, chunk), bool))
    if per_dim:
        diff = b[:, :, :, :, None, :] - b[:, :, :, None, :, :]
        dec = jnp.exp(jnp.where(causal[:, :, None], diff, -jnp.inf))
        scores = jnp.einsum('bhcnmd,bhcmd->bhcnm', q[:, :, :, :, None, :] * dec, k)
    else:
        bs = b[..., 0]
        diff = bs[..., :, None] - bs[..., None, :]
        dec = jnp.exp(jnp.where(causal, diff, -jnp.inf))
        scores = jnp.einsum('bhcnd,bhcmd->bhcnm', q, k) * dec
    o_intra = jnp.einsum('bhcnm,bhcmv->bhcnv', scores, v)
    q_in = q * jnp.exp(b)
    k_st = k * jnp.exp(b_last - b)
    a_last = jnp.exp(b_last[:, :, :, 0, :])

    def step(S, xs):
        qi, ki, vi, ai = xs
        o = jnp.einsum('bhnd,bhdv->bhnv', qi, S)
        S = ai[..., :, None] * S + jnp.einsum('bhmd,bhmv->bhdv', ki, vi)
        return S, o

    xs = tuple(jnp.moveaxis(a, 2, 0) for a in (q_in, k_st, v, a_last))
    s_T, o_inter = lax.scan(step, s0, xs)
    o = o_intra + jnp.moveaxis(o_inter, 0, 2)
    return o.reshape(B, H, T, -1).astype(dt), s_T


def _bidir_scan(q, v, k_dirs, g_dirs, qc, vc, kc_dirs, gc_dirs, chunk, per_dim):
    B, H, _, dk = q.shape
    s0 = jnp.zeros((B, H, dk, v.shape[-1]), F32)
    ident = lambda a: a
    flip = lambda a: jnp.flip(a, axis=2)
    o_lat, o_ctx = [], []
    for d, tf in enumerate((ident, flip)):
        oc, sc = _chunk_scan(tf(qc), tf(kc_dirs[d]), tf(vc), tf(gc_dirs[d]), s0, chunk, per_dim)
        o, _ = _chunk_scan(tf(q), tf(k_dirs[d]), tf(v), tf(g_dirs[d]), sc, chunk, per_dim)
        o_lat.append(tf(o))
        o_ctx.append(tf(oc))
    return o_lat[0] + o_lat[1], o_ctx[0] + o_ctx[1]


def _mla(qn, qr, kn, kr, v, qnc, qrc, knc, krc, vc, need_ctx):
    B, T, H, _ = qn.shape
    L = knc.shape[1]
    nb = T // MLA_QBLOCK
    scale = (MLA_NOPE + MLA_ROPE) ** -0.5
    k_n = jnp.concatenate([knc, kn], 1)
    k_r = jnp.concatenate([krc, kr], 1)
    v_all = jnp.concatenate([vc, v], 1)

    def block(args):
        qbn, qbr = args
        s = (jnp.einsum('bqhd,bkhd->bhqk', qbn, k_n) + jnp.einsum('bqhr,bkr->bhqk', qbr, k_r)).astype(F32) * scale
        p = jax.nn.softmax(s, axis=-1).astype(v_all.dtype)
        return jnp.einsum('bhqk,bkhd->bqhd', p, v_all)

    to_blocks = lambda a: jnp.moveaxis(a.reshape((B, nb, MLA_QBLOCK) + a.shape[2:]), 1, 0)
    o = lax.map(block, (to_blocks(qn), to_blocks(qr)))
    o_lat = jnp.moveaxis(o, 0, 1).reshape(B, T, H * MLA_V)
    o_ctx = None
    if need_ctx:
        s = (jnp.einsum('blhd,bmhd->bhlm', qnc, knc) + jnp.einsum('blhr,bmr->bhlm', qrc, krc)).astype(F32) * scale
        pc = jax.nn.softmax(s, axis=-1).astype(vc.dtype)
        o_ctx = jnp.einsum('bhlm,bmhd->blhd', pc, vc).reshape(B, L, H * MLA_V)
    return o_lat, o_ctx


def _ret_out(o, gate, gn):
    y = _layer_norm(jnp.swapaxes(o, 1, 2))
    y = y.reshape(y.shape[:2] + (-1,)) * gn
    return jax.nn.silu(gate) * y


def _hgrn_out(o, gate, gn):
    y = _rms_norm(jnp.swapaxes(o, 1, 2), gn.reshape(HGRN_HEADS, HGRN_DV))
    return jax.nn.silu(gate) * y.reshape(y.shape[:2] + (-1,))


def _token_mixers(h_lat, h_ctx, w_in, w_out, swa_sink, ret_s, ret_gn, q_norm, kv_norm, w_uq, w_ukv,
                  lb, hgrn_gn, ang_swa, ang_mla, need_ctx):
    B, T, _ = h_lat.shape
    L = h_ctx.shape[1]
    cuts = np.cumsum(IN_WIDTHS)[:-1].tolist()
    (sq, sk, sv, rq, rk, rv, rg, cq, ckv, kr, hq, hff, hfb, hi, hg) = jnp.split(h_lat @ w_in, cuts, axis=-1)
    (sqc, skc, svc, rqc, rkc, rvc, rgc, cqc, ckvc, krc, hqc, hffc, hfbc, hic, hgc) = jnp.split(h_ctx @ w_in, cuts, axis=-1)

    a_lat, a_ctx = _swa(_rope(_heads(sq, SWA_HEADS), ang_swa[:, None]), _rope(_heads(sk, SWA_KV_HEADS), ang_swa[:, None]),
                        _heads(sv, SWA_KV_HEADS), _heads(sqc, SWA_HEADS), _heads(skc, SWA_KV_HEADS),
                        _heads(svc, SWA_KV_HEADS), swa_sink, need_ctx)

    log_gamma = jnp.log1p(-jnp.exp2(-ret_s.astype(F32)))
    ret_g = lambda n: [jnp.broadcast_to(log_gamma[d][None, :, None, None], (B, RET_HEADS, n, 1)) for d in range(2)]
    ksc = RET_DK ** -0.5
    k_r, kc_r = _bhtd(rk, RET_HEADS) * ksc, _bhtd(rkc, RET_HEADS) * ksc
    b_lat, b_ctx = _bidir_scan(_bhtd(rq, RET_HEADS), _bhtd(rv, RET_HEADS), [k_r, k_r], ret_g(T),
                               _bhtd(rqc, RET_HEADS), _bhtd(rvc, RET_HEADS), [kc_r, kc_r], ret_g(L), RET_CHUNK, False)

    def mla_proj(cq_, ckv_):
        qq = _heads(_rms_norm(cq_, q_norm) @ w_uq, MLA_HEADS)
        kv = _heads(_rms_norm(ckv_, kv_norm) @ w_ukv, MLA_HEADS)
        return qq[..., :MLA_NOPE], qq[..., MLA_NOPE:], kv[..., :MLA_NOPE], kv[..., MLA_NOPE:]
    qn, qr, kn, vv = mla_proj(cq, ckv)
    qnc, qrc, knc, vvc = mla_proj(cqc, ckvc)
    c_lat, c_ctx = _mla(qn, _rope(qr, ang_mla[:, None]), kn, _rope(kr, ang_mla), vv,
                        qnc, qrc, knc, krc, vvc, need_ctx)

    def hgrn_dirs(zf, zb):
        ks_, gs_ = [], []
        for d, z in enumerate((zf, zb)):
            lbd = lb[d].reshape(HGRN_HEADS, 1, HGRN_DK)
            f = lbd + (1.0 - lbd) * jax.nn.sigmoid(_bhtd(z, HGRN_HEADS).astype(F32))
            ks_.append(1.0 - f)
            gs_.append(jnp.log(f))
        return ks_, gs_
    hk, hgd = hgrn_dirs(hff, hfb)
    hkc, hgdc = hgrn_dirs(hffc, hfbc)
    d_lat, d_ctx = _bidir_scan(jax.nn.silu(_bhtd(hq, HGRN_HEADS)), _bhtd(hi, HGRN_HEADS), hk, hgd,
                               jax.nn.silu(_bhtd(hqc, HGRN_HEADS)), _bhtd(hic, HGRN_HEADS), hkc, hgdc, HGRN_CHUNK, True)

    o_lat = jnp.concatenate([a_lat, _ret_out(b_lat, rg, ret_gn), c_lat, _hgrn_out(d_lat, hg, hgrn_gn)], -1) @ w_out
    o_ctx = None
    if need_ctx:
        o_ctx = jnp.concatenate([a_ctx, _ret_out(b_ctx, rgc, ret_gn), c_ctx, _hgrn_out(d_ctx, hgc, hgrn_gn)], -1) @ w_out
    return o_lat, o_ctx


def _hier_moe(h, w_rg, w_re, w1, w3, w2):
    n, d = h.shape
    pg = jax.nn.softmax((h @ w_rg).astype(F32), axis=-1)
    grp = jnp.argmax(pg, axis=-1)
    p_grp = jnp.take_along_axis(pg, grp[:, None], axis=-1)
    le = (h @ w_re).astype(F32).reshape(n, N_GROUPS, EXPERTS_PER_GROUP)
    le = jnp.take_along_axis(le, grp[:, None, None], axis=1)[:, 0]
    top_p, top_i = lax.top_k(jax.nn.softmax(le, axis=-1), TOP_K)
    gate = p_grp * top_p / jnp.sum(top_p, -1, keepdims=True)
    eid = (grp[:, None] * EXPERTS_PER_GROUP + top_i).reshape(-1).astype(jnp.int32)
    tok = jnp.repeat(jnp.arange(n, dtype=jnp.int32), TOP_K)
    wgt = gate.reshape(-1)
    order = jnp.argsort(eid)
    eid, tok, wgt = eid[order], tok[order], wgt[order]
    counts = jnp.zeros((N_EXPERTS,), jnp.int32).at[eid].add(1)
    padded = (counts + MOE_BLOCK - 1) // MOE_BLOCK * MOE_BLOCK
    start = jnp.cumsum(counts) - counts
    pend = jnp.cumsum(padded)
    pstart = pend - padded
    dest = pstart[eid] + jnp.arange(eid.shape[0], dtype=jnp.int32) - start[eid]
    n_blocks = (n * TOP_K + N_EXPERTS * (MOE_BLOCK - 1) + MOE_BLOCK - 1) // MOE_BLOCK
    xbuf = jnp.zeros((n_blocks * MOE_BLOCK, d), h.dtype).at[dest].set(h[tok])
    blk_e = jnp.minimum(jnp.searchsorted(pend, jnp.arange(n_blocks, dtype=jnp.int32) * MOE_BLOCK, side='right'),
                        N_EXPERTS - 1)

    def expert_block(args):
        xb, e = args
        return (jax.nn.silu(xb @ w1[e]) * (xb @ w3[e])) @ w2[e]

    ybuf = lax.map(expert_block, (xbuf.reshape(n_blocks, MOE_BLOCK, d), blk_e)).reshape(-1, d)
    y = jax.ops.segment_sum(ybuf[dest].astype(F32) * wgt[:, None], tok, num_segments=n)
    return y.astype(h.dtype)


def setup_inputs(seed: int = 0) -> dict:
    key = jax.random.key(seed)
    ks = jax.random.split(key, 28)
    nrm = lambda k, shape, s: jax.random.normal(k, shape, F32) * s
    D = D_MODEL
    return {
        "x": nrm(ks[0], (BATCH, SEQ, D), 1.0),
        "c": nrm(ks[1], (BATCH, D), 1.0),
        "ctx": nrm(ks[2], (BATCH, CTX_LEN, D), 1.0),
        "c_ctx": nrm(ks[3], (D,), 1.0),
        "w_ada": nrm(ks[4], (DEPTH, D, 6 * D), 0.5 * D ** -0.5),
        "b_ada": nrm(ks[5], (DEPTH, 6 * D), 0.02),
        "w_in": nrm(ks[6], (DEPTH, D, IN_COLS), D ** -0.5),
        "swa_sink": nrm(ks[7], (DEPTH, SWA_HEADS), 1.0),
        "ret_decay_exp": 5.0 + jnp.arange(RET_HEADS, dtype=F32) + nrm(ks[8], (DEPTH, 2, RET_HEADS), 0.2),
        "ret_gn": 1.0 + nrm(ks[9], (DEPTH, RET_HEADS * RET_DV), 0.1),
        "mla_q_norm": 1.0 + nrm(ks[10], (DEPTH, MLA_Q_RANK), 0.1),
        "mla_kv_norm": 1.0 + nrm(ks[11], (DEPTH, MLA_KV_RANK), 0.1),
        "mla_w_uq": nrm(ks[12], (DEPTH, MLA_Q_RANK, MLA_HEADS * (MLA_NOPE + MLA_ROPE)), MLA_Q_RANK ** -0.5),
        "mla_w_ukv": nrm(ks[13], (DEPTH, MLA_KV_RANK, MLA_HEADS * (MLA_NOPE + MLA_V)), MLA_KV_RANK ** -0.5),
        "hgrn_lb_logits": nrm(ks[14], (DEPTH, 2, HGRN_HEADS * HGRN_DK), 0.5),
        "hgrn_gn": 1.0 + nrm(ks[15], (DEPTH, HGRN_HEADS * HGRN_DV), 0.1),
        "w_out": nrm(ks[16], (DEPTH, MIX_WIDTH, D), DEEPNORM_BETA * MIX_WIDTH ** -0.5),
        "ln1_g": 1.0 + nrm(ks[17], (DEPTH, D), 0.1),
        "ln1_b": nrm(ks[18], (DEPTH, D), 0.02),
        "router_group": nrm(ks[19], (DEPTH, D, N_GROUPS), D ** -0.5),
        "router_expert": nrm(ks[20], (DEPTH, D, N_EXPERTS), D ** -0.5),
        "moe_w1": nrm(ks[21], (DEPTH, N_EXPERTS, D, EXPERT_FF), D ** -0.5),
        "moe_w3": nrm(ks[22], (DEPTH, N_EXPERTS, D, EXPERT_FF), D ** -0.5),
        "moe_w2": nrm(ks[23], (DEPTH, N_EXPERTS, EXPERT_FF, D), DEEPNORM_BETA * EXPERT_FF ** -0.5),
        "ln2_g": 1.0 + nrm(ks[24], (DEPTH, D), 0.1),
        "ln2_b": nrm(ks[25], (DEPTH, D), 0.02),
    }


def reference(x, c, ctx, c_ctx, w_ada, b_ada, w_in, swa_sink, ret_decay_exp, ret_gn, mla_q_norm, mla_kv_norm,
              mla_w_uq, mla_w_ukv, hgrn_lb_logits, hgrn_gn, w_out, ln1_g, ln1_b, router_group, router_expert,
              moe_w1, moe_w3, moe_w2, ln2_g, ln2_b):
    B, T, D = x.shape
    L = ctx.shape[1]
    rows = T // GRID_W
    row = jnp.repeat(jnp.arange(rows, dtype=jnp.int32), GRID_W)
    col = jnp.tile(jnp.arange(GRID_W, dtype=jnp.int32), rows)
    ang_swa = _axial_angles(row, col, HEAD_DIM)
    ang_mla = _axial_angles(row, col, MLA_ROPE)
    lbp = jax.nn.softmax(hgrn_lb_logits.astype(F32), axis=0)
    lower_bounds = jnp.cumsum(lbp, axis=0) - lbp[0]

    for l in range(DEPTH):
        need_ctx = l < DEPTH - 1
        ml = (jax.nn.silu(c) @ w_ada[l] + b_ada[l])[:, None, :]
        mc = jax.nn.silu(c_ctx) @ w_ada[l] + b_ada[l]
        sh1, sc1, g1, sh2, sc2, g2 = jnp.split(ml, 6, axis=-1)
        csh1, csc1, cg1, csh2, csc2, cg2 = jnp.split(mc, 6, axis=-1)

        o_lat, o_ctx = _token_mixers(_modulate(x, sh1, sc1), _modulate(ctx, csh1, csc1), w_in[l], w_out[l],
                                     swa_sink[l], ret_decay_exp[l], ret_gn[l], mla_q_norm[l], mla_kv_norm[l],
                                     mla_w_uq[l], mla_w_ukv[l], lower_bounds[l], hgrn_gn[l], ang_swa, ang_mla, need_ctx)
        x = _layer_norm(DEEPNORM_ALPHA * x + g1 * o_lat, ln1_g[l], ln1_b[l])
        h2 = _modulate(x, sh2, sc2).reshape(B * T, D)
        if need_ctx:
            ctx = _layer_norm(DEEPNORM_ALPHA * ctx + cg1 * o_ctx, ln1_g[l], ln1_b[l])
            h2c = _modulate(ctx, csh2, csc2).reshape(B * L, D)
            y = _hier_moe(jnp.concatenate([h2, h2c], 0), router_group[l], router_expert[l],
                          moe_w1[l], moe_w3[l], moe_w2[l])
            y_lat, y_ctx = y[:B * T].reshape(B, T, D), y[B * T:].reshape(B, L, D)
            ctx = _layer_norm(DEEPNORM_ALPHA * ctx + cg2 * y_ctx, ln2_g[l], ln2_b[l])
        else:
            y_lat = _hier_moe(h2, router_group[l], router_expert[l], moe_w1[l], moe_w3[l], moe_w2[l]).reshape(B, T, D)
        x = _layer_norm(DEEPNORM_ALPHA * x + g2 * y_lat, ln2_g[l], ln2_b[l])
    return x
```

```cpp
#include <hip/hip_runtime.h>
#include <cstdio>
#include <cstdint>

#ifndef ONE_LAUNCH
#define ONE_LAUNCH 1
#endif

constexpr int D = 2048, NBATCH = 2, T = 4096, LCTX = 256, DEPTH = 2;
constexpr int NLAT = NBATCH * T, NCTX = NBATCH * LCTX, R = NLAT + NCTX;
constexpr int INC = 6208;
constexpr int SQ = 0, SK = 512, SV = 768, RQ = 1024, RK = 1536, RV = 2048, RG = 2560, CQ = 3072, CKV = 3456, KR = 3584,
              HQ = 3648, HFF = 4160, HFB = 4672, HI = 5184, HG = 5696;
constexpr int NEXP = 32, FF = 512;
constexpr int NSLOT = 21504, NTILE = NSLOT / 128;
constexpr float EPS = 1e-6f;
constexpr float ALPHA = 1.41421356237309515f;
constexpr int NTH = 512, NWV = 8;

typedef float f32x16 __attribute__((ext_vector_type(16)));

#define XB_TMO      128
#define XB_XCNT(j)  (256  + 64 * (j))
#define XB_XSUB(j)  (1280 + 64 * (j))
#define XB_XGEN(j)  (2304 + 64 * (j))
#define XB_TOP      3328
#define XB_TOPGEN   3392
#define XCD_BAR_WORDS 3456
#define XB_SPIN_CAP (1u << 18)
#define LAS __attribute__((address_space(3)))

__device__ __forceinline__ unsigned xb_ld(unsigned* p)              { return __hip_atomic_load(p, __ATOMIC_RELAXED, __HIP_MEMORY_SCOPE_AGENT); }
__device__ __forceinline__ unsigned xb_add(unsigned* p, unsigned v) { return __hip_atomic_fetch_add(p, v, __ATOMIC_RELAXED, __HIP_MEMORY_SCOPE_AGENT); }
__device__ __forceinline__ unsigned xb_xcc_id() { return (unsigned)__builtin_amdgcn_s_getreg((3 << 11) | 20) & 0xFu; }
#define XB_SPIN(cond, bar) do { unsigned _sp = 0; while (cond) { __builtin_amdgcn_s_sleep(1); \
    if ((++_sp & 255u) == 0u) { if (xb_ld(&(bar)[XB_TMO])) break; if (_sp > XB_SPIN_CAP) { atomicAdd(&(bar)[XB_TMO], 1u); break; } } } } while (0)

struct XcdBarrier { unsigned* bar; unsigned x; volatile LAS unsigned* st; };

__device__ __forceinline__ XcdBarrier xcd_barrier_post(unsigned* bar, volatile LAS unsigned* st) {
    XcdBarrier b; b.bar = bar; b.x = xb_xcc_id(); b.st = st;
    if (threadIdx.x == 0) (void)xb_add(&bar[XB_XCNT(b.x)], 1u);
    return b;
}
__device__ __forceinline__ void xcd_barrier_complete(unsigned* bar, unsigned x, unsigned& nloc, unsigned& nx) {
    const unsigned G = gridDim.x * gridDim.y * gridDim.z;
    unsigned sum, cnt, mine, sp = 0u;
    for (;;) {
        sum = 0u; cnt = 0u; mine = 0u;
#pragma unroll
        for (unsigned j = 0; j < 16; ++j) { const unsigned c = xb_ld(&bar[XB_XCNT(j)]); sum += c; cnt += (c > 0u) ? 1u : 0u; mine = (j == x) ? c : mine; }
        if (sum == G) break;
        __builtin_amdgcn_s_sleep(1);
        if ((++sp & 255u) == 0u) { if (xb_ld(&bar[XB_TMO])) break; if (sp > XB_SPIN_CAP) { atomicAdd(&bar[XB_TMO], 1u); break; } }
    }
    nloc = mine > 0u ? mine : 1u; nx = cnt > 0u ? cnt : 1u;
}
__device__ __forceinline__ void xcd_barrier(const XcdBarrier& b) {
    asm volatile("s_waitcnt vmcnt(0)" ::: "memory");
    __syncthreads();
    if (threadIdx.x == 0) {
        unsigned* bar = b.bar;
        __builtin_amdgcn_s_waitcnt(0);
        unsigned nloc = b.st[0], nx = b.st[1];
        if (nloc == 0u) { xcd_barrier_complete(bar, b.x, nloc, nx); b.st[0] = nloc; b.st[1] = nx; }
        const unsigned old = xb_add(&bar[XB_XSUB(b.x)], 1u);
        const unsigned gen = old / nloc;
        if (old + 1u == (gen + 1u) * nloc) {
            __builtin_amdgcn_fence(__ATOMIC_RELEASE, "agent");
            asm volatile("s_waitcnt vmcnt(0)" ::: "memory");
            const unsigned og = xb_add(&bar[XB_TOP], 1u);
            const unsigned tg = og / nx;
            if (og + 1u == (tg + 1u) * nx) xb_add(&bar[XB_TOPGEN], 1u);
            else XB_SPIN(xb_ld(&bar[XB_TOPGEN]) == tg, bar);
            __builtin_amdgcn_fence(__ATOMIC_ACQUIRE, "agent");
            xb_add(&bar[XB_XGEN(b.x)], 1u);
            asm volatile("s_waitcnt vmcnt(0)" ::: "memory");
        } else {
            XB_SPIN(xb_ld(&bar[XB_XGEN(b.x)]) == gen, bar);
            __builtin_amdgcn_fence(__ATOMIC_ACQUIRE, "agent");
            asm volatile("s_waitcnt vmcnt(0)" ::: "memory");
        }
    }
    __syncthreads();
}

struct Params {
    const float *x, *c, *ctx, *c_ctx, *w_ada, *b_ada, *w_in, *swa_sink, *ret_s, *ret_gn, *q_norm, *kv_norm, *w_uq, *w_ukv,
                *lb_logits, *hgrn_gn, *w_out, *ln1_g, *ln1_b, *w_rg, *w_re, *w1, *w3, *w2, *ln2_g, *ln2_b;
    float* out;
    unsigned* bar;
    float *modv, *xc, *hb, *P, *cqn, *ckvn, *Q2, *KV2, *oscan, *mix, *ob, *G1, *G3, *act, *Ys, *gate;
    int *eid, *slot_of, *slot_tok, *tile_e;
    int ph_lo, ph_hi;
};

__device__ __forceinline__ int otid() { int t = threadIdx.x; asm volatile("" : "+v"(t)); return t; }
__device__ __forceinline__ float wsum(float v) {
#pragma unroll
    for (int o = 32; o > 0; o >>= 1) v += __shfl_xor(v, o);
    return v;
}
__device__ __forceinline__ float siluf(float v) { return v / (1.0f + expf(-v)); }
__device__ __forceinline__ float sigmf(float v) { return 1.0f / (1.0f + expf(-v)); }
__device__ __forceinline__ int mod_row(int r) { return r < NLAT ? (r >= T ? 1 : 0) : 2; }
__device__ __forceinline__ float4 ld4(const float* p) { return *(const float4*)p; }
__device__ __forceinline__ void st4(float* p, float4 v) { *(float4*)p = v; }

struct GemmArgs {
    const float* A; int lda; const int* rowidx;
    const float* B; int ldb; long bstride; const int* tile_e;
    float* C; int ldc; int M, N, K;
};
__device__ __forceinline__ void gemm_f32(const GemmArgs& g, int bid, int nb, float* smem) {
    const int tid = otid(), lane = tid & 63, wid = tid >> 6, wr = wid >> 1, wc = wid & 1;
    float* As = smem;
    float* Bs = smem + 16 * 132;
    const int ntm = (g.M + 127) / 128, ntn = (g.N + 127) / 128;
    const float4 z4 = make_float4(0.f, 0.f, 0.f, 0.f);
    for (int tile = bid; tile < ntm * ntn; tile += nb) {
        const int tm = tile / ntn, tn = tile % ntn;
        const float* Bp = g.B;
        if (g.tile_e) { const int e = g.tile_e[tm]; if (e < 0) continue; Bp += (long)e * g.bstride; }
        const int arow = tid >> 2, ak = (tid & 3) * 4;
        const int grow = tm * 128 + arow;
        const float* Ap = nullptr;
        if (grow < g.M) { const int src = g.rowidx ? g.rowidx[grow] : grow; if (src >= 0) Ap = g.A + (long)src * g.lda + ak; }
        const int bk = tid >> 5, bn = (tid & 31) * 4;
        const int gcol = tn * 128 + bn;
        const bool bvalid = gcol < g.N;
        const float* Bq = Bp + (long)bk * g.ldb + gcol;
        float4 ra = Ap ? ld4(Ap) : z4, rb = bvalid ? ld4(Bq) : z4;
        f32x16 acc0, acc1;
#pragma unroll
        for (int i = 0; i < 16; ++i) { acc0[i] = 0.f; acc1[i] = 0.f; }
        for (int k0 = 0; k0 < g.K; k0 += 16) {
            __syncthreads();
            As[(ak + 0) * 132 + arow] = ra.x; As[(ak + 1) * 132 + arow] = ra.y; As[(ak + 2) * 132 + arow] = ra.z; As[(ak + 3) * 132 + arow] = ra.w;
            st4(&Bs[bk * 132 + bn], rb);
            __syncthreads();
            if (k0 + 16 < g.K) {
                ra = Ap ? ld4(Ap + k0 + 16) : z4;
                rb = bvalid ? ld4(Bq + (long)(k0 + 16) * g.ldb) : z4;
            }
#pragma unroll
            for (int kk = 0; kk < 16; kk += 2) {
                const int kr = kk + (lane >> 5);
                const float a = As[kr * 132 + wr * 32 + (lane & 31)];
                const float b0 = Bs[kr * 132 + wc * 64 + (lane & 31)];
                const float b1 = Bs[kr * 132 + wc * 64 + 32 + (lane & 31)];
                acc0 = __builtin_amdgcn_mfma_f32_32x32x2f32(a, b0, acc0, 0, 0, 0);
                acc1 = __builtin_amdgcn_mfma_f32_32x32x2f32(a, b1, acc1, 0, 0, 0);
            }
        }
#pragma unroll
        for (int reg = 0; reg < 16; ++reg) {
            const int row = tm * 128 + wr * 32 + (reg & 3) + 8 * (reg >> 2) + 4 * (lane >> 5);
            const int col = tn * 128 + wc * 64 + (lane & 31);
            if (row < g.M) {
                if (col < g.N) g.C[(long)row * g.ldc + col] = acc0[reg];
                if (col + 32 < g.N) g.C[(long)row * g.ldc + col + 32] = acc1[reg];
            }
        }
    }
}

__device__ __forceinline__ void ph_prologue(const Params& p, int bid, int nb, float* smem) {
    const int tid = otid();
    {
        const long n4 = (long)R * D / 4, nl4 = (long)NLAT * D / 4;
        for (long i = (long)bid * NTH + tid; i < n4; i += (long)nb * NTH) {
            float4 v = (i < nl4) ? ld4(p.x + i * 4) : ld4(p.ctx + (i - nl4) * 4);
            st4(p.xc + i * 4, v);
        }
    }
    for (int u = bid; u < DEPTH * 24; u += nb) {
        const int l = u / 24, jb = u % 24;
        __syncthreads();
        for (int i = tid; i < 3 * D; i += NTH) {
            const int r = i / D, k = i % D;
            const float cv = (r < 2) ? p.c[r * D + k] : p.c_ctx[k];
            smem[i] = siluf(cv);
        }
        __syncthreads();
        const int j = jb * NTH + tid;
        const float* w = p.w_ada + (long)l * D * (6 * D) + j;
        float a0 = 0.f, a1 = 0.f, a2 = 0.f;
#pragma unroll 8
        for (int k = 0; k < D; ++k) {
            const float wv = w[(long)k * (6 * D)];
            a0 = fmaf(smem[k], wv, a0); a1 = fmaf(smem[D + k], wv, a1); a2 = fmaf(smem[2 * D + k], wv, a2);
        }
        const float bv = p.b_ada[l * 6 * D + j];
        float* mv = p.modv + (long)l * 3 * 6 * D;
        mv[0 * 6 * D + j] = a0 + bv; mv[1 * 6 * D + j] = a1 + bv; mv[2 * 6 * D + j] = a2 + bv;
    }
}

struct Row { float4 v[8]; };
__device__ __forceinline__ void row_load(Row& r, const float* p, int lane) {
#pragma unroll
    for (int i = 0; i < 8; ++i) r.v[i] = ld4(p + (i * 64 + lane) * 4);
}
__device__ __forceinline__ void row_store(const Row& r, float* p, int lane) {
#pragma unroll
    for (int i = 0; i < 8; ++i) st4(p + (i * 64 + lane) * 4, r.v[i]);
}
__device__ __forceinline__ void row_stats(const Row& r, float& mean, float& rstd) {
    float s = 0.f;
#pragma unroll
    for (int i = 0; i < 8; ++i) s += (r.v[i].x + r.v[i].y) + (r.v[i].z + r.v[i].w);
    mean = wsum(s) * (1.0f / D);
    float q = 0.f;
#pragma unroll
    for (int i = 0; i < 8; ++i) { const float a = r.v[i].x - mean, b = r.v[i].y - mean, c = r.v[i].z - mean, d = r.v[i].w - mean; q += (a * a + b * b) + (c * c + d * d); }
    rstd = rsqrtf(wsum(q) * (1.0f / D) + EPS);
}
__device__ __forceinline__ void row_modulate(Row& r, float mean, float rstd, const float* sh, const float* sc, int lane) {
#pragma unroll
    for (int i = 0; i < 8; ++i) {
        const int c = (i * 64 + lane) * 4;
        const float4 s = ld4(sc + c), h = ld4(sh + c);
        r.v[i].x = (r.v[i].x - mean) * rstd * (1.f + s.x) + h.x; r.v[i].y = (r.v[i].y - mean) * rstd * (1.f + s.y) + h.y;
        r.v[i].z = (r.v[i].z - mean) * rstd * (1.f + s.z) + h.z; r.v[i].w = (r.v[i].w - mean) * rstd * (1.f + s.w) + h.w;
    }
}
__device__ __forceinline__ void row_affine(Row& r, float mean, float rstd, const float* g, const float* b, int lane) {
#pragma unroll
    for (int i = 0; i < 8; ++i) {
        const int c = (i * 64 + lane) * 4;
        const float4 s = ld4(g + c), h = ld4(b + c);
        r.v[i].x = (r.v[i].x - mean) * rstd * s.x + h.x; r.v[i].y = (r.v[i].y - mean) * rstd * s.y + h.y;
        r.v[i].z = (r.v[i].z - mean) * rstd * s.z + h.z; r.v[i].w = (r.v[i].w - mean) * rstd * s.w + h.w;
    }
}

__device__ __forceinline__ void ph_lnmod(const Params& p, int l, int bid, int nb) {
    const int tid = otid(), lane = tid & 63, wid = tid >> 6;
    for (int r = bid * NWV + wid; r < R; r += nb * NWV) {
        Row x; row_load(x, p.xc + (long)r * D, lane);
        float mean, rstd; row_stats(x, mean, rstd);
        const float* mv = p.modv + ((long)l * 3 + mod_row(r)) * 6 * D;
        row_modulate(x, mean, rstd, mv + 0 * D, mv + 1 * D, lane);
        row_store(x, p.hb + (long)r * D, lane);
    }
}

__device__ __forceinline__ void ph_prep(const Params& p, int l, int bid, int nb) {
    const int tid = otid(), lane = tid & 63, wid = tid >> 6;
    for (int r = bid * NWV + wid; r < R; r += nb * NWV) {
        float* pr = p.P + (long)r * INC;
        if (r < NLAT) {
            const int t = r % T; const float rowi = (float)(t / 64), coli = (float)(t % 64);
            {
                const int f = lane & 31;
                const float inv = powf(10000.0f, -(float)f / 32.0f);
                const float ang = (lane < 32 ? rowi : coli) * inv;
                float sn, cs; sincosf(ang, &sn, &cs);
#pragma unroll
                for (int h = 0; h < 6; ++h) {
                    float* q = pr + SQ + h * 128;
                    const float x1 = q[lane], x2 = q[lane + 64];
                    q[lane] = x1 * cs - x2 * sn; q[lane + 64] = x2 * cs + x1 * sn;
                }
            }
            if (lane < 32) {
                const int f = lane & 15;
                const float inv = powf(10000.0f, -(float)f / 16.0f);
                const float ang = (lane < 16 ? rowi : coli) * inv;
                float sn, cs; sincosf(ang, &sn, &cs);
                float* q = pr + KR;
                const float x1 = q[lane], x2 = q[lane + 32];
                q[lane] = x1 * cs - x2 * sn; q[lane + 32] = x2 * cs + x1 * sn;
            }
        }
        {
            float v[6]; float s = 0.f;
#pragma unroll
            for (int i = 0; i < 6; ++i) { v[i] = pr[CQ + i * 64 + lane]; s += v[i] * v[i]; }
            const float rs = rsqrtf(wsum(s) * (1.0f / 384.0f) + EPS);
#pragma unroll
            for (int i = 0; i < 6; ++i) p.cqn[(long)r * 384 + i * 64 + lane] = v[i] * rs * p.q_norm[l * 384 + i * 64 + lane];
            const float a = pr[CKV + lane], b = pr[CKV + 64 + lane];
            const float rs2 = rsqrtf(wsum(a * a + b * b) * (1.0f / 128.0f) + EPS);
            p.ckvn[(long)r * 128 + lane] = a * rs2 * p.kv_norm[l * 128 + lane];
            p.ckvn[(long)r * 128 + 64 + lane] = b * rs2 * p.kv_norm[l * 128 + 64 + lane];
        }
    }
}

#define OSM_UPDATE(S, M_, L_, A0, A1, V0, V1) do { const float mn_ = fmaxf(M_, S); const float cr_ = expf(M_ - mn_); const float pp_ = expf((S) - mn_); \
    L_ = L_ * cr_ + pp_; A0 = A0 * cr_ + pp_ * (V0); A1 = A1 * cr_ + pp_ * (V1); M_ = mn_; } while (0)

__device__ __forceinline__ void swa_task(const Params& p, int l, int h, int r0, int lane) {
    constexpr int QW = 4;
    const float scale = 0.08838834764831845f;
    const bool lat = r0 < NLAT;
    const int b = lat ? r0 / T : (r0 - NLAT) / LCTX;
    const int kvh = h >> 1;
    float q0[QW], q1[QW], m[QW], ls[QW], a0[QW], a1[QW];
#pragma unroll
    for (int i = 0; i < QW; ++i) {
        const float* q = p.P + (long)(r0 + i) * INC + SQ + h * 128;
        q0[i] = q[lane] * scale; q1[i] = q[lane + 64] * scale; m[i] = -INFINITY; ls[i] = 0.f; a0[i] = 0.f; a1[i] = 0.f;
    }
    for (int j = 0; j < LCTX; ++j) {
        const float* kp = p.P + (long)(NLAT + b * LCTX + j) * INC;
        const float k0 = kp[SK + kvh * 128 + lane], k1 = kp[SK + kvh * 128 + 64 + lane];
        const float v0 = kp[SV + kvh * 128 + lane], v1 = kp[SV + kvh * 128 + 64 + lane];
#pragma unroll
        for (int i = 0; i < QW; ++i) { const float s = wsum(q0[i] * k0 + q1[i] * k1); OSM_UPDATE(s, m[i], ls[i], a0[i], a1[i], v0, v1); }
    }
    if (lat) {
        const int t0 = r0 % T;
        const int lo = (t0 - 128) < 0 ? 0 : (t0 - 128), hi = (t0 + QW - 1 + 128) > (T - 1) ? (T - 1) : (t0 + QW - 1 + 128);
        for (int tk = lo; tk <= hi; ++tk) {
            const float* kp = p.P + (long)(b * T + tk) * INC;
            const float k0 = kp[SK + kvh * 128 + lane], k1 = kp[SK + kvh * 128 + 64 + lane];
            const float v0 = kp[SV + kvh * 128 + lane], v1 = kp[SV + kvh * 128 + 64 + lane];
#pragma unroll
            for (int i = 0; i < QW; ++i) {
                const int d = tk - (t0 + i);
                if (d >= -128 && d <= 128) { const float s = wsum(q0[i] * k0 + q1[i] * k1); OSM_UPDATE(s, m[i], ls[i], a0[i], a1[i], v0, v1); }
            }
        }
    }
    const float sk = p.swa_sink[l * 4 + h];
#pragma unroll
    for (int i = 0; i < QW; ++i) {
        OSM_UPDATE(sk, m[i], ls[i], a0[i], a1[i], 0.f, 0.f);
        float* o = p.mix + (long)(r0 + i) * D + h * 128;
        const float il = 1.0f / ls[i];
        o[lane] = a0[i] * il; o[lane + 64] = a1[i] * il;
    }
}

__device__ __forceinline__ void mla_task(const Params& p, int h, int r0, int lane) {
    constexpr int QW = 8;
    const float scale = 0.07216878364870323f;
    const bool lat = r0 < NLAT;
    const int b = lat ? r0 / T : (r0 - NLAT) / LCTX;
    float q0[QW], q1[QW], q2[QW], m[QW], ls[QW], a0[QW], a1[QW];
#pragma unroll
    for (int i = 0; i < QW; ++i) {
        const float* q = p.Q2 + (long)(r0 + i) * 768 + h * 192;
        q0[i] = q[lane] * scale; q1[i] = q[lane + 64] * scale;
        float qr = q[128 + lane];
        if (lat) {
            const int t = (r0 + i) % T; const float rowi = (float)(t / 64), coli = (float)(t % 64);
            const int ii = lane & 31, f = ii & 15;
            const float inv = powf(10000.0f, -(float)f / 16.0f);
            const float ang = (ii < 16 ? rowi : coli) * inv;
            float sn, cs; sincosf(ang, &sn, &cs);
            const float other = __shfl_xor(qr, 32);
            qr = (lane < 32) ? (qr * cs - other * sn) : (qr * cs + other * sn);
        }
        q2[i] = qr * scale; m[i] = -INFINITY; ls[i] = 0.f; a0[i] = 0.f; a1[i] = 0.f;
    }
    const int nkeys = lat ? (LCTX + T) : LCTX;
    for (int j = 0; j < nkeys; ++j) {
        const int rk = (j < LCTX) ? (NLAT + b * LCTX + j) : (b * T + (j - LCTX));
        const float* kv = p.KV2 + (long)rk * 1024 + h * 256;
        const float k0 = kv[lane], k1 = kv[64 + lane], v0 = kv[128 + lane], v1 = kv[192 + lane];
        const float k2 = p.P[(long)rk * INC + KR + lane];
#pragma unroll
        for (int i = 0; i < QW; ++i) { const float s = wsum(q0[i] * k0 + q1[i] * k1 + q2[i] * k2); OSM_UPDATE(s, m[i], ls[i], a0[i], a1[i], v0, v1); }
    }
#pragma unroll
    for (int i = 0; i < QW; ++i) {
        float* o = p.mix + (long)(r0 + i) * D + 1024 + h * 128;
        const float il = 1.0f / ls[i];
        o[lane] = a0[i] * il; o[lane + 64] = a1[i] * il;
    }
}

__device__ __forceinline__ void scan_unit(const Params& p, int l, int u, float* smem) {
    const int tid = otid();
    const int dir = u & 1, h = (u >> 1) & 3, b = (u >> 3) & 1, mixer = u >> 4;
    const int j = tid & 127, part = tid >> 7;
    float* sq = smem;
    float* sk = smem + 2048;
    float* sf = smem + 4096;
    float* op = smem + 6144;
    float S[32];
#pragma unroll
    for (int i = 0; i < 32; ++i) S[i] = 0.f;
    float gam = 1.f, lbv[4] = {0.f, 0.f, 0.f, 0.f};
    if (mixer == 0) gam = 1.0f - exp2f(-p.ret_s[(l * 2 + dir) * 4 + h]);
    else if (l > 0) {
#pragma unroll
        for (int e = 0; e < 4; ++e) {
            const int i = (tid + e * NTH) & 127;
            const float l0 = p.lb_logits[(0 * 2 + dir) * 512 + h * 128 + i], l1 = p.lb_logits[(1 * 2 + dir) * 512 + h * 128 + i];
            const float mx = fmaxf(l0, l1), e0 = expf(l0 - mx), e1 = expf(l1 - mx);
            lbv[e] = e1 / (e0 + e1);
        }
    }
    const int voff = (mixer == 0 ? RV : HI) + h * 128 + j;
    float* outp = p.oscan + ((long)(mixer * 2 + dir) * R) * 512 + h * 128 + j;
    for (int p0 = 0; p0 < LCTX + T; p0 += 16) {
        __syncthreads();
#pragma unroll
        for (int e = 0; e < 4; ++e) {
            const int idx = tid + e * NTH, s = idx >> 7, i = idx & 127;
            const int pos = p0 + s;
            int row;
            if (pos < LCTX) row = NLAT + b * LCTX + (dir ? (LCTX - 1 - pos) : pos);
            else { const int t = pos - LCTX; row = b * T + (dir ? (T - 1 - t) : t); }
            const float* pr = p.P + (long)row * INC;
            float qv, kv, fv;
            if (mixer == 0) { qv = pr[RQ + h * 128 + i]; kv = pr[RK + h * 128 + i] * 0.08838834764831845f; fv = gam; }
            else {
                qv = siluf(pr[HQ + h * 128 + i]);
                const float z = pr[(dir ? HFB : HFF) + h * 128 + i];
                const float lb = lbv[e];
                fv = lb + (1.0f - lb) * sigmf(z); kv = 1.0f - fv;
            }
            sq[idx] = qv; sk[idx] = kv; sf[idx] = fv;
        }
        float vv[16];
#pragma unroll
        for (int s = 0; s < 16; ++s) {
            const int pos = p0 + s;
            int row;
            if (pos < LCTX) row = NLAT + b * LCTX + (dir ? (LCTX - 1 - pos) : pos);
            else { const int t = pos - LCTX; row = b * T + (dir ? (T - 1 - t) : t); }
            vv[s] = p.P[(long)row * INC + voff];
        }
        __syncthreads();
#pragma unroll
        for (int s = 0; s < 16; ++s) {
            float o = 0.f;
            const float v = vv[s];
#pragma unroll
            for (int i4 = 0; i4 < 8; ++i4) {
                const float4 f4 = ld4(sf + s * 128 + part * 32 + i4 * 4), k4 = ld4(sk + s * 128 + part * 32 + i4 * 4), q4 = ld4(sq + s * 128 + part * 32 + i4 * 4);
                S[i4 * 4 + 0] = fmaf(f4.x, S[i4 * 4 + 0], k4.x * v); o = fmaf(S[i4 * 4 + 0], q4.x, o);
                S[i4 * 4 + 1] = fmaf(f4.y, S[i4 * 4 + 1], k4.y * v); o = fmaf(S[i4 * 4 + 1], q4.y, o);
                S[i4 * 4 + 2] = fmaf(f4.z, S[i4 * 4 + 2], k4.z * v); o = fmaf(S[i4 * 4 + 2], q4.z, o);
                S[i4 * 4 + 3] = fmaf(f4.w, S[i4 * 4 + 3], k4.w * v); o = fmaf(S[i4 * 4 + 3], q4.w, o);
            }
            op[(part * 16 + s) * 128 + j] = o;
        }
        __syncthreads();
#pragma unroll
        for (int e = 0; e < 4; ++e) {
            const int idx = tid + e * NTH, s = idx >> 7, jj = idx & 127;
            const int pos = p0 + s;
            int row;
            if (pos < LCTX) row = NLAT + b * LCTX + (dir ? (LCTX - 1 - pos) : pos);
            else { const int t = pos - LCTX; row = b * T + (dir ? (T - 1 - t) : t); }
            const float o = (op[(0 * 16 + s) * 128 + jj] + op[(1 * 16 + s) * 128 + jj]) + (op[(2 * 16 + s) * 128 + jj] + op[(3 * 16 + s) * 128 + jj]);
            p.oscan[((long)(mixer * 2 + dir) * R + row) * 512 + h * 128 + jj] = o;
        }
    }
    (void)outp;
}

__device__ __forceinline__ void ph_mixers(const Params& p, int l, int bid, int nb, float* smem) {
    const bool need_ctx = l < DEPTH - 1;
    if (bid < 32) { scan_unit(p, l, bid, smem); return; }
    const int tid = otid(), lane = tid & 63, wid = tid >> 6;
    const int nrows = need_ctx ? R : NLAT;
    const int n_mla = (nrows / 8) * 4, n_swa = (nrows / 4) * 4;
    for (int t = (bid - 32) * NWV + wid; t < n_mla + n_swa; t += (nb - 32) * NWV) {
        if (t < n_mla) mla_task(p, t & 3, (t >> 2) * 8, lane);
        else { const int s = t - n_mla; swa_task(p, l, s & 3, (s >> 2) * 4, lane); }
    }
}

__device__ __forceinline__ void ph_mixpost(const Params& p, int l, int bid, int nb) {
    const int tid = otid(), lane = tid & 63, wid = tid >> 6;
    for (int r = bid * NWV + wid; r < R; r += nb * NWV) {
        const float* pr = p.P + (long)r * INC;
#pragma unroll
        for (int h = 0; h < 4; ++h) {
            {
                const float* o0 = p.oscan + ((long)(0 * 2 + 0) * R + r) * 512 + h * 128;
                const float* o1 = p.oscan + ((long)(0 * 2 + 1) * R + r) * 512 + h * 128;
                const float a = o0[lane] + o1[lane], b = o0[lane + 64] + o1[lane + 64];
                const float mean = wsum(a + b) * (1.0f / 128.0f);
                const float da = a - mean, db = b - mean;
                const float rstd = rsqrtf(wsum(da * da + db * db) * (1.0f / 128.0f) + EPS);
                const int c = h * 128 + lane;
                p.mix[(long)r * D + 512 + c] = siluf(pr[RG + c]) * (da * rstd * p.ret_gn[l * 512 + c]);
                p.mix[(long)r * D + 512 + c + 64] = siluf(pr[RG + c + 64]) * (db * rstd * p.ret_gn[l * 512 + c + 64]);
            }
            {
                const float* o0 = p.oscan + ((long)(1 * 2 + 0) * R + r) * 512 + h * 128;
                const float* o1 = p.oscan + ((long)(1 * 2 + 1) * R + r) * 512 + h * 128;
                const float a = o0[lane] + o1[lane], b = o0[lane + 64] + o1[lane + 64];
                const float rs = rsqrtf(wsum(a * a + b * b) * (1.0f / 128.0f) + EPS);
                const int c = h * 128 + lane;
                p.mix[(long)r * D + 1536 + c] = siluf(pr[HG + c]) * (a * rs * p.hgrn_gn[l * 512 + c]);
                p.mix[(long)r * D + 1536 + c + 64] = siluf(pr[HG + c + 64]) * (b * rs * p.hgrn_gn[l * 512 + c + 64]);
            }
        }
    }
}

__device__ __forceinline__ void ph_post1(const Params& p, int l, int bid, int nb, float* smem) {
    const int tid = otid(), lane = tid & 63, wid = tid >> 6;
    const int nrows = (l < DEPTH - 1) ? R : NLAT;
    for (int r = bid * NWV + wid; r < nrows; r += nb * NWV) {
        const float* mv = p.modv + ((long)l * 3 + mod_row(r)) * 6 * D;
        Row x, o; row_load(x, p.xc + (long)r * D, lane); row_load(o, p.ob + (long)r * D, lane);
#pragma unroll
        for (int i = 0; i < 8; ++i) {
            const float4 g = ld4(mv + 2 * D + (i * 64 + lane) * 4);
            x.v[i].x = ALPHA * x.v[i].x + g.x * o.v[i].x; x.v[i].y = ALPHA * x.v[i].y + g.y * o.v[i].y;
            x.v[i].z = ALPHA * x.v[i].z + g.z * o.v[i].z; x.v[i].w = ALPHA * x.v[i].w + g.w * o.v[i].w;
        }
        float mean, rstd; row_stats(x, mean, rstd);
        row_affine(x, mean, rstd, p.ln1_g + l * D, p.ln1_b + l * D, lane);
        row_store(x, p.xc + (long)r * D, lane);
        row_stats(x, mean, rstd);
        row_modulate(x, mean, rstd, mv + 3 * D, mv + 4 * D, lane);
        row_store(x, p.hb + (long)r * D, lane);
        float* hrow = smem + wid * D;
#pragma unroll
        for (int i = 0; i < 8; ++i) st4(hrow + (i * 64 + lane) * 4, x.v[i]);
        asm volatile("s_waitcnt lgkmcnt(0)" ::: "memory");
        float acc = 0.f;
        if (lane < 36) {
            const float* wp = (lane < 32) ? (p.w_re + (long)l * D * 32 + lane) : (p.w_rg + (long)l * D * 4 + (lane - 32));
            const int wst = (lane < 32) ? 32 : 4;
#pragma unroll 8
            for (int k = 0; k < D; ++k) acc = fmaf(hrow[k], wp[(long)k * wst], acc);
        }
        asm volatile("" ::: "memory");
        float lg[4], le[32];
#pragma unroll
        for (int g = 0; g < 4; ++g) lg[g] = __shfl(acc, 32 + g);
#pragma unroll
        for (int e = 0; e < 32; ++e) le[e] = __shfl(acc, e);
        int grp = 0; float gm = lg[0];
#pragma unroll
        for (int g = 1; g < 4; ++g) if (lg[g] > gm) { gm = lg[g]; grp = g; }
        float zs = 0.f;
#pragma unroll
        for (int g = 0; g < 4; ++g) zs += expf(lg[g] - gm);
        const float pgrp = 1.0f / zs;
        float ev[8];
#pragma unroll
        for (int e = 0; e < 8; ++e) { ev[e] = (grp == 0) ? le[e] : (grp == 1) ? le[8 + e] : (grp == 2) ? le[16 + e] : le[24 + e]; }
        int i0 = 0; float v0 = ev[0];
#pragma unroll
        for (int e = 1; e < 8; ++e) if (ev[e] > v0) { v0 = ev[e]; i0 = e; }
        int i1 = -1; float v1 = -INFINITY;
#pragma unroll
        for (int e = 0; e < 8; ++e) if (e != i0 && ev[e] > v1) { v1 = ev[e]; i1 = e; }
        const float e1 = expf(v1 - v0);
        const float g0 = pgrp / (1.0f + e1), g1 = pgrp * e1 / (1.0f + e1);
        if (lane == 0) {
            p.eid[r * 2 + 0] = grp * 8 + i0; p.eid[r * 2 + 1] = grp * 8 + i1;
            p.gate[r * 2 + 0] = g0; p.gate[r * 2 + 1] = g1;
        }
    }
}

__device__ __forceinline__ void ph_sort(const Params& p, int l, int bid, int* smem) {
    if (bid != 0) return;
    const int tid = otid(), lane = tid & 63, wid = tid >> 6;
    const int ntok = (l < DEPTH - 1) ? R : NLAT;
    const int nch = ntok / 64;
    int* cnt = smem;
    int* pst = smem + 136 * 32;
    int* tot = pst + 32;
    for (int i = tid; i < NSLOT; i += NTH) p.slot_tok[i] = -1;
    for (int c = wid; c < nch; c += NWV) {
        const int t = c * 64 + lane;
        const int e0 = p.eid[t * 2], e1 = p.eid[t * 2 + 1];
        for (int e = 0; e < 32; ++e) {
            const unsigned long long mk = __ballot(e0 == e || e1 == e);
            if (lane == 0) cnt[c * 32 + e] = __popcll(mk);
        }
    }
    __threadfence_block();
    __syncthreads();
    if (tid < 32) {
        int run = 0;
        for (int c = 0; c < nch; ++c) { const int v = cnt[c * 32 + tid]; cnt[c * 32 + tid] = run; run += v; }
        tot[tid] = run;
    }
    __syncthreads();
    if (tid == 0) {
        int ps = 0;
        for (int e = 0; e < 32; ++e) { pst[e] = ps; ps += (tot[e] + 127) / 128 * 128; }
        int e = 0;
        for (int b = 0; b < NTILE; ++b) {
            const int s = b * 128;
            while (e < 32 && s >= pst[e] + (tot[e] + 127) / 128 * 128) ++e;
            p.tile_e[b] = (e < 32) ? e : -1;
        }
    }
    __syncthreads();
    for (int c = wid; c < nch; c += NWV) {
        const int t = c * 64 + lane;
        const int e0 = p.eid[t * 2], e1 = p.eid[t * 2 + 1];
        for (int e = 0; e < 32; ++e) {
            const unsigned long long mk = __ballot(e0 == e || e1 == e);
            const int rank = __popcll(mk & ((1ull << lane) - 1ull));
            if (e0 == e || e1 == e) {
                const int slot = pst[e] + cnt[c * 32 + e] + rank;
                p.slot_tok[slot] = t;
                p.slot_of[t * 2 + (e1 == e ? 1 : 0)] = slot;
            }
        }
    }
}

__device__ __forceinline__ void ph_act(const Params& p, int bid, int nb) {
    const long n4 = (long)NSLOT * FF / 4;
    for (long i = (long)bid * NTH + otid(); i < n4; i += (long)nb * NTH) {
        if (p.tile_e[(int)(i / (128 * FF / 4))] < 0) continue;
        const float4 a = ld4(p.G1 + i * 4), b = ld4(p.G3 + i * 4);
        st4(p.act + i * 4, make_float4(siluf(a.x) * b.x, siluf(a.y) * b.y, siluf(a.z) * b.z, siluf(a.w) * b.w));
    }
}

__device__ __forceinline__ void ph_post2(const Params& p, int l, int bid, int nb) {
    const int tid = otid(), lane = tid & 63, wid = tid >> 6;
    const int nrows = (l < DEPTH - 1) ? R : NLAT;
    for (int r = bid * NWV + wid; r < nrows; r += nb * NWV) {
        const float* mv = p.modv + ((long)l * 3 + mod_row(r)) * 6 * D;
        const int s0 = p.slot_of[r * 2], s1 = p.slot_of[r * 2 + 1];
        const float g0 = p.gate[r * 2], g1 = p.gate[r * 2 + 1];
        Row x, y0, y1; row_load(x, p.xc + (long)r * D, lane); row_load(y0, p.Ys + (long)s0 * D, lane); row_load(y1, p.Ys + (long)s1 * D, lane);
#pragma unroll
        for (int i = 0; i < 8; ++i) {
            const float4 g = ld4(mv + 5 * D + (i * 64 + lane) * 4);
            x.v[i].x = ALPHA * x.v[i].x + g.x * (g0 * y0.v[i].x + g1 * y1.v[i].x); x.v[i].y = ALPHA * x.v[i].y + g.y * (g0 * y0.v[i].y + g1 * y1.v[i].y);
            x.v[i].z = ALPHA * x.v[i].z + g.z * (g0 * y0.v[i].z + g1 * y1.v[i].z); x.v[i].w = ALPHA * x.v[i].w + g.w * (g0 * y0.v[i].w + g1 * y1.v[i].w);
        }
        float mean, rstd; row_stats(x, mean, rstd);
        row_affine(x, mean, rstd, p.ln2_g + l * D, p.ln2_b + l * D, lane);
        if (l == DEPTH - 1) row_store(x, p.out + (long)r * D, lane);
        else row_store(x, p.xc + (long)r * D, lane);
    }
}

constexpr int PH_PER_LAYER = 13, N_PHASES = 1 + DEPTH * PH_PER_LAYER;
constexpr int LDS_BYTES = 80 * 1024;

__global__ void __launch_bounds__(NTH, 2) fwd(Params p) {
    extern __shared__ __attribute__((aligned(16))) unsigned char lds_raw[];
    float* smem = (float*)(lds_raw + 16);
    const int bid = blockIdx.x, nb = gridDim.x;
#if ONE_LAUNCH
    if (threadIdx.x == 0) *(uint4*)lds_raw = make_uint4(0u, 0u, 0u, 0u);
    __syncthreads();
    XcdBarrier bar = xcd_barrier_post(p.bar, (volatile LAS unsigned*)lds_raw);
#define SEAM(k) do { if ((k) + 1 < p.ph_hi) xcd_barrier(bar); } while (0)
#else
#define SEAM(k) do { } while (0)
#endif
#define IN(k) (p.ph_lo <= (k) && (k) < p.ph_hi)
    if (IN(0)) { ph_prologue(p, bid, nb, smem); SEAM(0); }
    for (int l = 0; l < DEPTH; ++l) {
        const int k0 = 1 + l * PH_PER_LAYER;
        const int mrows = (l < DEPTH - 1) ? R : NLAT;
        if (IN(k0 + 0)) { ph_lnmod(p, l, bid, nb); SEAM(k0 + 0); }
        if (IN(k0 + 1)) { GemmArgs g{p.hb, D, nullptr, p.w_in + (long)l * D * INC, INC, 0, nullptr, p.P, INC, R, INC, D}; gemm_f32(g, bid, nb, smem); SEAM(k0 + 1); }
        if (IN(k0 + 2)) { ph_prep(p, l, bid, nb); SEAM(k0 + 2); }
        if (IN(k0 + 3)) {
            GemmArgs g1{p.cqn, 384, nullptr, p.w_uq + (long)l * 384 * 768, 768, 0, nullptr, p.Q2, 768, R, 768, 384}; gemm_f32(g1, bid, nb, smem);
            GemmArgs g2{p.ckvn, 128, nullptr, p.w_ukv + (long)l * 128 * 1024, 1024, 0, nullptr, p.KV2, 1024, R, 1024, 128}; gemm_f32(g2, bid, nb, smem);
            SEAM(k0 + 3);
        }
        if (IN(k0 + 4)) { ph_mixers(p, l, bid, nb, smem); SEAM(k0 + 4); }
        if (IN(k0 + 5)) { ph_mixpost(p, l, bid, nb); SEAM(k0 + 5); }
        if (IN(k0 + 6)) { GemmArgs g{p.mix, D, nullptr, p.w_out + (long)l * D * D, D, 0, nullptr, p.ob, D, mrows, D, D}; gemm_f32(g, bid, nb, smem); SEAM(k0 + 6); }
        if (IN(k0 + 7)) { ph_post1(p, l, bid, nb, smem); SEAM(k0 + 7); }
        if (IN(k0 + 8)) { ph_sort(p, l, bid, (int*)smem); SEAM(k0 + 8); }
        if (IN(k0 + 9)) {
            GemmArgs g1{p.hb, D, p.slot_tok, p.w1 + (long)l * NEXP * D * FF, FF, (long)D * FF, p.tile_e, p.G1, FF, NSLOT, FF, D}; gemm_f32(g1, bid, nb, smem);
            GemmArgs g3{p.hb, D, p.slot_tok, p.w3 + (long)l * NEXP * D * FF, FF, (long)D * FF, p.tile_e, p.G3, FF, NSLOT, FF, D}; gemm_f32(g3, bid, nb, smem);
            SEAM(k0 + 9);
        }
        if (IN(k0 + 10)) { ph_act(p, bid, nb); SEAM(k0 + 10); }
        if (IN(k0 + 11)) { GemmArgs g{p.act, FF, nullptr, p.w2 + (long)l * NEXP * FF * D, D, (long)FF * D, p.tile_e, p.Ys, D, NSLOT, D, FF}; gemm_f32(g, bid, nb, smem); SEAM(k0 + 11); }
        if (IN(k0 + 12)) { ph_post2(p, l, bid, nb); SEAM(k0 + 12); }
    }
}

static inline size_t al256(size_t v) { return (v + 255) & ~(size_t)255; }

extern "C" void kernel_launch(void* const* d_in, const int* in_sizes, int n_in, void* d_out, int out_size, void* d_ws, size_t ws_size, hipStream_t stream) {
    static int grid = 0;
    if (grid == 0) {
        int dev = 0, cus = 0, per_cu = 0;
        hipGetDevice(&dev);
        hipDeviceGetAttribute(&cus, hipDeviceAttributeMultiprocessorCount, dev);
        hipFuncSetAttribute((const void*)fwd, hipFuncAttributeMaxDynamicSharedMemorySize, LDS_BYTES);
        hipOccupancyMaxActiveBlocksPerMultiprocessor(&per_cu, (const void*)fwd, NTH, LDS_BYTES);
        (void)hipGetLastError();
        if (cus <= 0) cus = 256;
        grid = cus;
        if (per_cu < 1) fprintf(stderr, "kernel_launch: occupancy query reports %d\n", per_cu);
    }
    Params p{};
    const float* const* in = (const float* const*)d_in;
    p.x = in[0]; p.c = in[1]; p.ctx = in[2]; p.c_ctx = in[3]; p.w_ada = in[4]; p.b_ada = in[5]; p.w_in = in[6]; p.swa_sink = in[7];
    p.ret_s = in[8]; p.ret_gn = in[9]; p.q_norm = in[10]; p.kv_norm = in[11]; p.w_uq = in[12]; p.w_ukv = in[13]; p.lb_logits = in[14];
    p.hgrn_gn = in[15]; p.w_out = in[16]; p.ln1_g = in[17]; p.ln1_b = in[18]; p.w_rg = in[19]; p.w_re = in[20]; p.w1 = in[21]; p.w3 = in[22];
    p.w2 = in[23]; p.ln2_g = in[24]; p.ln2_b = in[25];
    p.out = (float*)d_out;
    unsigned char* ws = (unsigned char*)d_ws; size_t off = 0;
    auto carve = [&](size_t bytes) { unsigned char* q = ws + off; off = al256(off + bytes); return q; };
    p.bar = (unsigned*)carve(XCD_BAR_WORDS * 4);
    p.modv = (float*)carve((size_t)DEPTH * 3 * 6 * D * 4);
    p.xc = (float*)carve((size_t)R * D * 4);
    p.hb = (float*)carve((size_t)R * D * 4);
    p.P = (float*)carve((size_t)R * INC * 4);
    p.cqn = (float*)carve((size_t)R * 384 * 4);
    p.ckvn = (float*)carve((size_t)R * 128 * 4);
    p.Q2 = (float*)carve((size_t)R * 768 * 4);
    p.KV2 = (float*)carve((size_t)R * 1024 * 4);
    p.oscan = (float*)carve((size_t)4 * R * 512 * 4);
    p.mix = (float*)carve((size_t)R * D * 4);
    p.ob = (float*)carve((size_t)R * D * 4);
    p.G1 = (float*)carve((size_t)NSLOT * FF * 4);
    p.G3 = (float*)carve((size_t)NSLOT * FF * 4);
    p.act = (float*)carve((size_t)NSLOT * FF * 4);
    p.Ys = (float*)carve((size_t)NSLOT * D * 4);
    p.gate = (float*)carve((size_t)R * 2 * 4);
    p.eid = (int*)carve((size_t)R * 2 * 4);
    p.slot_of = (int*)carve((size_t)R * 2 * 4);
    p.slot_tok = (int*)carve((size_t)NSLOT * 4);
    p.tile_e = (int*)carve((size_t)NTILE * 4);
    if (off > ws_size) { fprintf(stderr, "kernel_launch: workspace too small: need %zu have %zu\n", off, ws_size); return; }
    hipMemsetAsync(p.bar, 0, XCD_BAR_WORDS * 4, stream);
#if ONE_LAUNCH
    p.ph_lo = 0; p.ph_hi = N_PHASES;
    hipLaunchKernelGGL(fwd, dim3(grid), dim3(NTH), LDS_BYTES, stream, p);
#else
    for (int k = 0; k < N_PHASES; ++k) {
        p.ph_lo = k; p.ph_hi = k + 1;
        hipLaunchKernelGGL(fwd, dim3(grid), dim3(NTH), LDS_BYTES, stream, p);
    }
#endif
}
```

```cpp
#include <hip/hip_runtime.h>
#include <cstdio>
#include <cstdint>

#ifndef ONE_LAUNCH
#define ONE_LAUNCH 1
#endif

constexpr int D = 2048, NBATCH = 2, T = 4096, LCTX = 256, DEPTH = 2;
constexpr int NLAT = NBATCH * T, NCTX = NBATCH * LCTX, R = NLAT + NCTX;
constexpr int INC = 6208;
constexpr int SQ = 0, SK = 512, SV = 768, RQ = 1024, RK = 1536, RV = 2048, RG = 2560, CQ = 3072, CKV = 3456, KR = 3584,
              HQ = 3648, HFF = 4160, HFB = 4672, HI = 5184, HG = 5696;
constexpr int NEXP = 32, FF = 512;
constexpr int NSLOT = 25600, NTILE = NSLOT / 256;
constexpr int INP = 6400;
constexpr float EPS = 1e-6f;
constexpr float ALPHA = 1.41421356237309515f;
constexpr int NTH = 512, NWV = 8;

typedef float f32x16 __attribute__((ext_vector_type(16)));
typedef unsigned short bf16_t;
typedef short bf16x8 __attribute__((ext_vector_type(8)));
typedef float f32x4 __attribute__((ext_vector_type(4)));
typedef unsigned u32x4 __attribute__((ext_vector_type(4)));
typedef unsigned u32x2 __attribute__((ext_vector_type(2)));

#define XB_TMO      128
#define XB_XCNT(j)  (256  + 64 * (j))
#define XB_XSUB(j)  (1280 + 64 * (j))
#define XB_XGEN(j)  (2304 + 64 * (j))
#define XB_TOP      3328
#define XB_TOPGEN   3392
#define XCD_BAR_WORDS 3456
#define XB_SPIN_CAP (1u << 18)
#define LAS __attribute__((address_space(3)))

__device__ __forceinline__ unsigned xb_ld(unsigned* p)              { return __hip_atomic_load(p, __ATOMIC_RELAXED, __HIP_MEMORY_SCOPE_AGENT); }
__device__ __forceinline__ unsigned xb_add(unsigned* p, unsigned v) { return __hip_atomic_fetch_add(p, v, __ATOMIC_RELAXED, __HIP_MEMORY_SCOPE_AGENT); }
__device__ __forceinline__ unsigned xb_xcc_id() { return (unsigned)__builtin_amdgcn_s_getreg((3 << 11) | 20) & 0xFu; }
#define XB_SPIN(cond, bar) do { unsigned _sp = 0; while (cond) { __builtin_amdgcn_s_sleep(1); \
    if ((++_sp & 255u) == 0u) { if (xb_ld(&(bar)[XB_TMO])) break; if (_sp > XB_SPIN_CAP) { atomicAdd(&(bar)[XB_TMO], 1u); break; } } } } while (0)

struct XcdBarrier { unsigned* bar; unsigned x; volatile LAS unsigned* st; };

__device__ __forceinline__ XcdBarrier xcd_barrier_post(unsigned* bar, volatile LAS unsigned* st) {
    XcdBarrier b; b.bar = bar; b.x = xb_xcc_id(); b.st = st;
    if (threadIdx.x == 0) (void)xb_add(&bar[XB_XCNT(b.x)], 1u);
    return b;
}
__device__ __forceinline__ void xcd_barrier_complete(unsigned* bar, unsigned x, unsigned& nloc, unsigned& nx) {
    const unsigned G = gridDim.x * gridDim.y * gridDim.z;
    unsigned sum, cnt, mine, sp = 0u;
    for (;;) {
        sum = 0u; cnt = 0u; mine = 0u;
#pragma unroll
        for (unsigned j = 0; j < 16; ++j) { const unsigned c = xb_ld(&bar[XB_XCNT(j)]); sum += c; cnt += (c > 0u) ? 1u : 0u; mine = (j == x) ? c : mine; }
        if (sum == G) break;
        __builtin_amdgcn_s_sleep(1);
        if ((++sp & 255u) == 0u) { if (xb_ld(&bar[XB_TMO])) break; if (sp > XB_SPIN_CAP) { atomicAdd(&bar[XB_TMO], 1u); break; } }
    }
    nloc = mine > 0u ? mine : 1u; nx = cnt > 0u ? cnt : 1u;
}
__device__ __forceinline__ void xcd_barrier(const XcdBarrier& b) {
    asm volatile("s_waitcnt vmcnt(0)" ::: "memory");
    __syncthreads();
    if (threadIdx.x == 0) {
        unsigned* bar = b.bar;
        __builtin_amdgcn_s_waitcnt(0);
        unsigned nloc = b.st[0], nx = b.st[1];
        if (nloc == 0u) { xcd_barrier_complete(bar, b.x, nloc, nx); b.st[0] = nloc; b.st[1] = nx; }
        const unsigned old = xb_add(&bar[XB_XSUB(b.x)], 1u);
        const unsigned gen = old / nloc;
        if (old + 1u == (gen + 1u) * nloc) {
            __builtin_amdgcn_fence(__ATOMIC_RELEASE, "agent");
            asm volatile("s_waitcnt vmcnt(0)" ::: "memory");
            const unsigned og = xb_add(&bar[XB_TOP], 1u);
            const unsigned tg = og / nx;
            if (og + 1u == (tg + 1u) * nx) xb_add(&bar[XB_TOPGEN], 1u);
            else XB_SPIN(xb_ld(&bar[XB_TOPGEN]) == tg, bar);
            __builtin_amdgcn_fence(__ATOMIC_ACQUIRE, "agent");
            xb_add(&bar[XB_XGEN(b.x)], 1u);
            asm volatile("s_waitcnt vmcnt(0)" ::: "memory");
        } else {
            XB_SPIN(xb_ld(&bar[XB_XGEN(b.x)]) == gen, bar);
            __builtin_amdgcn_fence(__ATOMIC_ACQUIRE, "agent");
            asm volatile("s_waitcnt vmcnt(0)" ::: "memory");
        }
    }
    __syncthreads();
}

struct Params {
    const float *x, *c, *ctx, *c_ctx, *w_ada, *b_ada, *w_in, *swa_sink, *ret_s, *ret_gn, *q_norm, *kv_norm, *w_uq, *w_ukv,
                *lb_logits, *hgrn_gn, *w_out, *ln1_g, *ln1_b, *w_rg, *w_re, *w1, *w3, *w2, *ln2_g, *ln2_b;
    float* out;
    unsigned* bar;
    float *modv, *xc, *P, *Q2, *KV2, *oscan, *ob, *Ys, *gate;
    bf16_t *hb, *cqn, *ckvn, *mix, *xs, *act;
    bf16_t *WinT, *WoutT, *WuqT, *WukvT, *W13T, *W2T;
    int *eid, *slot_of, *slot_tok, *tile_e;
    int ph_lo, ph_hi;
};

__device__ __forceinline__ int otid() { int t = threadIdx.x; asm volatile("" : "+v"(t)); return t; }
__device__ __forceinline__ float wsum(float v) {
#pragma unroll
    for (int o = 32; o > 0; o >>= 1) v += __shfl_xor(v, o);
    return v;
}
__device__ __forceinline__ float siluf(float v) { return v / (1.0f + expf(-v)); }
__device__ __forceinline__ float sigmf(float v) { return 1.0f / (1.0f + expf(-v)); }
__device__ __forceinline__ int mod_row(int r) { return r < NLAT ? (r >= T ? 1 : 0) : 2; }
__device__ __forceinline__ float4 ld4(const float* p) { return *(const float4*)p; }
__device__ __forceinline__ bf16_t f2bf(float f) { unsigned u = __float_as_uint(f); u += 0x7FFFu + ((u >> 16) & 1u); return (bf16_t)(u >> 16); }
__device__ __forceinline__ unsigned cvt_pk_bf16(float lo, float hi) { unsigned r; asm volatile("v_cvt_pk_bf16_f32 %0, %1, %2" : "=v"(r) : "v"(lo), "v"(hi)); return r; }
__device__ __forceinline__ void st4(float* p, float4 v) { *(float4*)p = v; }

namespace pg8 {
constexpr int BM = 256, BK = 64, HALF = 128, HTB = HALF * BK * 2, STAGE_BYTES = 8 * HTB, NXCD = 8, WGM = 8;
__host__ __device__ __forceinline__ int lds_byte(int r, int c) { const int st = (r >> 4) * 2 + (c >> 5), rr = r & 15, cc = c & 31, ob = rr * 64 + cc * 2; return st * 1024 + (ob ^ (((ob >> 9) & 1) << 5)); }
__host__ __device__ __forceinline__ void stage_rc(int b, int& R, int& C) { const int st = b / 1024, sb = b % 1024, swz = sb ^ (((sb >> 9) & 1) << 5); R = (st >> 1) * 16 + swz / 64; C = (st & 1) * 32 + (swz % 64) / 2; }
struct Unit { int pm, pn; };
struct Gemm { const bf16_t* A; const bf16_t* Bt; int M, N, K; };
struct StaticOrder {
    int nM, nN, nwg, G, c;
    __device__ void init(int M, int N, int G_, int c_) { nM = M / BM; nN = N / BM; nwg = nM * nN; G = G_; c = c_; }
    __device__ bool next(int i, Unit& u) const {
        const long L = (long)i * G + c; if (L >= nwg) return false;
        int wgid = (int)L; { const int q = nwg / NXCD, r = nwg % NXCD, xcd = wgid % NXCD, off = wgid / NXCD; wgid = (xcd < r ? xcd * (q + 1) : r * (q + 1) + (xcd - r) * q) + off; }
        const int nig = WGM * nN, gid = wgid / nig, fm = gid * WGM, gsz = (nM - fm) < WGM ? (nM - fm) : WGM;
        u.pm = fm + ((wgid % nig) % gsz); u.pn = (wgid % nig) / gsz; return true;
    }
    __device__ __forceinline__ size_t boff(const Unit& u, size_t tstep) const { return (size_t)u.pn * tstep; }
};
struct MoeOrder {
    int npn, nunits, G, c; size_t estride; const int* tile_e;
    __device__ bool next(int i, Unit& u) const { const long L = (long)i * G + c; if (L >= nunits) return false; u.pm = (int)(L / npn); u.pn = (int)(L % npn); return true; }
    __device__ __forceinline__ size_t boff(const Unit& u, size_t tstep) const { return (size_t)tile_e[u.pm] * estride + (size_t)u.pn * tstep; }
};
struct EpiF32 {
    float* C; int ldc; int ncols;
    __device__ __forceinline__ void operator()(const f32x4 (&acc)[2][2][4][2], const Unit& u, int wr, int wc, int fr, int fq) const {
        const int row0 = u.pm * BM + wr * 64 + fr, col0 = u.pn * BM + wc * 32 + 4 * fq;
#pragma unroll
        for (int ai = 0; ai < 2; ++ai)
#pragma unroll
            for (int m = 0; m < 4; ++m) { float* rowp = C + (size_t)(row0 + ai * HALF + m * 16) * ldc + col0;
#pragma unroll
                for (int bj = 0; bj < 2; ++bj)
#pragma unroll
                    for (int n = 0; n < 2; ++n) if (col0 + bj * HALF + n * 16 < ncols) *(f32x4*)(rowp + bj * HALF + n * 16) = acc[ai][bj][m][n]; }
    }
};
struct EpiSwiglu {
    bf16_t* O; int ldc;
    __device__ __forceinline__ void operator()(const f32x4 (&acc)[2][2][4][2], const Unit& u, int wr, int wc, int fr, int fq) const {
        const int row0 = u.pm * BM + wr * 64 + fr, col0 = u.pn * HALF + wc * 32 + 4 * fq;
#pragma unroll
        for (int ai = 0; ai < 2; ++ai)
#pragma unroll
            for (int m = 0; m < 4; ++m) { bf16_t* rowp = O + (size_t)(row0 + ai * HALF + m * 16) * ldc + col0;
#pragma unroll
                for (int n = 0; n < 2; ++n) { const f32x4 g = acc[ai][0][m][n], v = acc[ai][1][m][n]; float r[4];
#pragma unroll
                    for (int j = 0; j < 4; ++j) r[j] = g[j] / (1.0f + __expf(-g[j])) * v[j];
                    u32x2 w; w.x = cvt_pk_bf16(r[0], r[1]); w.y = cvt_pk_bf16(r[2], r[3]); *(u32x2*)(rowp + n * 16) = w; } }
    }
};
template <class Epi, class Sched>
__device__ __forceinline__ void gemm_phase(LAS unsigned char* lds, const Gemm g, const Sched& S, const Epi& E) {
    const int tid = otid(), wid = __builtin_amdgcn_readfirstlane(tid >> 6), lane = tid & 63, wr = wid >> 2, wc = wid & 3, fr = lane & 15, fq = lane >> 4;
    const int K = g.K, nt = K / BK;
    unsigned voffA[2], voffB[2];
#pragma unroll
    for (int i = 0; i < 2; ++i) { int R_, C_; stage_rc(tid * 16 + i * 8192, R_, C_); voffA[i] = (unsigned)(R_ * K + C_) * 2u; voffB[i] = voffA[i]; }
    const size_t kstep = (size_t)(BK * 2);
    const size_t hstep = (size_t)HALF * K * 2;
    const size_t tstep = 2 * hstep;
    const unsigned ldsw = (unsigned)wid * 1024u;
    const int aoff = lds_byte(wr * 64 + fr, fq * 8), boff = lds_byte(wc * 32 + fr, fq * 8);
#define PG8_SA(b, h) (((b) * 2 + (h)) * HTB)
#define PG8_SB(b, h) ((4 + (b) * 2 + (h)) * HTB)
#define PG8_STAGE(bufoff, gbase, voff) do { _Pragma("unroll") for (int _i = 0; _i < 2; ++_i) \
        __builtin_amdgcn_global_load_lds((const unsigned*)((const char*)(gbase) + (voff)[_i]), (LAS unsigned*)(lds + (bufoff) + ldsw + _i * 8192), 16, 0, 0); } while (0)
#define PG8_LDA(dst, b, h) do { _Pragma("unroll") for (int m = 0; m < 4; ++m) _Pragma("unroll") for (int k = 0; k < 2; ++k) dst[m][k] = *(const LAS bf16x8*)(lds + PG8_SA(b, h) + aoff + m * 2048 + k * 1024); } while (0)
#define PG8_LDB(dst, b, h) do { _Pragma("unroll") for (int n = 0; n < 2; ++n) _Pragma("unroll") for (int k = 0; k < 2; ++k) dst[n][k] = *(const LAS bf16x8*)(lds + PG8_SB(b, h) + boff + n * 2048 + k * 1024); } while (0)
#define PG8_MMA(ai, bj, At, Bt) do { __builtin_amdgcn_s_setprio(1); _Pragma("unroll") for (int m = 0; m < 4; ++m) _Pragma("unroll") for (int n = 0; n < 2; ++n) _Pragma("unroll") for (int k = 0; k < 2; ++k) \
        acc[ai][bj][m][n] = __builtin_amdgcn_mfma_f32_16x16x32_bf16(Bt[n][k], At[m][k], acc[ai][bj][m][n], 0, 0, 0); __builtin_amdgcn_s_setprio(0); } while (0)
#define PG8_WAIT_V(n) asm volatile("s_waitcnt vmcnt(" #n ")" ::: "memory")
#define PG8_WAIT_L(n) asm volatile("s_waitcnt lgkmcnt(" #n ")" ::: "memory")
#define PG8_BAR __builtin_amdgcn_s_barrier()
#define PG8_SCHED __builtin_amdgcn_sched_barrier(0)
    Unit cur, nxt; int ui = 0;
    if (!S.next(0, cur)) return;
    f32x4 acc[2][2][4][2];
#pragma unroll
    for (int a = 0; a < 2; ++a)
#pragma unroll
        for (int b = 0; b < 2; ++b)
#pragma unroll
            for (int m = 0; m < 4; ++m)
#pragma unroll
                for (int n = 0; n < 2; ++n) acc[a][b][m][n] = (f32x4){0.f, 0.f, 0.f, 0.f};
    bf16x8 At[4][2], B0[2][2], B1[2][2];
    const char* cA = (const char*)g.A + (size_t)cur.pm * tstep; const char* cB = (const char*)g.Bt + S.boff(cur, tstep);
    PG8_STAGE(PG8_SB(0, 0), cB, voffB); PG8_STAGE(PG8_SA(0, 0), cA, voffA); PG8_STAGE(PG8_SB(0, 1), cB + hstep, voffB); PG8_STAGE(PG8_SA(0, 1), cA + hstep, voffA);
    if (wr == 1) PG8_BAR;
    PG8_WAIT_V(4); PG8_BAR;
    PG8_STAGE(PG8_SB(1, 0), cB + kstep, voffB); PG8_STAGE(PG8_SA(1, 0), cA + kstep, voffA); PG8_STAGE(PG8_SB(1, 1), cB + hstep + kstep, voffB);
    PG8_WAIT_V(6); PG8_BAR;
    for (;;) {
        const bool has_next = S.next(ui + 1, nxt);
        const char* nA = has_next ? (const char*)g.A + (size_t)nxt.pm * tstep : cA; const char* nB = has_next ? (const char*)g.Bt + S.boff(nxt, tstep) : cB;
        for (int t = 0; t < nt; t += 2) {
            const bool last = (t == nt - 2);
            const char* a1 = cA + (size_t)(t + 1) * kstep;
            const char* a2 = last ? nA : cA + (size_t)(t + 2) * kstep; const char* b2 = last ? nB : cB + (size_t)(t + 2) * kstep;
            const char* a3 = a2 + kstep; const char* b3 = b2 + kstep;
            PG8_LDB(B0, 0, 0); PG8_SCHED; PG8_LDA(At, 0, 0); PG8_STAGE(PG8_SA(1, 1), a1 + hstep, voffA);
            PG8_WAIT_L(8); PG8_BAR; PG8_WAIT_L(0); PG8_MMA(0, 0, At, B0); PG8_BAR; PG8_SCHED;
            PG8_LDB(B1, 0, 1); PG8_STAGE(PG8_SB(0, 0), b2, voffB);
            PG8_BAR; PG8_WAIT_L(0); PG8_MMA(0, 1, At, B1); PG8_BAR;
            PG8_LDA(At, 0, 1); PG8_STAGE(PG8_SA(0, 0), a2, voffA);
            PG8_BAR; PG8_WAIT_L(0); PG8_MMA(1, 0, At, B0); PG8_BAR; PG8_SCHED;
            PG8_STAGE(PG8_SB(0, 1), b2 + hstep, voffB);
            PG8_WAIT_V(6); PG8_BAR; PG8_MMA(1, 1, At, B1); PG8_BAR;
            PG8_LDB(B0, 1, 0); PG8_SCHED; PG8_LDA(At, 1, 0); PG8_STAGE(PG8_SA(0, 1), a2 + hstep, voffA);
            PG8_WAIT_L(8); PG8_BAR; PG8_WAIT_L(0); PG8_MMA(0, 0, At, B0); PG8_BAR; PG8_SCHED;
            PG8_LDB(B1, 1, 1); PG8_STAGE(PG8_SB(1, 0), b3, voffB);
            PG8_BAR; PG8_WAIT_L(0); PG8_MMA(0, 1, At, B1); PG8_BAR;
            PG8_LDA(At, 1, 1); PG8_STAGE(PG8_SA(1, 0), a3, voffA);
            PG8_BAR; PG8_WAIT_L(0); PG8_MMA(1, 0, At, B0); PG8_BAR; PG8_SCHED;
            PG8_STAGE(PG8_SB(1, 1), b3 + hstep, voffB);
            PG8_WAIT_V(6); PG8_BAR; PG8_MMA(1, 1, At, B1); PG8_BAR;
        }
        E(acc, cur, wr, wc, fr, fq);
        if (!has_next) break;
#pragma unroll
        for (int a = 0; a < 2; ++a)
#pragma unroll
            for (int b = 0; b < 2; ++b)
#pragma unroll
                for (int m = 0; m < 4; ++m)
#pragma unroll
                    for (int n = 0; n < 2; ++n) acc[a][b][m][n] = (f32x4){0.f, 0.f, 0.f, 0.f};
        cur = nxt; cA = nA; cB = nB; ++ui;
    }
    PG8_WAIT_V(0);
    if (wr == 0) PG8_BAR;
    PG8_BAR;
#undef PG8_SA
#undef PG8_SB
#undef PG8_STAGE
#undef PG8_LDA
#undef PG8_LDB
#undef PG8_MMA
#undef PG8_WAIT_V
#undef PG8_WAIT_L
#undef PG8_BAR
#undef PG8_SCHED
}
}

struct ConvDesc { const float* src; bf16_t* dst; int K, N, ldk, nblk, nmul, noff, nmat; long sstride, dstride; };
__device__ __forceinline__ void conv_wT(const ConvDesc& d, int bid, int nb, float* smem) {
    const int tid = otid();
    const int tk = d.K / 64, tn = d.N / 64, per = tk * tn;
    for (int u = bid; u < d.nmat * per; u += nb) {
        const int mat = u / per, t = u % per, kt = t / tn, ntl = t % tn;
        const float* s = d.src + (long)mat * d.sstride + (long)(kt * 64) * d.N + ntl * 64;
        __syncthreads();
#pragma unroll
        for (int ps = 0; ps < 2; ++ps) {
            const int kk = (tid >> 4) + ps * 32, n4 = (tid & 15) * 4;
            const float4 v = ld4(s + (long)kk * d.N + n4);
            smem[kk * 65 + n4 + 0] = v.x; smem[kk * 65 + n4 + 1] = v.y; smem[kk * 65 + n4 + 2] = v.z; smem[kk * 65 + n4 + 3] = v.w;
        }
        __syncthreads();
        const int n = tid >> 3, k8 = (tid & 7) * 8;
        u32x4 w;
        w.x = cvt_pk_bf16(smem[(k8 + 0) * 65 + n], smem[(k8 + 1) * 65 + n]); w.y = cvt_pk_bf16(smem[(k8 + 2) * 65 + n], smem[(k8 + 3) * 65 + n]);
        w.z = cvt_pk_bf16(smem[(k8 + 4) * 65 + n], smem[(k8 + 5) * 65 + n]); w.w = cvt_pk_bf16(smem[(k8 + 6) * 65 + n], smem[(k8 + 7) * 65 + n]);
        const int gn = ntl * 64 + n, drow = (gn / d.nblk) * d.nmul + d.noff + gn % d.nblk;
        *(u32x4*)(d.dst + (long)mat * d.dstride + (long)drow * d.ldk + kt * 64 + k8) = w;
    }
}

__device__ __forceinline__ void ph_prologue(const Params& p, int bid, int nb, float* smem) {
    const int tid = otid();
    {
        const long n4 = (long)R * D / 4, nl4 = (long)NLAT * D / 4;
        for (long i = (long)bid * NTH + tid; i < n4; i += (long)nb * NTH) {
            float4 v = (i < nl4) ? ld4(p.x + i * 4) : ld4(p.ctx + (i - nl4) * 4);
            st4(p.xc + i * 4, v);
        }
    }
    {
        const ConvDesc c_in{p.w_in, p.WinT, D, INC, D, 1 << 30, 0, 0, DEPTH, (long)D * INC, (long)INP * D};
        conv_wT(c_in, bid, nb, smem);
        const ConvDesc c_out{p.w_out, p.WoutT, D, D, D, 1 << 30, 0, 0, DEPTH, (long)D * D, (long)D * D};
        conv_wT(c_out, bid, nb, smem);
        const ConvDesc c_uq{p.w_uq, p.WuqT, 384, 768, 384, 1 << 30, 0, 0, DEPTH, 384L * 768, 768L * 384};
        conv_wT(c_uq, bid, nb, smem);
        const ConvDesc c_ukv{p.w_ukv, p.WukvT, 128, 1024, 256, 1 << 30, 0, 0, DEPTH, 128L * 1024, 1024L * 256};
        conv_wT(c_ukv, bid, nb, smem);
        const ConvDesc c_w1{p.w1, p.W13T, D, FF, D, 128, 256, 0, DEPTH * NEXP, (long)D * FF, 1024L * D};
        conv_wT(c_w1, bid, nb, smem);
        const ConvDesc c_w3{p.w3, p.W13T, D, FF, D, 128, 256, 128, DEPTH * NEXP, (long)D * FF, 1024L * D};
        conv_wT(c_w3, bid, nb, smem);
        const ConvDesc c_w2{p.w2, p.W2T, FF, D, FF, 1 << 30, 0, 0, DEPTH * NEXP, (long)FF * D, (long)D * FF};
        conv_wT(c_w2, bid, nb, smem);
        const u32x4 z = {0u, 0u, 0u, 0u};
        for (long i = (long)bid * NTH + tid; i < (long)DEPTH * (INP - INC) * D / 8; i += (long)nb * NTH) {
            const long per = (long)(INP - INC) * D / 8; const int l = (int)(i / per); const long o = i % per;
            *(u32x4*)(p.WinT + (long)l * INP * D + (long)INC * D + o * 8) = z;
        }
        for (long i = (long)bid * NTH + tid; i < (long)DEPTH * 1024 * 16; i += (long)nb * NTH) {
            const long row = i / 16; const int c8 = (int)(i % 16) * 8;
            *(u32x4*)(p.WukvT + row * 256 + 128 + c8) = z;
        }
    }
    for (int u = bid; u < DEPTH * 24; u += nb) {
        const int l = u / 24, jb = u % 24;
        __syncthreads();
        for (int i = tid; i < 3 * D; i += NTH) {
            const int r = i / D, k = i % D;
            const float cv = (r < 2) ? p.c[r * D + k] : p.c_ctx[k];
            smem[i] = siluf(cv);
        }
        __syncthreads();
        const int j = jb * NTH + tid;
        const float* w = p.w_ada + (long)l * D * (6 * D) + j;
        float a0 = 0.f, a1 = 0.f, a2 = 0.f;
#pragma unroll 8
        for (int k = 0; k < D; ++k) {
            const float wv = w[(long)k * (6 * D)];
            a0 = fmaf(smem[k], wv, a0); a1 = fmaf(smem[D + k], wv, a1); a2 = fmaf(smem[2 * D + k], wv, a2);
        }
        const float bv = p.b_ada[l * 6 * D + j];
        float* mv = p.modv + (long)l * 3 * 6 * D;
        mv[0 * 6 * D + j] = a0 + bv; mv[1 * 6 * D + j] = a1 + bv; mv[2 * 6 * D + j] = a2 + bv;
    }
}

struct Row { float4 v[8]; };
__device__ __forceinline__ void row_load(Row& r, const float* p, int lane) {
#pragma unroll
    for (int i = 0; i < 8; ++i) r.v[i] = ld4(p + (i * 64 + lane) * 4);
}
__device__ __forceinline__ void row_store(const Row& r, float* p, int lane) {
#pragma unroll
    for (int i = 0; i < 8; ++i) st4(p + (i * 64 + lane) * 4, r.v[i]);
}
__device__ __forceinline__ void row_store_bf16(const Row& r, bf16_t* p, int lane) {
#pragma unroll
    for (int i = 0; i < 8; ++i) { u32x2 w; w.x = cvt_pk_bf16(r.v[i].x, r.v[i].y); w.y = cvt_pk_bf16(r.v[i].z, r.v[i].w); *(u32x2*)(p + (i * 64 + lane) * 4) = w; }
}
__device__ __forceinline__ void row_stats(const Row& r, float& mean, float& rstd) {
    float s = 0.f;
#pragma unroll
    for (int i = 0; i < 8; ++i) s += (r.v[i].x + r.v[i].y) + (r.v[i].z + r.v[i].w);
    mean = wsum(s) * (1.0f / D);
    float q = 0.f;
#pragma unroll
    for (int i = 0; i < 8; ++i) { const float a = r.v[i].x - mean, b = r.v[i].y - mean, c = r.v[i].z - mean, d = r.v[i].w - mean; q += (a * a + b * b) + (c * c + d * d); }
    rstd = rsqrtf(wsum(q) * (1.0f / D) + EPS);
}
__device__ __forceinline__ void row_modulate(Row& r, float mean, float rstd, const float* sh, const float* sc, int lane) {
#pragma unroll
    for (int i = 0; i < 8; ++i) {
        const int c = (i * 64 + lane) * 4;
        const float4 s = ld4(sc + c), h = ld4(sh + c);
        r.v[i].x = (r.v[i].x - mean) * rstd * (1.f + s.x) + h.x; r.v[i].y = (r.v[i].y - mean) * rstd * (1.f + s.y) + h.y;
        r.v[i].z = (r.v[i].z - mean) * rstd * (1.f + s.z) + h.z; r.v[i].w = (r.v[i].w - mean) * rstd * (1.f + s.w) + h.w;
    }
}
__device__ __forceinline__ void row_affine(Row& r, float mean, float rstd, const float* g, const float* b, int lane) {
#pragma unroll
    for (int i = 0; i < 8; ++i) {
        const int c = (i * 64 + lane) * 4;
        const float4 s = ld4(g + c), h = ld4(b + c);
        r.v[i].x = (r.v[i].x - mean) * rstd * s.x + h.x; r.v[i].y = (r.v[i].y - mean) * rstd * s.y + h.y;
        r.v[i].z = (r.v[i].z - mean) * rstd * s.z + h.z; r.v[i].w = (r.v[i].w - mean) * rstd * s.w + h.w;
    }
}

__device__ __forceinline__ void ph_lnmod(const Params& p, int l, int bid, int nb) {
    const int tid = otid(), lane = tid & 63, wid = tid >> 6;
    for (int r = bid * NWV + wid; r < R; r += nb * NWV) {
        Row x; row_load(x, p.xc + (long)r * D, lane);
        float mean, rstd; row_stats(x, mean, rstd);
        const float* mv = p.modv + ((long)l * 3 + mod_row(r)) * 6 * D;
        row_modulate(x, mean, rstd, mv + 0 * D, mv + 1 * D, lane);
        row_store_bf16(x, p.hb + (long)r * D, lane);
    }
}

__device__ __forceinline__ void ph_prep(const Params& p, int l, int bid, int nb) {
    const int tid = otid(), lane = tid & 63, wid = tid >> 6;
    for (int r = bid * NWV + wid; r < R; r += nb * NWV) {
        float* pr = p.P + (long)r * INC;
        if (r < NLAT) {
            const int t = r % T; const float rowi = (float)(t / 64), coli = (float)(t % 64);
            {
                const int f = lane & 31;
                const float inv = powf(10000.0f, -(float)f / 32.0f);
                const float ang = (lane < 32 ? rowi : coli) * inv;
                float sn, cs; sincosf(ang, &sn, &cs);
#pragma unroll
                for (int h = 0; h < 6; ++h) {
                    float* q = pr + SQ + h * 128;
                    const float x1 = q[lane], x2 = q[lane + 64];
                    q[lane] = x1 * cs - x2 * sn; q[lane + 64] = x2 * cs + x1 * sn;
                }
            }
            if (lane < 32) {
                const int f = lane & 15;
                const float inv = powf(10000.0f, -(float)f / 16.0f);
                const float ang = (lane < 16 ? rowi : coli) * inv;
                float sn, cs; sincosf(ang, &sn, &cs);
                float* q = pr + KR;
                const float x1 = q[lane], x2 = q[lane + 32];
                q[lane] = x1 * cs - x2 * sn; q[lane + 32] = x2 * cs + x1 * sn;
            }
        }
        {
            float v[6]; float s = 0.f;
#pragma unroll
            for (int i = 0; i < 6; ++i) { v[i] = pr[CQ + i * 64 + lane]; s += v[i] * v[i]; }
            const float rs = rsqrtf(wsum(s) * (1.0f / 384.0f) + EPS);
#pragma unroll
            for (int i = 0; i < 6; ++i) p.cqn[(long)r * 384 + i * 64 + lane] = f2bf(v[i] * rs * p.q_norm[l * 384 + i * 64 + lane]);
            const float a = pr[CKV + lane], b = pr[CKV + 64 + lane];
            const float rs2 = rsqrtf(wsum(a * a + b * b) * (1.0f / 128.0f) + EPS);
            p.ckvn[(long)r * 256 + lane] = f2bf(a * rs2 * p.kv_norm[l * 128 + lane]);
            p.ckvn[(long)r * 256 + 64 + lane] = f2bf(b * rs2 * p.kv_norm[l * 128 + 64 + lane]);
            p.ckvn[(long)r * 256 + 128 + lane] = 0; p.ckvn[(long)r * 256 + 192 + lane] = 0;
        }
    }
}

#define OSM_UPDATE(S, M_, L_, A0, A1, V0, V1) do { const float mn_ = fmaxf(M_, S); const float cr_ = expf(M_ - mn_); const float pp_ = expf((S) - mn_); \
    L_ = L_ * cr_ + pp_; A0 = A0 * cr_ + pp_ * (V0); A1 = A1 * cr_ + pp_ * (V1); M_ = mn_; } while (0)

__device__ __forceinline__ void swa_task(const Params& p, int l, int h, int r0, int lane) {
    constexpr int QW = 4;
    const float scale = 0.08838834764831845f;
    const bool lat = r0 < NLAT;
    const int b = lat ? r0 / T : (r0 - NLAT) / LCTX;
    const int kvh = h >> 1;
    float q0[QW], q1[QW], m[QW], ls[QW], a0[QW], a1[QW];
#pragma unroll
    for (int i = 0; i < QW; ++i) {
        const float* q = p.P + (long)(r0 + i) * INC + SQ + h * 128;
        q0[i] = q[lane] * scale; q1[i] = q[lane + 64] * scale; m[i] = -INFINITY; ls[i] = 0.f; a0[i] = 0.f; a1[i] = 0.f;
    }
    for (int j = 0; j < LCTX; ++j) {
        const float* kp = p.P + (long)(NLAT + b * LCTX + j) * INC;
        const float k0 = kp[SK + kvh * 128 + lane], k1 = kp[SK + kvh * 128 + 64 + lane];
        const float v0 = kp[SV + kvh * 128 + lane], v1 = kp[SV + kvh * 128 + 64 + lane];
#pragma unroll
        for (int i = 0; i < QW; ++i) { const float s = wsum(q0[i] * k0 + q1[i] * k1); OSM_UPDATE(s, m[i], ls[i], a0[i], a1[i], v0, v1); }
    }
    if (lat) {
        const int t0 = r0 % T;
        const int lo = (t0 - 128) < 0 ? 0 : (t0 - 128), hi = (t0 + QW - 1 + 128) > (T - 1) ? (T - 1) : (t0 + QW - 1 + 128);
        for (int tk = lo; tk <= hi; ++tk) {
            const float* kp = p.P + (long)(b * T + tk) * INC;
            const float k0 = kp[SK + kvh * 128 + lane], k1 = kp[SK + kvh * 128 + 64 + lane];
            const float v0 = kp[SV + kvh * 128 + lane], v1 = kp[SV + kvh * 128 + 64 + lane];
#pragma unroll
            for (int i = 0; i < QW; ++i) {
                const int d = tk - (t0 + i);
                if (d >= -128 && d <= 128) { const float s = wsum(q0[i] * k0 + q1[i] * k1); OSM_UPDATE(s, m[i], ls[i], a0[i], a1[i], v0, v1); }
            }
        }
    }
    const float sk = p.swa_sink[l * 4 + h];
#pragma unroll
    for (int i = 0; i < QW; ++i) {
        OSM_UPDATE(sk, m[i], ls[i], a0[i], a1[i], 0.f, 0.f);
        bf16_t* o = p.mix + (long)(r0 + i) * D + h * 128;
        const float il = 1.0f / ls[i];
        o[lane] = f2bf(a0[i] * il); o[lane + 64] = f2bf(a1[i] * il);
    }
}

__device__ __forceinline__ void mla_task(const Params& p, int h, int r0, int lane) {
    constexpr int QW = 8;
    const float scale = 0.07216878364870323f;
    const bool lat = r0 < NLAT;
    const int b = lat ? r0 / T : (r0 - NLAT) / LCTX;
    float q0[QW], q1[QW], q2[QW], m[QW], ls[QW], a0[QW], a1[QW];
#pragma unroll
    for (int i = 0; i < QW; ++i) {
        const float* q = p.Q2 + (long)(r0 + i) * 768 + h * 192;
        q0[i] = q[lane] * scale; q1[i] = q[lane + 64] * scale;
        float qr = q[128 + lane];
        if (lat) {
            const int t = (r0 + i) % T; const float rowi = (float)(t / 64), coli = (float)(t % 64);
            const int ii = lane & 31, f = ii & 15;
            const float inv = powf(10000.0f, -(float)f / 16.0f);
            const float ang = (ii < 16 ? rowi : coli) * inv;
            float sn, cs; sincosf(ang, &sn, &cs);
            const float other = __shfl_xor(qr, 32);
            qr = (lane < 32) ? (qr * cs - other * sn) : (qr * cs + other * sn);
        }
        q2[i] = qr * scale; m[i] = -INFINITY; ls[i] = 0.f; a0[i] = 0.f; a1[i] = 0.f;
    }
    const int nkeys = lat ? (LCTX + T) : LCTX;
    for (int j = 0; j < nkeys; ++j) {
        const int rk = (j < LCTX) ? (NLAT + b * LCTX + j) : (b * T + (j - LCTX));
        const float* kv = p.KV2 + (long)rk * 1024 + h * 256;
        const float k0 = kv[lane], k1 = kv[64 + lane], v0 = kv[128 + lane], v1 = kv[192 + lane];
        const float k2 = p.P[(long)rk * INC + KR + lane];
#pragma unroll
        for (int i = 0; i < QW; ++i) { const float s = wsum(q0[i] * k0 + q1[i] * k1 + q2[i] * k2); OSM_UPDATE(s, m[i], ls[i], a0[i], a1[i], v0, v1); }
    }
#pragma unroll
    for (int i = 0; i < QW; ++i) {
        bf16_t* o = p.mix + (long)(r0 + i) * D + 1024 + h * 128;
        const float il = 1.0f / ls[i];
        o[lane] = f2bf(a0[i] * il); o[lane + 64] = f2bf(a1[i] * il);
    }
}

__device__ __forceinline__ void scan_unit(const Params& p, int l, int u, float* smem) {
    const int tid = otid();
    const int dir = u & 1, h = (u >> 1) & 3, b = (u >> 3) & 1, mixer = u >> 4;
    const int j = tid & 127, part = tid >> 7;
    float* sq = smem;
    float* sk = smem + 2048;
    float* sf = smem + 4096;
    float* op = smem + 6144;
    float S[32];
#pragma unroll
    for (int i = 0; i < 32; ++i) S[i] = 0.f;
    float gam = 1.f, lbv[4] = {0.f, 0.f, 0.f, 0.f};
    if (mixer == 0) gam = 1.0f - exp2f(-p.ret_s[(l * 2 + dir) * 4 + h]);
    else if (l > 0) {
#pragma unroll
        for (int e = 0; e < 4; ++e) {
            const int i = (tid + e * NTH) & 127;
            const float l0 = p.lb_logits[(0 * 2 + dir) * 512 + h * 128 + i], l1 = p.lb_logits[(1 * 2 + dir) * 512 + h * 128 + i];
            const float mx = fmaxf(l0, l1), e0 = expf(l0 - mx), e1 = expf(l1 - mx);
            lbv[e] = e1 / (e0 + e1);
        }
    }
    const int voff = (mixer == 0 ? RV : HI) + h * 128 + j;
    float* outp = p.oscan + ((long)(mixer * 2 + dir) * R) * 512 + h * 128 + j;
    for (int p0 = 0; p0 < LCTX + T; p0 += 16) {
        __syncthreads();
#pragma unroll
        for (int e = 0; e < 4; ++e) {
            const int idx = tid + e * NTH, s = idx >> 7, i = idx & 127;
            const int pos = p0 + s;
            int row;
            if (pos < LCTX) row = NLAT + b * LCTX + (dir ? (LCTX - 1 - pos) : pos);
            else { const int t = pos - LCTX; row = b * T + (dir ? (T - 1 - t) : t); }
            const float* pr = p.P + (long)row * INC;
            float qv, kv, fv;
            if (mixer == 0) { qv = pr[RQ + h * 128 + i]; kv = pr[RK + h * 128 + i] * 0.08838834764831845f; fv = gam; }
            else {
                qv = siluf(pr[HQ + h * 128 + i]);
                const float z = pr[(dir ? HFB : HFF) + h * 128 + i];
                const float lb = lbv[e];
                fv = lb + (1.0f - lb) * sigmf(z); kv = 1.0f - fv;
            }
            sq[idx] = qv; sk[idx] = kv; sf[idx] = fv;
        }
        float vv[16];
#pragma unroll
        for (int s = 0; s < 16; ++s) {
            const int pos = p0 + s;
            int row;
            if (pos < LCTX) row = NLAT + b * LCTX + (dir ? (LCTX - 1 - pos) : pos);
            else { const int t = pos - LCTX; row = b * T + (dir ? (T - 1 - t) : t); }
            vv[s] = p.P[(long)row * INC + voff];
        }
        __syncthreads();
#pragma unroll
        for (int s = 0; s < 16; ++s) {
            float o = 0.f;
            const float v = vv[s];
#pragma unroll
            for (int i4 = 0; i4 < 8; ++i4) {
                const float4 f4 = ld4(sf + s * 128 + part * 32 + i4 * 4), k4 = ld4(sk + s * 128 + part * 32 + i4 * 4), q4 = ld4(sq + s * 128 + part * 32 + i4 * 4);
                S[i4 * 4 + 0] = fmaf(f4.x, S[i4 * 4 + 0], k4.x * v); o = fmaf(S[i4 * 4 + 0], q4.x, o);
                S[i4 * 4 + 1] = fmaf(f4.y, S[i4 * 4 + 1], k4.y * v); o = fmaf(S[i4 * 4 + 1], q4.y, o);
                S[i4 * 4 + 2] = fmaf(f4.z, S[i4 * 4 + 2], k4.z * v); o = fmaf(S[i4 * 4 + 2], q4.z, o);
                S[i4 * 4 + 3] = fmaf(f4.w, S[i4 * 4 + 3], k4.w * v); o = fmaf(S[i4 * 4 + 3], q4.w, o);
            }
            op[(part * 16 + s) * 128 + j] = o;
        }
        __syncthreads();
#pragma unroll
        for (int e = 0; e < 4; ++e) {
            const int idx = tid + e * NTH, s = idx >> 7, jj = idx & 127;
            const int pos = p0 + s;
            int row;
            if (pos < LCTX) row = NLAT + b * LCTX + (dir ? (LCTX - 1 - pos) : pos);
            else { const int t = pos - LCTX; row = b * T + (dir ? (T - 1 - t) : t); }
            const float o = (op[(0 * 16 + s) * 128 + jj] + op[(1 * 16 + s) * 128 + jj]) + (op[(2 * 16 + s) * 128 + jj] + op[(3 * 16 + s) * 128 + jj]);
            p.oscan[((long)(mixer * 2 + dir) * R + row) * 512 + h * 128 + jj] = o;
        }
    }
    (void)outp;
}

__device__ __forceinline__ void ph_mixers(const Params& p, int l, int bid, int nb, float* smem) {
    const bool need_ctx = l < DEPTH - 1;
    if (bid < 32) { scan_unit(p, l, bid, smem); return; }
    const int tid = otid(), lane = tid & 63, wid = tid >> 6;
    const int nrows = need_ctx ? R : NLAT;
    const int n_mla = (nrows / 8) * 4, n_swa = (nrows / 4) * 4;
    for (int t = (bid - 32) * NWV + wid; t < n_mla + n_swa; t += (nb - 32) * NWV) {
        if (t < n_mla) mla_task(p, t & 3, (t >> 2) * 8, lane);
        else { const int s = t - n_mla; swa_task(p, l, s & 3, (s >> 2) * 4, lane); }
    }
}

__device__ __forceinline__ void ph_mixpost(const Params& p, int l, int bid, int nb) {
    const int tid = otid(), lane = tid & 63, wid = tid >> 6;
    for (int r = bid * NWV + wid; r < R; r += nb * NWV) {
        const float* pr = p.P + (long)r * INC;
#pragma unroll
        for (int h = 0; h < 4; ++h) {
            {
                const float* o0 = p.oscan + ((long)(0 * 2 + 0) * R + r) * 512 + h * 128;
                const float* o1 = p.oscan + ((long)(0 * 2 + 1) * R + r) * 512 + h * 128;
                const float a = o0[lane] + o1[lane], b = o0[lane + 64] + o1[lane + 64];
                const float mean = wsum(a + b) * (1.0f / 128.0f);
                const float da = a - mean, db = b - mean;
                const float rstd = rsqrtf(wsum(da * da + db * db) * (1.0f / 128.0f) + EPS);
                const int c = h * 128 + lane;
                p.mix[(long)r * D + 512 + c] = f2bf(siluf(pr[RG + c]) * (da * rstd * p.ret_gn[l * 512 + c]));
                p.mix[(long)r * D + 512 + c + 64] = f2bf(siluf(pr[RG + c + 64]) * (db * rstd * p.ret_gn[l * 512 + c + 64]));
            }
            {
                const float* o0 = p.oscan + ((long)(1 * 2 + 0) * R + r) * 512 + h * 128;
                const float* o1 = p.oscan + ((long)(1 * 2 + 1) * R + r) * 512 + h * 128;
                const float a = o0[lane] + o1[lane], b = o0[lane + 64] + o1[lane + 64];
                const float rs = rsqrtf(wsum(a * a + b * b) * (1.0f / 128.0f) + EPS);
                const int c = h * 128 + lane;
                p.mix[(long)r * D + 1536 + c] = f2bf(siluf(pr[HG + c]) * (a * rs * p.hgrn_gn[l * 512 + c]));
                p.mix[(long)r * D + 1536 + c + 64] = f2bf(siluf(pr[HG + c + 64]) * (b * rs * p.hgrn_gn[l * 512 + c + 64]));
            }
        }
    }
}

__device__ __forceinline__ void ph_post1(const Params& p, int l, int bid, int nb, float* smem) {
    const int tid = otid(), lane = tid & 63, wid = tid >> 6;
    const int nrows = (l < DEPTH - 1) ? R : NLAT;
    for (int r = bid * NWV + wid; r < nrows; r += nb * NWV) {
        const float* mv = p.modv + ((long)l * 3 + mod_row(r)) * 6 * D;
        Row x, o; row_load(x, p.xc + (long)r * D, lane); row_load(o, p.ob + (long)r * D, lane);
#pragma unroll
        for (int i = 0; i < 8; ++i) {
            const float4 g = ld4(mv + 2 * D + (i * 64 + lane) * 4);
            x.v[i].x = ALPHA * x.v[i].x + g.x * o.v[i].x; x.v[i].y = ALPHA * x.v[i].y + g.y * o.v[i].y;
            x.v[i].z = ALPHA * x.v[i].z + g.z * o.v[i].z; x.v[i].w = ALPHA * x.v[i].w + g.w * o.v[i].w;
        }
        float mean, rstd; row_stats(x, mean, rstd);
        row_affine(x, mean, rstd, p.ln1_g + l * D, p.ln1_b + l * D, lane);
        row_store(x, p.xc + (long)r * D, lane);
        row_stats(x, mean, rstd);
        row_modulate(x, mean, rstd, mv + 3 * D, mv + 4 * D, lane);
        row_store_bf16(x, p.hb + (long)r * D, lane);
        float* hrow = smem + wid * D;
#pragma unroll
        for (int i = 0; i < 8; ++i) st4(hrow + (i * 64 + lane) * 4, x.v[i]);
        asm volatile("s_waitcnt lgkmcnt(0)" ::: "memory");
        float acc = 0.f;
        if (lane < 36) {
            const float* wp = (lane < 32) ? (p.w_re + (long)l * D * 32 + lane) : (p.w_rg + (long)l * D * 4 + (lane - 32));
            const int wst = (lane < 32) ? 32 : 4;
#pragma unroll 8
            for (int k = 0; k < D; ++k) acc = fmaf(hrow[k], wp[(long)k * wst], acc);
        }
        asm volatile("" ::: "memory");
        float lg[4], le[32];
#pragma unroll
        for (int g = 0; g < 4; ++g) lg[g] = __shfl(acc, 32 + g);
#pragma unroll
        for (int e = 0; e < 32; ++e) le[e] = __shfl(acc, e);
        int grp = 0; float gm = lg[0];
#pragma unroll
        for (int g = 1; g < 4; ++g) if (lg[g] > gm) { gm = lg[g]; grp = g; }
        float zs = 0.f;
#pragma unroll
        for (int g = 0; g < 4; ++g) zs += expf(lg[g] - gm);
        const float pgrp = 1.0f / zs;
        float ev[8];
#pragma unroll
        for (int e = 0; e < 8; ++e) { ev[e] = (grp == 0) ? le[e] : (grp == 1) ? le[8 + e] : (grp == 2) ? le[16 + e] : le[24 + e]; }
        int i0 = 0; float v0 = ev[0];
#pragma unroll
        for (int e = 1; e < 8; ++e) if (ev[e] > v0) { v0 = ev[e]; i0 = e; }
        int i1 = -1; float v1 = -INFINITY;
#pragma unroll
        for (int e = 0; e < 8; ++e) if (e != i0 && ev[e] > v1) { v1 = ev[e]; i1 = e; }
        const float e1 = expf(v1 - v0);
        const float g0 = pgrp / (1.0f + e1), g1 = pgrp * e1 / (1.0f + e1);
        if (lane == 0) {
            p.eid[r * 2 + 0] = grp * 8 + i0; p.eid[r * 2 + 1] = grp * 8 + i1;
            p.gate[r * 2 + 0] = g0; p.gate[r * 2 + 1] = g1;
        }
    }
}

__device__ __forceinline__ void ph_sort(const Params& p, int l, int bid, int* smem) {
    if (bid != 0) return;
    const int tid = otid(), lane = tid & 63, wid = tid >> 6;
    const int ntok = (l < DEPTH - 1) ? R : NLAT;
    const int nch = ntok / 64;
    int* cnt = smem;
    int* pst = smem + 136 * 32;
    int* tot = pst + 32;
    for (int i = tid; i < NSLOT; i += NTH) p.slot_tok[i] = -1;
    for (int c = wid; c < nch; c += NWV) {
        const int t = c * 64 + lane;
        const int e0 = p.eid[t * 2], e1 = p.eid[t * 2 + 1];
        for (int e = 0; e < 32; ++e) {
            const unsigned long long mk = __ballot(e0 == e || e1 == e);
            if (lane == 0) cnt[c * 32 + e] = __popcll(mk);
        }
    }
    __threadfence_block();
    __syncthreads();
    if (tid < 32) {
        int run = 0;
        for (int c = 0; c < nch; ++c) { const int v = cnt[c * 32 + tid]; cnt[c * 32 + tid] = run; run += v; }
        tot[tid] = run;
    }
    __syncthreads();
    if (tid == 0) {
        int ps = 0;
        for (int e = 0; e < 32; ++e) { pst[e] = ps; ps += (tot[e] + 255) / 256 * 256; }
        p.tile_e[NTILE] = ps / 256;
        int e = 0;
        for (int b = 0; b < NTILE; ++b) {
            const int s = b * 256;
            while (e < 32 && s >= pst[e] + (tot[e] + 255) / 256 * 256) ++e;
            p.tile_e[b] = (e < 32) ? e : -1;
        }
    }
    __syncthreads();
    for (int c = wid; c < nch; c += NWV) {
        const int t = c * 64 + lane;
        const int e0 = p.eid[t * 2], e1 = p.eid[t * 2 + 1];
        for (int e = 0; e < 32; ++e) {
            const unsigned long long mk = __ballot(e0 == e || e1 == e);
            const int rank = __popcll(mk & ((1ull << lane) - 1ull));
            if (e0 == e || e1 == e) {
                const int slot = pst[e] + cnt[c * 32 + e] + rank;
                p.slot_tok[slot] = t;
                p.slot_of[t * 2 + (e1 == e ? 1 : 0)] = slot;
            }
        }
    }
}

__device__ __forceinline__ void ph_gather(const Params& p, int bid, int nb) {
    const int tid = otid(), lane = tid & 63, wid = tid >> 6;
    const int nslots = p.tile_e[NTILE] * 256;
    for (int s0 = bid * NWV + wid; s0 < nslots; s0 += nb * NWV) {
        const int src = p.slot_tok[s0];
        u32x4* d = (u32x4*)(p.xs + (long)s0 * D);
        if (src >= 0) { const u32x4* sp = (const u32x4*)(p.hb + (long)src * D);
#pragma unroll
            for (int i = 0; i < 4; ++i) d[i * 64 + lane] = sp[i * 64 + lane]; }
        else { const u32x4 z = {0u, 0u, 0u, 0u};
#pragma unroll
            for (int i = 0; i < 4; ++i) d[i * 64 + lane] = z; }
    }
}

__device__ __forceinline__ void ph_post2(const Params& p, int l, int bid, int nb) {
    const int tid = otid(), lane = tid & 63, wid = tid >> 6;
    const int nrows = (l < DEPTH - 1) ? R : NLAT;
    for (int r = bid * NWV + wid; r < nrows; r += nb * NWV) {
        const float* mv = p.modv + ((long)l * 3 + mod_row(r)) * 6 * D;
        const int s0 = p.slot_of[r * 2], s1 = p.slot_of[r * 2 + 1];
        const float g0 = p.gate[r * 2], g1 = p.gate[r * 2 + 1];
        Row x, y0, y1; row_load(x, p.xc + (long)r * D, lane); row_load(y0, p.Ys + (long)s0 * D, lane); row_load(y1, p.Ys + (long)s1 * D, lane);
#pragma unroll
        for (int i = 0; i < 8; ++i) {
            const float4 g = ld4(mv + 5 * D + (i * 64 + lane) * 4);
            x.v[i].x = ALPHA * x.v[i].x + g.x * (g0 * y0.v[i].x + g1 * y1.v[i].x); x.v[i].y = ALPHA * x.v[i].y + g.y * (g0 * y0.v[i].y + g1 * y1.v[i].y);
            x.v[i].z = ALPHA * x.v[i].z + g.z * (g0 * y0.v[i].z + g1 * y1.v[i].z); x.v[i].w = ALPHA * x.v[i].w + g.w * (g0 * y0.v[i].w + g1 * y1.v[i].w);
        }
        float mean, rstd; row_stats(x, mean, rstd);
        row_affine(x, mean, rstd, p.ln2_g + l * D, p.ln2_b + l * D, lane);
        if (l == DEPTH - 1) row_store(x, p.out + (long)r * D, lane);
        else row_store(x, p.xc + (long)r * D, lane);
    }
}

constexpr int PH_PER_LAYER = 13, N_PHASES = 1 + DEPTH * PH_PER_LAYER;
constexpr int LDS_MAIN = 128 * 1024, LDS_BYTES = LDS_MAIN + 256;

__global__ void __launch_bounds__(NTH, 2) fwd(Params p) {
    extern __shared__ __attribute__((aligned(16))) unsigned char lds_raw[];
    float* smem = (float*)lds_raw;
    LAS unsigned char* ldsp = (LAS unsigned char*)lds_raw;
    const int bid = blockIdx.x, nb = gridDim.x;
    const int vcu = (nb % 8 == 0) ? (bid % 8) * (nb / 8) + bid / 8 : bid;
#if ONE_LAUNCH
    if (threadIdx.x == 0) *(uint4*)(lds_raw + LDS_MAIN) = make_uint4(0u, 0u, 0u, 0u);
    __syncthreads();
    XcdBarrier bar = xcd_barrier_post(p.bar, (volatile LAS unsigned*)(ldsp + LDS_MAIN));
#define SEAM(k) do { if ((k) + 1 < p.ph_hi) xcd_barrier(bar); } while (0)
#else
#define SEAM(k) do { } while (0)
#endif
#define IN(k) (p.ph_lo <= (k) && (k) < p.ph_hi)
    if (IN(0)) { ph_prologue(p, bid, nb, smem); SEAM(0); }
    for (int l = 0; l < DEPTH; ++l) {
        const int k0 = 1 + l * PH_PER_LAYER;
        const int mrows = (l < DEPTH - 1) ? R : NLAT;
        if (IN(k0 + 0)) { ph_lnmod(p, l, bid, nb); SEAM(k0 + 0); }
        if (IN(k0 + 1)) {
            pg8::Gemm g{p.hb, p.WinT + (long)l * INP * D, R, INP, D}; pg8::StaticOrder S; S.init(R, INP, nb, bid);
            pg8::EpiF32 E{p.P, INC, INC};
            pg8::gemm_phase(ldsp, g, S, E); SEAM(k0 + 1);
        }
        if (IN(k0 + 2)) { ph_prep(p, l, bid, nb); SEAM(k0 + 2); }
        if (IN(k0 + 3)) {
            { pg8::Gemm g{p.cqn, p.WuqT + (long)l * 768 * 384, R, 768, 384}; pg8::StaticOrder S; S.init(R, 768, nb, bid); pg8::EpiF32 E{p.Q2, 768, 768}; pg8::gemm_phase(ldsp, g, S, E); }
            { pg8::Gemm g{p.ckvn, p.WukvT + (long)l * 1024 * 256, R, 1024, 256}; pg8::StaticOrder S; S.init(R, 1024, nb, bid); pg8::EpiF32 E{p.KV2, 1024, 1024}; pg8::gemm_phase(ldsp, g, S, E); }
            SEAM(k0 + 3);
        }
        if (IN(k0 + 4)) { ph_mixers(p, l, bid, nb, smem); SEAM(k0 + 4); }
        if (IN(k0 + 5)) { ph_mixpost(p, l, bid, nb); SEAM(k0 + 5); }
        if (IN(k0 + 6)) {
            pg8::Gemm g{p.mix, p.WoutT + (long)l * D * D, mrows, D, D}; pg8::StaticOrder S; S.init(mrows, D, nb, bid);
            pg8::EpiF32 E{p.ob, D, D};
            pg8::gemm_phase(ldsp, g, S, E); SEAM(k0 + 6);
        }
        if (IN(k0 + 7)) { ph_post1(p, l, bid, nb, smem); SEAM(k0 + 7); }
        if (IN(k0 + 8)) { ph_sort(p, l, bid, (int*)smem); SEAM(k0 + 8); }
        if (IN(k0 + 9)) { ph_gather(p, bid, nb); SEAM(k0 + 9); }
        if (IN(k0 + 10)) {
            pg8::Gemm g{p.xs, p.W13T + (long)l * NEXP * 1024 * D, NSLOT, 1024, D};
            pg8::MoeOrder S{4, p.tile_e[NTILE] * 4, nb, vcu, (size_t)1024 * D * 2, p.tile_e};
            pg8::EpiSwiglu E{p.act, FF};
            pg8::gemm_phase(ldsp, g, S, E); SEAM(k0 + 10);
        }
        if (IN(k0 + 11)) {
            pg8::Gemm g{p.act, p.W2T + (long)l * NEXP * D * FF, NSLOT, D, FF};
            pg8::MoeOrder S{8, p.tile_e[NTILE] * 8, nb, vcu, (size_t)D * FF * 2, p.tile_e};
            pg8::EpiF32 E{p.Ys, D, D};
            pg8::gemm_phase(ldsp, g, S, E); SEAM(k0 + 11);
        }
        if (IN(k0 + 12)) { ph_post2(p, l, bid, nb); SEAM(k0 + 12); }
    }
}

static inline size_t al256(size_t v) { return (v + 255) & ~(size_t)255; }

extern "C" void kernel_launch(void* const* d_in, const int* in_sizes, int n_in, void* d_out, int out_size, void* d_ws, size_t ws_size, hipStream_t stream) {
    static int grid = 0;
    if (grid == 0) {
        int dev = 0, cus = 0, per_cu = 0;
        hipGetDevice(&dev);
        hipDeviceGetAttribute(&cus, hipDeviceAttributeMultiprocessorCount, dev);
        hipFuncSetAttribute((const void*)fwd, hipFuncAttributeMaxDynamicSharedMemorySize, LDS_BYTES);
        hipOccupancyMaxActiveBlocksPerMultiprocessor(&per_cu, (const void*)fwd, NTH, LDS_BYTES);
        (void)hipGetLastError();
        if (cus <= 0) cus = 256;
        grid = cus;
        if (per_cu < 1) fprintf(stderr, "kernel_launch: occupancy query reports %d\n", per_cu);
    }
    Params p{};
    const float* const* in = (const float* const*)d_in;
    p.x = in[0]; p.c = in[1]; p.ctx = in[2]; p.c_ctx = in[3]; p.w_ada = in[4]; p.b_ada = in[5]; p.w_in = in[6]; p.swa_sink = in[7];
    p.ret_s = in[8]; p.ret_gn = in[9]; p.q_norm = in[10]; p.kv_norm = in[11]; p.w_uq = in[12]; p.w_ukv = in[13]; p.lb_logits = in[14];
    p.hgrn_gn = in[15]; p.w_out = in[16]; p.ln1_g = in[17]; p.ln1_b = in[18]; p.w_rg = in[19]; p.w_re = in[20]; p.w1 = in[21]; p.w3 = in[22];
    p.w2 = in[23]; p.ln2_g = in[24]; p.ln2_b = in[25];
    p.out = (float*)d_out;
    unsigned char* ws = (unsigned char*)d_ws; size_t off = 0;
    auto carve = [&](size_t bytes) { unsigned char* q = ws + off; off = al256(off + bytes); return q; };
    p.bar = (unsigned*)carve(XCD_BAR_WORDS * 4);
    p.modv = (float*)carve((size_t)DEPTH * 3 * 6 * D * 4);
    p.xc = (float*)carve((size_t)R * D * 4);
    p.hb = (bf16_t*)carve((size_t)R * D * 2);
    p.P = (float*)carve((size_t)R * INC * 4);
    p.Ys = p.P;
    p.cqn = (bf16_t*)carve((size_t)R * 384 * 2);
    p.ckvn = (bf16_t*)carve((size_t)R * 256 * 2);
    p.Q2 = (float*)carve((size_t)R * 768 * 4);
    p.KV2 = (float*)carve((size_t)R * 1024 * 4);
    p.oscan = (float*)carve((size_t)4 * R * 512 * 4);
    p.mix = (bf16_t*)carve((size_t)R * D * 2);
    p.ob = (float*)carve((size_t)R * D * 4);
    p.xs = (bf16_t*)carve((size_t)NSLOT * D * 2);
    p.act = (bf16_t*)carve((size_t)NSLOT * FF * 2);
    p.gate = (float*)carve((size_t)R * 2 * 4);
    p.eid = (int*)carve((size_t)R * 2 * 4);
    p.slot_of = (int*)carve((size_t)R * 2 * 4);
    p.slot_tok = (int*)carve((size_t)NSLOT * 4);
    p.tile_e = (int*)carve((size_t)(NTILE + 1) * 4);
    p.WinT = (bf16_t*)carve((size_t)DEPTH * INP * D * 2);
    p.WoutT = (bf16_t*)carve((size_t)DEPTH * D * D * 2);
    p.WuqT = (bf16_t*)carve((size_t)DEPTH * 768 * 384 * 2);
    p.WukvT = (bf16_t*)carve((size_t)DEPTH * 1024 * 256 * 2);
    p.W13T = (bf16_t*)carve((size_t)DEPTH * NEXP * 1024 * D * 2);
    p.W2T = (bf16_t*)carve((size_t)DEPTH * NEXP * D * FF * 2);
    if (off > ws_size) { fprintf(stderr, "kernel_launch: workspace too small: need %zu have %zu\n", off, ws_size); return; }
    hipMemsetAsync(p.bar, 0, XCD_BAR_WORDS * 4, stream);
#if ONE_LAUNCH
    p.ph_lo = 0; p.ph_hi = N_PHASES;
    hipLaunchKernelGGL(fwd, dim3(grid), dim3(NTH), LDS_BYTES, stream, p);
#else
    for (int k = 0; k < N_PHASES; ++k) {
        p.ph_lo = k; p.ph_hi = k + 1;
        hipLaunchKernelGGL(fwd, dim3(grid), dim3(NTH), LDS_BYTES, stream, p);
    }
#endif
}
```

```cpp
#include <hip/hip_runtime.h>
#include <cstdio>
#include <cstdint>

#ifndef DIAG_NAIVE
#define DIAG_NAIVE 0
#endif
#ifndef ONE_LAUNCH
#define ONE_LAUNCH 1
#endif

constexpr int D = 2048, NBATCH = 2, T = 4096, LCTX = 256, DEPTH = 2;
constexpr int NLAT = NBATCH * T, NCTX = NBATCH * LCTX, R = NLAT + NCTX;
constexpr int INC = 6208;
constexpr int SQ = 0, SK = 512, SV = 768, RQ = 1024, RK = 1536, RV = 2048, RG = 2560, CQ = 3072, CKV = 3456, KR = 3584,
              HQ = 3648, HFF = 4160, HFB = 4672, HI = 5184, HG = 5696;
constexpr int NEXP = 32, FF = 512;
constexpr int NSLOT = 25600, NTILE = NSLOT / 256;
constexpr int INP = 6400;
constexpr float EPS = 1e-6f;
constexpr float ALPHA = 1.41421356237309515f;
constexpr int NTH = 512, NWV = 8;

typedef float f32x16 __attribute__((ext_vector_type(16)));
typedef unsigned short bf16_t;
typedef short bf16x8 __attribute__((ext_vector_type(8)));
typedef float f32x4 __attribute__((ext_vector_type(4)));
typedef unsigned u32x4 __attribute__((ext_vector_type(4)));
typedef unsigned u32x2 __attribute__((ext_vector_type(2)));

#define XB_TMO      128
#define XB_XCNT(j)  (256  + 64 * (j))
#define XB_XSUB(j)  (1280 + 64 * (j))
#define XB_XGEN(j)  (2304 + 64 * (j))
#define XB_TOP      3328
#define XB_TOPGEN   3392
#define XCD_BAR_WORDS 3456
#define XB_SPIN_CAP (1u << 18)
#define LAS __attribute__((address_space(3)))

__device__ __forceinline__ unsigned xb_ld(unsigned* p)              { return __hip_atomic_load(p, __ATOMIC_RELAXED, __HIP_MEMORY_SCOPE_AGENT); }
__device__ __forceinline__ unsigned xb_add(unsigned* p, unsigned v) { return __hip_atomic_fetch_add(p, v, __ATOMIC_RELAXED, __HIP_MEMORY_SCOPE_AGENT); }
__device__ __forceinline__ unsigned xb_xcc_id() { return (unsigned)__builtin_amdgcn_s_getreg((3 << 11) | 20) & 0xFu; }
#define XB_SPIN(cond, bar) do { unsigned _sp = 0; while (cond) { __builtin_amdgcn_s_sleep(1); \
    if ((++_sp & 255u) == 0u) { if (xb_ld(&(bar)[XB_TMO])) break; if (_sp > XB_SPIN_CAP) { atomicAdd(&(bar)[XB_TMO], 1u); break; } } } } while (0)

struct XcdBarrier { unsigned* bar; unsigned x; volatile LAS unsigned* st; };

__device__ __forceinline__ XcdBarrier xcd_barrier_post(unsigned* bar, volatile LAS unsigned* st) {
    XcdBarrier b; b.bar = bar; b.x = xb_xcc_id(); b.st = st;
    if (threadIdx.x == 0) (void)xb_add(&bar[XB_XCNT(b.x)], 1u);
    return b;
}
__device__ __forceinline__ void xcd_barrier_complete(unsigned* bar, unsigned x, unsigned& nloc, unsigned& nx) {
    const unsigned G = gridDim.x * gridDim.y * gridDim.z;
    unsigned sum, cnt, mine, sp = 0u;
    for (;;) {
        sum = 0u; cnt = 0u; mine = 0u;
#pragma unroll
        for (unsigned j = 0; j < 16; ++j) { const unsigned c = xb_ld(&bar[XB_XCNT(j)]); sum += c; cnt += (c > 0u) ? 1u : 0u; mine = (j == x) ? c : mine; }
        if (sum == G) break;
        __builtin_amdgcn_s_sleep(1);
        if ((++sp & 255u) == 0u) { if (xb_ld(&bar[XB_TMO])) break; if (sp > XB_SPIN_CAP) { atomicAdd(&bar[XB_TMO], 1u); break; } }
    }
    nloc = mine > 0u ? mine : 1u; nx = cnt > 0u ? cnt : 1u;
}
__device__ __forceinline__ void xcd_barrier(const XcdBarrier& b) {
    asm volatile("s_waitcnt vmcnt(0)" ::: "memory");
    __syncthreads();
    if (threadIdx.x == 0) {
        unsigned* bar = b.bar;
        __builtin_amdgcn_s_waitcnt(0);
        unsigned nloc = b.st[0], nx = b.st[1];
        if (nloc == 0u) { xcd_barrier_complete(bar, b.x, nloc, nx); b.st[0] = nloc; b.st[1] = nx; }
        const unsigned old = xb_add(&bar[XB_XSUB(b.x)], 1u);
        const unsigned gen = old / nloc;
        if (old + 1u == (gen + 1u) * nloc) {
            __builtin_amdgcn_fence(__ATOMIC_RELEASE, "agent");
            asm volatile("s_waitcnt vmcnt(0)" ::: "memory");
            const unsigned og = xb_add(&bar[XB_TOP], 1u);
            const unsigned tg = og / nx;
            if (og + 1u == (tg + 1u) * nx) xb_add(&bar[XB_TOPGEN], 1u);
            else XB_SPIN(xb_ld(&bar[XB_TOPGEN]) == tg, bar);
            __builtin_amdgcn_fence(__ATOMIC_ACQUIRE, "agent");
            xb_add(&bar[XB_XGEN(b.x)], 1u);
            asm volatile("s_waitcnt vmcnt(0)" ::: "memory");
        } else {
            XB_SPIN(xb_ld(&bar[XB_XGEN(b.x)]) == gen, bar);
            __builtin_amdgcn_fence(__ATOMIC_ACQUIRE, "agent");
            asm volatile("s_waitcnt vmcnt(0)" ::: "memory");
        }
    }
    __syncthreads();
}

struct Params {
    const float *x, *c, *ctx, *c_ctx, *w_ada, *b_ada, *w_in, *swa_sink, *ret_s, *ret_gn, *q_norm, *kv_norm, *w_uq, *w_ukv,
                *lb_logits, *hgrn_gn, *w_out, *ln1_g, *ln1_b, *w_rg, *w_re, *w1, *w3, *w2, *ln2_g, *ln2_b;
    float* out;
    unsigned* bar;
    float *modv, *xc, *P, *oscan, *ob, *Ys, *gate;
    bf16_t *hb, *cqn, *ckvn, *mix, *xs, *act, *Q2b, *Kn, *VtM, *Krb, *sqb, *skb, *svT;
    bf16_t *WinT, *WoutT, *WuqT, *WukvT, *W13T, *W2T;
    int *eid, *slot_of, *slot_tok, *tile_e;
    int ph_lo, ph_hi;
};

__device__ __forceinline__ int otid() { int t = threadIdx.x; asm volatile("" : "+v"(t)); return t; }
__device__ __forceinline__ float wsum(float v) {
#pragma unroll
    for (int o = 32; o > 0; o >>= 1) v += __shfl_xor(v, o);
    return v;
}
__device__ __forceinline__ float siluf(float v) { return v / (1.0f + expf(-v)); }
__device__ __forceinline__ float sigmf(float v) { return 1.0f / (1.0f + expf(-v)); }
__device__ __forceinline__ int mod_row(int r) { return r < NLAT ? (r >= T ? 1 : 0) : 2; }
__device__ __forceinline__ float4 ld4(const float* p) { return *(const float4*)p; }
__device__ __forceinline__ bf16_t f2bf(float f) { unsigned u = __float_as_uint(f); u += 0x7FFFu + ((u >> 16) & 1u); return (bf16_t)(u >> 16); }
__device__ __forceinline__ unsigned cvt_pk_bf16(float lo, float hi) { unsigned r; asm volatile("v_cvt_pk_bf16_f32 %0, %1, %2" : "=v"(r) : "v"(lo), "v"(hi)); return r; }
__device__ __forceinline__ void st4(float* p, float4 v) { *(float4*)p = v; }

namespace pg8 {
constexpr int BM = 256, BK = 64, HALF = 128, HTB = HALF * BK * 2, STAGE_BYTES = 8 * HTB, NXCD = 8, WGM = 8;
__host__ __device__ __forceinline__ int lds_byte(int r, int c) { const int st = (r >> 4) * 2 + (c >> 5), rr = r & 15, cc = c & 31, ob = rr * 64 + cc * 2; return st * 1024 + (ob ^ (((ob >> 9) & 1) << 5)); }
__host__ __device__ __forceinline__ void stage_rc(int b, int& R, int& C) { const int st = b / 1024, sb = b % 1024, swz = sb ^ (((sb >> 9) & 1) << 5); R = (st >> 1) * 16 + swz / 64; C = (st & 1) * 32 + (swz % 64) / 2; }
struct Unit { int pm, pn; };
struct Gemm { const bf16_t* A; const bf16_t* Bt; int M, N, K; };
struct StaticOrder {
    int nM, nN, nwg, G, c;
    __device__ void init(int M, int N, int G_, int c_) { nM = M / BM; nN = N / BM; nwg = nM * nN; G = G_; c = c_; }
    __device__ bool next(int i, Unit& u) const {
        const long L = (long)i * G + c; if (L >= nwg) return false;
        int wgid = (int)L; { const int q = nwg / NXCD, r = nwg % NXCD, xcd = wgid % NXCD, off = wgid / NXCD; wgid = (xcd < r ? xcd * (q + 1) : r * (q + 1) + (xcd - r) * q) + off; }
        const int nig = WGM * nN, gid = wgid / nig, fm = gid * WGM, gsz = (nM - fm) < WGM ? (nM - fm) : WGM;
        u.pm = fm + ((wgid % nig) % gsz); u.pn = (wgid % nig) / gsz; return true;
    }
    __device__ __forceinline__ size_t boff(const Unit& u, size_t tstep) const { return (size_t)u.pn * tstep; }
};
struct MoeOrder {
    int npn, nunits, G, c; size_t estride; const int* tile_e;
    __device__ bool next(int i, Unit& u) const { const long L = (long)i * G + c; if (L >= nunits) return false; u.pm = (int)(L / npn); u.pn = (int)(L % npn); return true; }
    __device__ __forceinline__ size_t boff(const Unit& u, size_t tstep) const { return (size_t)tile_e[u.pm] * estride + (size_t)u.pn * tstep; }
};
struct EpiF32 {
    float* C; int ldc; int ncols;
    __device__ __forceinline__ void operator()(const f32x4 (&acc)[2][2][4][2], const Unit& u, int wr, int wc, int fr, int fq) const {
        const int row0 = u.pm * BM + wr * 64 + fr, col0 = u.pn * BM + wc * 32 + 4 * fq;
#pragma unroll
        for (int ai = 0; ai < 2; ++ai)
#pragma unroll
            for (int m = 0; m < 4; ++m) { float* rowp = C + (size_t)(row0 + ai * HALF + m * 16) * ldc + col0;
#pragma unroll
                for (int bj = 0; bj < 2; ++bj)
#pragma unroll
                    for (int n = 0; n < 2; ++n) if (col0 + bj * HALF + n * 16 < ncols) *(f32x4*)(rowp + bj * HALF + n * 16) = acc[ai][bj][m][n]; }
    }
};
struct EpiBf16 {
    bf16_t* O; int ldc;
    __device__ __forceinline__ void operator()(const f32x4 (&acc)[2][2][4][2], const Unit& u, int wr, int wc, int fr, int fq) const {
        const int row0 = u.pm * BM + wr * 64 + fr, col0 = u.pn * BM + wc * 32 + 4 * fq;
#pragma unroll
        for (int ai = 0; ai < 2; ++ai)
#pragma unroll
            for (int m = 0; m < 4; ++m) { bf16_t* rowp = O + (size_t)(row0 + ai * HALF + m * 16) * ldc + col0;
#pragma unroll
                for (int bj = 0; bj < 2; ++bj)
#pragma unroll
                    for (int n = 0; n < 2; ++n) { const f32x4 v = acc[ai][bj][m][n]; u32x2 w; w.x = cvt_pk_bf16(v[0], v[1]); w.y = cvt_pk_bf16(v[2], v[3]); *(u32x2*)(rowp + bj * HALF + n * 16) = w; } }
    }
};
struct EpiSwiglu {
    bf16_t* O; int ldc;
    __device__ __forceinline__ void operator()(const f32x4 (&acc)[2][2][4][2], const Unit& u, int wr, int wc, int fr, int fq) const {
        const int row0 = u.pm * BM + wr * 64 + fr, col0 = u.pn * HALF + wc * 32 + 4 * fq;
#pragma unroll
        for (int ai = 0; ai < 2; ++ai)
#pragma unroll
            for (int m = 0; m < 4; ++m) { bf16_t* rowp = O + (size_t)(row0 + ai * HALF + m * 16) * ldc + col0;
#pragma unroll
                for (int n = 0; n < 2; ++n) { const f32x4 g = acc[ai][0][m][n], v = acc[ai][1][m][n]; float r[4];
#pragma unroll
                    for (int j = 0; j < 4; ++j) r[j] = g[j] / (1.0f + __expf(-g[j])) * v[j];
                    u32x2 w; w.x = cvt_pk_bf16(r[0], r[1]); w.y = cvt_pk_bf16(r[2], r[3]); *(u32x2*)(rowp + n * 16) = w; } }
    }
};
template <class Epi, class Sched>
__device__ __forceinline__ void gemm_phase(LAS unsigned char* lds, const Gemm g, const Sched& S, const Epi& E) {
    const int tid = otid(), wid = __builtin_amdgcn_readfirstlane(tid >> 6), lane = tid & 63, wr = wid >> 2, wc = wid & 3, fr = lane & 15, fq = lane >> 4;
    const int K = g.K, nt = K / BK;
    unsigned voffA[2], voffB[2];
#pragma unroll
    for (int i = 0; i < 2; ++i) { int R_, C_; stage_rc(tid * 16 + i * 8192, R_, C_); voffA[i] = (unsigned)(R_ * K + C_) * 2u; voffB[i] = voffA[i]; }
    const size_t kstep = (size_t)(BK * 2);
    const size_t hstep = (size_t)HALF * K * 2;
    const size_t tstep = 2 * hstep;
    const unsigned ldsw = (unsigned)wid * 1024u;
    const int aoff = lds_byte(wr * 64 + fr, fq * 8), boff = lds_byte(wc * 32 + fr, fq * 8);
#define PG8_SA(b, h) (((b) * 2 + (h)) * HTB)
#define PG8_SB(b, h) ((4 + (b) * 2 + (h)) * HTB)
#define PG8_STAGE(bufoff, gbase, voff) do { _Pragma("unroll") for (int _i = 0; _i < 2; ++_i) \
        __builtin_amdgcn_global_load_lds((const unsigned*)((const char*)(gbase) + (voff)[_i]), (LAS unsigned*)(lds + (bufoff) + ldsw + _i * 8192), 16, 0, 0); } while (0)
#define PG8_LDA(dst, b, h) do { _Pragma("unroll") for (int m = 0; m < 4; ++m) _Pragma("unroll") for (int k = 0; k < 2; ++k) dst[m][k] = *(const LAS bf16x8*)(lds + PG8_SA(b, h) + aoff + m * 2048 + k * 1024); } while (0)
#define PG8_LDB(dst, b, h) do { _Pragma("unroll") for (int n = 0; n < 2; ++n) _Pragma("unroll") for (int k = 0; k < 2; ++k) dst[n][k] = *(const LAS bf16x8*)(lds + PG8_SB(b, h) + boff + n * 2048 + k * 1024); } while (0)
#define PG8_MMA(ai, bj, At, Bt) do { __builtin_amdgcn_s_setprio(1); _Pragma("unroll") for (int m = 0; m < 4; ++m) _Pragma("unroll") for (int n = 0; n < 2; ++n) _Pragma("unroll") for (int k = 0; k < 2; ++k) \
        acc[ai][bj][m][n] = __builtin_amdgcn_mfma_f32_16x16x32_bf16(Bt[n][k], At[m][k], acc[ai][bj][m][n], 0, 0, 0); __builtin_amdgcn_s_setprio(0); } while (0)
#define PG8_WAIT_V(n) asm volatile("s_waitcnt vmcnt(" #n ")" ::: "memory")
#define PG8_WAIT_L(n) asm volatile("s_waitcnt lgkmcnt(" #n ")" ::: "memory")
#define PG8_BAR __builtin_amdgcn_s_barrier()
#define PG8_SCHED __builtin_amdgcn_sched_barrier(0)
    Unit cur, nxt; int ui = 0;
    if (!S.next(0, cur)) return;
    f32x4 acc[2][2][4][2];
#pragma unroll
    for (int a = 0; a < 2; ++a)
#pragma unroll
        for (int b = 0; b < 2; ++b)
#pragma unroll
            for (int m = 0; m < 4; ++m)
#pragma unroll
                for (int n = 0; n < 2; ++n) acc[a][b][m][n] = (f32x4){0.f, 0.f, 0.f, 0.f};
    bf16x8 At[4][2], B0[2][2], B1[2][2];
    const char* cA = (const char*)g.A + (size_t)cur.pm * tstep; const char* cB = (const char*)g.Bt + S.boff(cur, tstep);
    PG8_STAGE(PG8_SB(0, 0), cB, voffB); PG8_STAGE(PG8_SA(0, 0), cA, voffA); PG8_STAGE(PG8_SB(0, 1), cB + hstep, voffB); PG8_STAGE(PG8_SA(0, 1), cA + hstep, voffA);
    if (wr == 1) PG8_BAR;
    PG8_WAIT_V(4); PG8_BAR;
    PG8_STAGE(PG8_SB(1, 0), cB + kstep, voffB); PG8_STAGE(PG8_SA(1, 0), cA + kstep, voffA); PG8_STAGE(PG8_SB(1, 1), cB + hstep + kstep, voffB);
    PG8_WAIT_V(6); PG8_BAR;
    for (;;) {
        const bool has_next = S.next(ui + 1, nxt);
        const char* nA = has_next ? (const char*)g.A + (size_t)nxt.pm * tstep : cA; const char* nB = has_next ? (const char*)g.Bt + S.boff(nxt, tstep) : cB;
        for (int t = 0; t < nt; t += 2) {
            const bool last = (t == nt - 2);
            const char* a1 = cA + (size_t)(t + 1) * kstep;
            const char* a2 = last ? nA : cA + (size_t)(t + 2) * kstep; const char* b2 = last ? nB : cB + (size_t)(t + 2) * kstep;
            const char* a3 = a2 + kstep; const char* b3 = b2 + kstep;
            PG8_LDB(B0, 0, 0); PG8_SCHED; PG8_LDA(At, 0, 0); PG8_STAGE(PG8_SA(1, 1), a1 + hstep, voffA);
            PG8_WAIT_L(8); PG8_BAR; PG8_WAIT_L(0); PG8_MMA(0, 0, At, B0); PG8_BAR; PG8_SCHED;
            PG8_LDB(B1, 0, 1); PG8_STAGE(PG8_SB(0, 0), b2, voffB);
            PG8_BAR; PG8_WAIT_L(0); PG8_MMA(0, 1, At, B1); PG8_BAR;
            PG8_LDA(At, 0, 1); PG8_STAGE(PG8_SA(0, 0), a2, voffA);
            PG8_BAR; PG8_WAIT_L(0); PG8_MMA(1, 0, At, B0); PG8_BAR; PG8_SCHED;
            PG8_STAGE(PG8_SB(0, 1), b2 + hstep, voffB);
            PG8_WAIT_V(6); PG8_BAR; PG8_MMA(1, 1, At, B1); PG8_BAR;
            PG8_LDB(B0, 1, 0); PG8_SCHED; PG8_LDA(At, 1, 0); PG8_STAGE(PG8_SA(0, 1), a2 + hstep, voffA);
            PG8_WAIT_L(8); PG8_BAR; PG8_WAIT_L(0); PG8_MMA(0, 0, At, B0); PG8_BAR; PG8_SCHED;
            PG8_LDB(B1, 1, 1); PG8_STAGE(PG8_SB(1, 0), b3, voffB);
            PG8_BAR; PG8_WAIT_L(0); PG8_MMA(0, 1, At, B1); PG8_BAR;
            PG8_LDA(At, 1, 1); PG8_STAGE(PG8_SA(1, 0), a3, voffA);
            PG8_BAR; PG8_WAIT_L(0); PG8_MMA(1, 0, At, B0); PG8_BAR; PG8_SCHED;
            PG8_STAGE(PG8_SB(1, 1), b3 + hstep, voffB);
            PG8_WAIT_V(6); PG8_BAR; PG8_MMA(1, 1, At, B1); PG8_BAR;
        }
        E(acc, cur, wr, wc, fr, fq);
        if (!has_next) break;
#pragma unroll
        for (int a = 0; a < 2; ++a)
#pragma unroll
            for (int b = 0; b < 2; ++b)
#pragma unroll
                for (int m = 0; m < 4; ++m)
#pragma unroll
                    for (int n = 0; n < 2; ++n) acc[a][b][m][n] = (f32x4){0.f, 0.f, 0.f, 0.f};
        cur = nxt; cA = nA; cB = nB; ++ui;
    }
    PG8_WAIT_V(0);
    if (wr == 0) PG8_BAR;
    PG8_BAR;
#undef PG8_SA
#undef PG8_SB
#undef PG8_STAGE
#undef PG8_LDA
#undef PG8_LDB
#undef PG8_MMA
#undef PG8_WAIT_V
#undef PG8_WAIT_L
#undef PG8_BAR
#undef PG8_SCHED
}
}

struct ConvDesc { const float* src; bf16_t* dst; int K, N, ldk, nblk, nmul, noff, nmat; long sstride, dstride; };
__device__ __forceinline__ void conv_wT(const ConvDesc& d, int bid, int nb, float* smem) {
    const int tid = otid();
    const int tk = d.K / 64, tn = d.N / 64, per = tk * tn;
    for (int u = bid; u < d.nmat * per; u += nb) {
        const int mat = u / per, t = u % per, kt = t / tn, ntl = t % tn;
        const float* s = d.src + (long)mat * d.sstride + (long)(kt * 64) * d.N + ntl * 64;
        __syncthreads();
#pragma unroll
        for (int ps = 0; ps < 2; ++ps) {
            const int kk = (tid >> 4) + ps * 32, n4 = (tid & 15) * 4;
            const float4 v = ld4(s + (long)kk * d.N + n4);
            smem[kk * 65 + n4 + 0] = v.x; smem[kk * 65 + n4 + 1] = v.y; smem[kk * 65 + n4 + 2] = v.z; smem[kk * 65 + n4 + 3] = v.w;
        }
        __syncthreads();
        const int n = tid >> 3, k8 = (tid & 7) * 8;
        u32x4 w;
        w.x = cvt_pk_bf16(smem[(k8 + 0) * 65 + n], smem[(k8 + 1) * 65 + n]); w.y = cvt_pk_bf16(smem[(k8 + 2) * 65 + n], smem[(k8 + 3) * 65 + n]);
        w.z = cvt_pk_bf16(smem[(k8 + 4) * 65 + n], smem[(k8 + 5) * 65 + n]); w.w = cvt_pk_bf16(smem[(k8 + 6) * 65 + n], smem[(k8 + 7) * 65 + n]);
        const int gn = ntl * 64 + n;
        const int drow = (d.nblk < 0) ? (((gn >> 7) & 1) * 512 + (gn >> 8) * 128 + (gn & 127)) : ((gn / d.nblk) * d.nmul + d.noff + gn % d.nblk);
        *(u32x4*)(d.dst + (long)mat * d.dstride + (long)drow * d.ldk + kt * 64 + k8) = w;
    }
}

__device__ __forceinline__ void ph_prologue(const Params& p, int bid, int nb, float* smem) {
    const int tid = otid();
    {
        const long n4 = (long)R * D / 4, nl4 = (long)NLAT * D / 4;
        for (long i = (long)bid * NTH + tid; i < n4; i += (long)nb * NTH) {
            float4 v = (i < nl4) ? ld4(p.x + i * 4) : ld4(p.ctx + (i - nl4) * 4);
            st4(p.xc + i * 4, v);
        }
    }
    {
        const ConvDesc c_in{p.w_in, p.WinT, D, INC, D, 1 << 30, 0, 0, DEPTH, (long)D * INC, (long)INP * D};
        conv_wT(c_in, bid, nb, smem);
        const ConvDesc c_out{p.w_out, p.WoutT, D, D, D, 1 << 30, 0, 0, DEPTH, (long)D * D, (long)D * D};
        conv_wT(c_out, bid, nb, smem);
        const ConvDesc c_uq{p.w_uq, p.WuqT, 384, 768, 384, 1 << 30, 0, 0, DEPTH, 384L * 768, 768L * 384};
        conv_wT(c_uq, bid, nb, smem);
        const ConvDesc c_ukv{p.w_ukv, p.WukvT, 128, 1024, 256, -1, 0, 0, DEPTH, 128L * 1024, 1024L * 256};
        conv_wT(c_ukv, bid, nb, smem);
        const ConvDesc c_w1{p.w1, p.W13T, D, FF, D, 128, 256, 0, DEPTH * NEXP, (long)D * FF, 1024L * D};
        conv_wT(c_w1, bid, nb, smem);
        const ConvDesc c_w3{p.w3, p.W13T, D, FF, D, 128, 256, 128, DEPTH * NEXP, (long)D * FF, 1024L * D};
        conv_wT(c_w3, bid, nb, smem);
        const ConvDesc c_w2{p.w2, p.W2T, FF, D, FF, 1 << 30, 0, 0, DEPTH * NEXP, (long)FF * D, (long)D * FF};
        conv_wT(c_w2, bid, nb, smem);
        const u32x4 z = {0u, 0u, 0u, 0u};
        for (long i = (long)bid * NTH + tid; i < (long)DEPTH * (INP - INC) * D / 8; i += (long)nb * NTH) {
            const long per = (long)(INP - INC) * D / 8; const int l = (int)(i / per); const long o = i % per;
            *(u32x4*)(p.WinT + (long)l * INP * D + (long)INC * D + o * 8) = z;
        }
        for (long i = (long)bid * NTH + tid; i < (long)DEPTH * 1024 * 16; i += (long)nb * NTH) {
            const long row = i / 16; const int c8 = (int)(i % 16) * 8;
            *(u32x4*)(p.WukvT + row * 256 + 128 + c8) = z;
        }
    }
    for (int u = bid; u < DEPTH * 24; u += nb) {
        const int l = u / 24, jb = u % 24;
        __syncthreads();
        for (int i = tid; i < 3 * D; i += NTH) {
            const int r = i / D, k = i % D;
            const float cv = (r < 2) ? p.c[r * D + k] : p.c_ctx[k];
            smem[i] = siluf(cv);
        }
        __syncthreads();
        const int j = jb * NTH + tid;
        const float* w = p.w_ada + (long)l * D * (6 * D) + j;
        float a0 = 0.f, a1 = 0.f, a2 = 0.f;
#pragma unroll 8
        for (int k = 0; k < D; ++k) {
            const float wv = w[(long)k * (6 * D)];
            a0 = fmaf(smem[k], wv, a0); a1 = fmaf(smem[D + k], wv, a1); a2 = fmaf(smem[2 * D + k], wv, a2);
        }
        const float bv = p.b_ada[l * 6 * D + j];
        float* mv = p.modv + (long)l * 3 * 6 * D;
        mv[0 * 6 * D + j] = a0 + bv; mv[1 * 6 * D + j] = a1 + bv; mv[2 * 6 * D + j] = a2 + bv;
    }
}

struct Row { float4 v[8]; };
__device__ __forceinline__ void row_load(Row& r, const float* p, int lane) {
#pragma unroll
    for (int i = 0; i < 8; ++i) r.v[i] = ld4(p + (i * 64 + lane) * 4);
}
__device__ __forceinline__ void row_store(const Row& r, float* p, int lane) {
#pragma unroll
    for (int i = 0; i < 8; ++i) st4(p + (i * 64 + lane) * 4, r.v[i]);
}
__device__ __forceinline__ void row_store_bf16(const Row& r, bf16_t* p, int lane) {
#pragma unroll
    for (int i = 0; i < 8; ++i) { u32x2 w; w.x = cvt_pk_bf16(r.v[i].x, r.v[i].y); w.y = cvt_pk_bf16(r.v[i].z, r.v[i].w); *(u32x2*)(p + (i * 64 + lane) * 4) = w; }
}
__device__ __forceinline__ void row_stats(const Row& r, float& mean, float& rstd) {
    float s = 0.f;
#pragma unroll
    for (int i = 0; i < 8; ++i) s += (r.v[i].x + r.v[i].y) + (r.v[i].z + r.v[i].w);
    mean = wsum(s) * (1.0f / D);
    float q = 0.f;
#pragma unroll
    for (int i = 0; i < 8; ++i) { const float a = r.v[i].x - mean, b = r.v[i].y - mean, c = r.v[i].z - mean, d = r.v[i].w - mean; q += (a * a + b * b) + (c * c + d * d); }
    rstd = rsqrtf(wsum(q) * (1.0f / D) + EPS);
}
__device__ __forceinline__ void row_modulate(Row& r, float mean, float rstd, const float* sh, const float* sc, int lane) {
#pragma unroll
    for (int i = 0; i < 8; ++i) {
        const int c = (i * 64 + lane) * 4;
        const float4 s = ld4(sc + c), h = ld4(sh + c);
        r.v[i].x = (r.v[i].x - mean) * rstd * (1.f + s.x) + h.x; r.v[i].y = (r.v[i].y - mean) * rstd * (1.f + s.y) + h.y;
        r.v[i].z = (r.v[i].z - mean) * rstd * (1.f + s.z) + h.z; r.v[i].w = (r.v[i].w - mean) * rstd * (1.f + s.w) + h.w;
    }
}
__device__ __forceinline__ void row_affine(Row& r, float mean, float rstd, const float* g, const float* b, int lane) {
#pragma unroll
    for (int i = 0; i < 8; ++i) {
        const int c = (i * 64 + lane) * 4;
        const float4 s = ld4(g + c), h = ld4(b + c);
        r.v[i].x = (r.v[i].x - mean) * rstd * s.x + h.x; r.v[i].y = (r.v[i].y - mean) * rstd * s.y + h.y;
        r.v[i].z = (r.v[i].z - mean) * rstd * s.z + h.z; r.v[i].w = (r.v[i].w - mean) * rstd * s.w + h.w;
    }
}

__device__ __forceinline__ void ph_lnmod(const Params& p, int l, int bid, int nb) {
    const int tid = otid(), lane = tid & 63, wid = tid >> 6;
    for (int r = bid * NWV + wid; r < R; r += nb * NWV) {
        Row x; row_load(x, p.xc + (long)r * D, lane);
        float mean, rstd; row_stats(x, mean, rstd);
        const float* mv = p.modv + ((long)l * 3 + mod_row(r)) * 6 * D;
        row_modulate(x, mean, rstd, mv + 0 * D, mv + 1 * D, lane);
        row_store_bf16(x, p.hb + (long)r * D, lane);
    }
}

__device__ __forceinline__ void ph_prep(const Params& p, int l, int bid, int nb) {
    const int tid = otid(), lane = tid & 63, wid = tid >> 6;
    for (int rr = 0; rr < 8 * (R / 64); ++rr) {
        const int grp = rr >> 3;
        const int g64 = bid + (grp) * nb; if (g64 >= R / 64) break;
        const int r = g64 * 64 + wid * 8 + (rr & 7);
        const float* pr = p.P + (long)r * INC;
        const bool lat = r < NLAT;
        const int t = r % T; const float rowi = (float)(t / 64), coli = (float)(t % 64);
        {
            float sn = 0.f, cs = 1.f;
            if (lat) { const int f = lane & 31; const float inv = powf(10000.0f, -(float)f / 32.0f); sincosf((lane < 32 ? rowi : coli) * inv, &sn, &cs); }
#pragma unroll
            for (int h = 0; h < 6; ++h) {
                const float x1 = pr[SQ + h * 128 + lane], x2 = pr[SQ + h * 128 + lane + 64];
                const bf16_t y1 = f2bf(x1 * cs - x2 * sn), y2 = f2bf(x2 * cs + x1 * sn);
                bf16_t* d = (h < 4) ? (p.sqb + (long)r * 512 + h * 128) : (p.skb + (long)r * 256 + (h - 4) * 128);
                d[lane] = y1; d[lane + 64] = y2;
            }
#pragma unroll
            for (int i = 0; i < 4; ++i) p.svT[(long)(i * 64 + lane) * R + r] = f2bf(pr[SV + i * 64 + lane]);
        }
        if (lane < 32) {
            float sn = 0.f, cs = 1.f;
            if (lat) { const int f = lane & 15; const float inv = powf(10000.0f, -(float)f / 16.0f); sincosf((lane < 16 ? rowi : coli) * inv, &sn, &cs); }
            const float x1 = pr[KR + lane], x2 = pr[KR + lane + 32];
            p.Krb[(long)r * 64 + lane] = f2bf(x1 * cs - x2 * sn); p.Krb[(long)r * 64 + lane + 32] = f2bf(x2 * cs + x1 * sn);
        }
        {
            float v[6]; float s = 0.f;
#pragma unroll
            for (int i = 0; i < 6; ++i) { v[i] = pr[CQ + i * 64 + lane]; s += v[i] * v[i]; }
            const float rs = rsqrtf(wsum(s) * (1.0f / 384.0f) + EPS);
#pragma unroll
            for (int i = 0; i < 6; ++i) p.cqn[(long)r * 384 + i * 64 + lane] = f2bf(v[i] * rs * p.q_norm[l * 384 + i * 64 + lane]);
            const float a = pr[CKV + lane], b = pr[CKV + 64 + lane];
            const float rs2 = rsqrtf(wsum(a * a + b * b) * (1.0f / 128.0f) + EPS);
            p.ckvn[(long)r * 256 + lane] = f2bf(a * rs2 * p.kv_norm[l * 128 + lane]);
            p.ckvn[(long)r * 256 + 64 + lane] = f2bf(b * rs2 * p.kv_norm[l * 128 + 64 + lane]);
            p.ckvn[(long)r * 256 + 128 + lane] = 0; p.ckvn[(long)r * 256 + 192 + lane] = 0;
        }
    }
}

struct AttnSrc {
    const bf16_t* Q; int ldq, qoff;
    const bf16_t* K1; int ldk1, k1off;
    const bf16_t* K2; int ldk2;
    const bf16_t* Vt; int ldv, voff;
    bf16_t* O; int ldo, ooff;
};
template <bool MLA>
__device__ __forceinline__ void attn_unit(const AttnSrc& a, int qrow0, int ctxrow0, int locrow0, int nloc, bool win, int tq0, int tk0, bool rope_q,
                                          float sink_l2, float c, LAS unsigned char* lds) {
    constexpr int KSTR = MLA ? 400 : 272, NKS = MLA ? 6 : 4, VSTR = 144, KBYTES = 64 * KSTR, BUFB = KBYTES + 128 * VSTR, NCH = MLA ? 5 : 4;
    const int tid = otid(), lane = tid & 63, wid = tid >> 6, fr = lane & 15, fq = lane >> 4;
    const int ntiles = 4 + nloc;
    bf16x8 qf[NKS];
    {
        const bf16_t* qp = a.Q + (long)(qrow0 + wid * 16 + fr) * a.ldq + a.qoff + fq * 8;
#pragma unroll
        for (int ks = 0; ks < NKS; ++ks) qf[ks] = *(const bf16x8*)(qp + ks * 32);
        if (MLA && rope_q) {
            const int t = tq0 + wid * 16 + fr; const float rowi = (float)(t / 64), coli = (float)(t % 64);
#pragma unroll
            for (int e = 0; e < 8; ++e) {
                const int i = fq * 8 + e, f = i & 15;
                const float inv = powf(10000.0f, -(float)f / 16.0f);
                const float ang = (i < 16 ? rowi : coli) * inv;
                float sn, cs; sincosf(ang, &sn, &cs);
                const float x1 = __uint_as_float(((unsigned)(unsigned short)qf[4][e]) << 16), x2 = __uint_as_float(((unsigned)(unsigned short)qf[5][e]) << 16);
                qf[4][e] = (short)f2bf(x1 * cs - x2 * sn); qf[5][e] = (short)f2bf(x2 * cs + x1 * sn);
            }
        }
    }
    f32x4 o[8];
#pragma unroll
    for (int dt = 0; dt < 8; ++dt) o[dt] = (f32x4){0.f, 0.f, 0.f, 0.f};
    float m = -INFINITY, l = 0.f;
    u32x4 rg[NCH];
#define ATT_LOAD(keyrow0) do { \
        const int kr_ = (keyrow0); \
        rg[0] = *(const u32x4*)(a.K1 + (long)(kr_ + (tid >> 4)) * a.ldk1 + a.k1off + (tid & 15) * 8); \
        rg[1] = *(const u32x4*)(a.K1 + (long)(kr_ + 32 + (tid >> 4)) * a.ldk1 + a.k1off + (tid & 15) * 8); \
        if (MLA) { rg[2] = *(const u32x4*)(a.K2 + (long)(kr_ + (tid >> 3)) * a.ldk2 + (tid & 7) * 8); \
                   rg[3] = *(const u32x4*)(a.Vt + (long)(a.voff + (tid >> 3)) * a.ldv + kr_ + (tid & 7) * 8); \
                   rg[NCH - 1] = *(const u32x4*)(a.Vt + (long)(a.voff + 64 + (tid >> 3)) * a.ldv + kr_ + (tid & 7) * 8); } \
        else { rg[2] = *(const u32x4*)(a.Vt + (long)(a.voff + (tid >> 3)) * a.ldv + kr_ + (tid & 7) * 8); \
               rg[NCH - 1] = *(const u32x4*)(a.Vt + (long)(a.voff + 64 + (tid >> 3)) * a.ldv + kr_ + (tid & 7) * 8); } } while (0)
#define ATT_STORE(buf) do { LAS unsigned char* b_ = (buf); \
        *(LAS u32x4*)(b_ + (tid >> 4) * KSTR + (tid & 15) * 16) = rg[0]; \
        *(LAS u32x4*)(b_ + (32 + (tid >> 4)) * KSTR + (tid & 15) * 16) = rg[1]; \
        if (MLA) { *(LAS u32x4*)(b_ + (tid >> 3) * KSTR + 256 + (tid & 7) * 16) = rg[2]; \
                   *(LAS u32x4*)(b_ + KBYTES + (tid >> 3) * VSTR + (tid & 7) * 16) = rg[3]; \
                   *(LAS u32x4*)(b_ + KBYTES + (64 + (tid >> 3)) * VSTR + (tid & 7) * 16) = rg[NCH - 1]; } \
        else { *(LAS u32x4*)(b_ + KBYTES + (tid >> 3) * VSTR + (tid & 7) * 16) = rg[2]; \
               *(LAS u32x4*)(b_ + KBYTES + (64 + (tid >> 3)) * VSTR + (tid & 7) * 16) = rg[NCH - 1]; } } while (0)
#define ATT_KEYROW(i) ((i) < 4 ? ctxrow0 + 64 * (i) : locrow0 + 64 * ((i) - 4))
    __syncthreads();
    ATT_LOAD(ATT_KEYROW(0));
    ATT_STORE(lds);
    __syncthreads();
    for (int t = 0; t < ntiles; ++t) {
        LAS unsigned char* buf = lds + (t & 1) * BUFB;
        if (t + 1 < ntiles) ATT_LOAD(ATT_KEYROW(t + 1));
        f32x4 s[4];
#pragma unroll
        for (int kt = 0; kt < 4; ++kt) {
            s[kt] = (f32x4){0.f, 0.f, 0.f, 0.f};
#pragma unroll
            for (int ks = 0; ks < NKS; ++ks) {
                const bf16x8 kf = *(const LAS bf16x8*)(buf + (kt * 16 + fr) * KSTR + ks * 64 + fq * 16);
                s[kt] = __builtin_amdgcn_mfma_f32_16x16x32_bf16(kf, qf[ks], s[kt], 0, 0, 0);
            }
        }
        if (win && t >= 4) {
            const int tq = tq0 + wid * 16 + fr, tkb = tk0 + 64 * (t - 4) + 4 * fq;
#pragma unroll
            for (int kt = 0; kt < 4; ++kt)
#pragma unroll
                for (int j = 0; j < 4; ++j) { const int d = tkb + kt * 16 + j - tq; if (d < -128 || d > 128) s[kt][j] = -INFINITY; }
        }
        float mx = fmaxf(fmaxf(fmaxf(s[0][0], s[0][1]), fmaxf(s[0][2], s[0][3])), fmaxf(fmaxf(s[1][0], s[1][1]), fmaxf(s[1][2], s[1][3])));
        mx = fmaxf(mx, fmaxf(fmaxf(fmaxf(s[2][0], s[2][1]), fmaxf(s[2][2], s[2][3])), fmaxf(fmaxf(s[3][0], s[3][1]), fmaxf(s[3][2], s[3][3]))));
        mx = fmaxf(mx, __shfl_xor(mx, 16)); mx = fmaxf(mx, __shfl_xor(mx, 32));
        const float mn = fmaxf(m, mx * c);
        const float alpha = __builtin_amdgcn_exp2f(m - mn);
        m = mn;
        float ps = 0.f;
#pragma unroll
        for (int kt = 0; kt < 4; ++kt)
#pragma unroll
            for (int j = 0; j < 4; ++j) { const float pv = __builtin_amdgcn_exp2f(fmaf(s[kt][j], c, -mn)); s[kt][j] = pv; ps += pv; }
        l = l * alpha + ps;
#pragma unroll
        for (int dt = 0; dt < 8; ++dt) o[dt] = o[dt] * alpha;
#pragma unroll
        for (int s2 = 0; s2 < 2; ++s2) {
            u32x4 pk; pk.x = cvt_pk_bf16(s[2 * s2][0], s[2 * s2][1]); pk.y = cvt_pk_bf16(s[2 * s2][2], s[2 * s2][3]);
            pk.z = cvt_pk_bf16(s[2 * s2 + 1][0], s[2 * s2 + 1][1]); pk.w = cvt_pk_bf16(s[2 * s2 + 1][2], s[2 * s2 + 1][3]);
            const bf16x8 pf = __builtin_bit_cast(bf16x8, pk);
#pragma unroll
            for (int dt = 0; dt < 8; ++dt) {
                const LAS unsigned char* vp = buf + KBYTES + (dt * 16 + fr) * VSTR + (32 * s2 + 4 * fq) * 2;
                const u32x2 lo = *(const LAS u32x2*)vp, hi = *(const LAS u32x2*)(vp + 32);
                u32x4 vv; vv.x = lo.x; vv.y = lo.y; vv.z = hi.x; vv.w = hi.y;
                o[dt] = __builtin_amdgcn_mfma_f32_16x16x32_bf16(__builtin_bit_cast(bf16x8, vv), pf, o[dt], 0, 0, 0);
            }
        }
        __syncthreads();
        if (t + 1 < ntiles) ATT_STORE(lds + ((t + 1) & 1) * BUFB);
        __syncthreads();
    }
#undef ATT_LOAD
#undef ATT_STORE
#undef ATT_KEYROW
    l += __shfl_xor(l, 16); l += __shfl_xor(l, 32);
    if (sink_l2 > -INFINITY) { const float mn = fmaxf(m, sink_l2); const float alpha = __builtin_amdgcn_exp2f(m - mn); l = l * alpha + __builtin_amdgcn_exp2f(sink_l2 - mn);
#pragma unroll
        for (int dt = 0; dt < 8; ++dt) o[dt] = o[dt] * alpha; }
    const float il = 1.0f / l;
    bf16_t* op = a.O + (long)(qrow0 + wid * 16 + fr) * a.ldo + a.ooff + 4 * fq;
#pragma unroll
    for (int dt = 0; dt < 8; ++dt) { u32x2 w; w.x = cvt_pk_bf16(o[dt][0] * il, o[dt][1] * il); w.y = cvt_pk_bf16(o[dt][2] * il, o[dt][3] * il); *(u32x2*)(op + dt * 16) = w; }
}


__device__ __forceinline__ float bf2f(bf16_t v) { return __uint_as_float(((unsigned)v) << 16); }
#define OSM_UPDATE(S, M_, L_, A0, A1, V0, V1) do { const float mn_ = fmaxf(M_, S); const float cr_ = expf(M_ - mn_); const float pp_ = expf((S) - mn_); \
    L_ = L_ * cr_ + pp_; A0 = A0 * cr_ + pp_ * (V0); A1 = A1 * cr_ + pp_ * (V1); M_ = mn_; } while (0)
__device__ __forceinline__ void swa_task(const Params& p, int l, int h, int r0, int lane) {
    constexpr int QW = 4;
    const float scale = 0.08838834764831845f;
    const bool lat = r0 < NLAT;
    const int b = lat ? r0 / T : (r0 - NLAT) / LCTX;
    const int kvh = h >> 1;
    float q0[QW], q1[QW], m[QW], ls[QW], a0[QW], a1[QW];
#pragma unroll
    for (int i = 0; i < QW; ++i) {
        const bf16_t* q = p.sqb + (long)(r0 + i) * 512 + h * 128;
        q0[i] = bf2f(q[lane]) * scale; q1[i] = bf2f(q[lane + 64]) * scale; m[i] = -INFINITY; ls[i] = 0.f; a0[i] = 0.f; a1[i] = 0.f;
    }
    for (int j = 0; j < LCTX; ++j) {
        const long rk = NLAT + b * LCTX + j;
        const float k0 = bf2f(p.skb[rk * 256 + kvh * 128 + lane]), k1 = bf2f(p.skb[rk * 256 + kvh * 128 + 64 + lane]);
        const float v0 = bf2f(p.svT[(long)(kvh * 128 + lane) * R + rk]), v1 = bf2f(p.svT[(long)(kvh * 128 + 64 + lane) * R + rk]);
#pragma unroll
        for (int i = 0; i < QW; ++i) { const float s = wsum(q0[i] * k0 + q1[i] * k1); OSM_UPDATE(s, m[i], ls[i], a0[i], a1[i], v0, v1); }
    }
    if (lat) {
        const int t0 = r0 % T;
        const int lo = (t0 - 128) < 0 ? 0 : (t0 - 128), hi = (t0 + QW - 1 + 128) > (T - 1) ? (T - 1) : (t0 + QW - 1 + 128);
        for (int tk = lo; tk <= hi; ++tk) {
            const long rk = b * T + tk;
            const float k0 = bf2f(p.skb[rk * 256 + kvh * 128 + lane]), k1 = bf2f(p.skb[rk * 256 + kvh * 128 + 64 + lane]);
            const float v0 = bf2f(p.svT[(long)(kvh * 128 + lane) * R + rk]), v1 = bf2f(p.svT[(long)(kvh * 128 + 64 + lane) * R + rk]);
#pragma unroll
            for (int i = 0; i < QW; ++i) {
                const int d = tk - (t0 + i);
                if (d >= -128 && d <= 128) { const float s = wsum(q0[i] * k0 + q1[i] * k1); OSM_UPDATE(s, m[i], ls[i], a0[i], a1[i], v0, v1); }
            }
        }
    }
    const float sk = p.swa_sink[l * 4 + h];
#pragma unroll
    for (int i = 0; i < QW; ++i) {
        OSM_UPDATE(sk, m[i], ls[i], a0[i], a1[i], 0.f, 0.f);
        bf16_t* o = p.mix + (long)(r0 + i) * D + h * 128;
        const float il = 1.0f / ls[i];
        o[lane] = f2bf(a0[i] * il); o[lane + 64] = f2bf(a1[i] * il);
    }
}
__device__ __forceinline__ void mla_task(const Params& p, int h, int r0, int lane) {
    constexpr int QW = 8;
    const float scale = 0.07216878364870323f;
    const bool lat = r0 < NLAT;
    const int b = lat ? r0 / T : (r0 - NLAT) / LCTX;
    float q0[QW], q1[QW], q2[QW], m[QW], ls[QW], a0[QW], a1[QW];
#pragma unroll
    for (int i = 0; i < QW; ++i) {
        const bf16_t* q = p.Q2b + (long)(r0 + i) * 768 + h * 192;
        q0[i] = bf2f(q[lane]) * scale; q1[i] = bf2f(q[lane + 64]) * scale;
        float qr = bf2f(q[128 + lane]);
        if (lat) {
            const int t = (r0 + i) % T; const float rowi = (float)(t / 64), coli = (float)(t % 64);
            const int ii = lane & 31, f = ii & 15;
            const float inv = powf(10000.0f, -(float)f / 16.0f);
            const float ang = (ii < 16 ? rowi : coli) * inv;
            float sn, cs; sincosf(ang, &sn, &cs);
            const float other = __shfl_xor(qr, 32);
            qr = (lane < 32) ? (qr * cs - other * sn) : (qr * cs + other * sn);
        }
        q2[i] = qr * scale; m[i] = -INFINITY; ls[i] = 0.f; a0[i] = 0.f; a1[i] = 0.f;
    }
    const int nkeys = lat ? (LCTX + T) : LCTX;
    for (int j = 0; j < nkeys; ++j) {
        const long rk = (j < LCTX) ? (NLAT + b * LCTX + j) : (b * T + (j - LCTX));
        const float k0 = bf2f(p.Kn[rk * 512 + h * 128 + lane]), k1 = bf2f(p.Kn[rk * 512 + h * 128 + 64 + lane]);
        const float v0 = bf2f(p.VtM[(long)(h * 128 + lane) * R + rk]), v1 = bf2f(p.VtM[(long)(h * 128 + 64 + lane) * R + rk]);
        const float k2 = bf2f(p.Krb[rk * 64 + lane]);
#pragma unroll
        for (int i = 0; i < QW; ++i) { const float s = wsum(q0[i] * k0 + q1[i] * k1 + q2[i] * k2); OSM_UPDATE(s, m[i], ls[i], a0[i], a1[i], v0, v1); }
    }
#pragma unroll
    for (int i = 0; i < QW; ++i) {
        bf16_t* o = p.mix + (long)(r0 + i) * D + 1024 + h * 128;
        const float il = 1.0f / ls[i];
        o[lane] = f2bf(a0[i] * il); o[lane + 64] = f2bf(a1[i] * il);
    }
}

__device__ __forceinline__ void scan_unit(const Params& p, int l, int u, float* smem) {
    const int tid = otid();
    const int dir = u & 1, h = (u >> 1) & 3, b = (u >> 3) & 1, mixer = u >> 4;
    const int j = tid & 127, part = tid >> 7;
    float* sq = smem;
    float* sk = smem + 2048;
    float* sf = smem + 4096;
    float* op = smem + 6144;
    float S[32];
#pragma unroll
    for (int i = 0; i < 32; ++i) S[i] = 0.f;
    float gam = 1.f, lbv[4] = {0.f, 0.f, 0.f, 0.f};
    if (mixer == 0) gam = 1.0f - exp2f(-p.ret_s[(l * 2 + dir) * 4 + h]);
    else if (l > 0) {
#pragma unroll
        for (int e = 0; e < 4; ++e) {
            const int i = (tid + e * NTH) & 127;
            const float l0 = p.lb_logits[(0 * 2 + dir) * 512 + h * 128 + i], l1 = p.lb_logits[(1 * 2 + dir) * 512 + h * 128 + i];
            const float mx = fmaxf(l0, l1), e0 = expf(l0 - mx), e1 = expf(l1 - mx);
            lbv[e] = e1 / (e0 + e1);
        }
    }
    const int voff = (mixer == 0 ? RV : HI) + h * 128 + j;
    float* outp = p.oscan + ((long)(mixer * 2 + dir) * R) * 512 + h * 128 + j;
    for (int p0 = 0; p0 < LCTX + T; p0 += 16) {
        __syncthreads();
#pragma unroll
        for (int e = 0; e < 4; ++e) {
            const int idx = tid + e * NTH, s = idx >> 7, i = idx & 127;
            const int pos = p0 + s;
            int row;
            if (pos < LCTX) row = NLAT + b * LCTX + (dir ? (LCTX - 1 - pos) : pos);
            else { const int t = pos - LCTX; row = b * T + (dir ? (T - 1 - t) : t); }
            const float* pr = p.P + (long)row * INC;
            float qv, kv, fv;
            if (mixer == 0) { qv = pr[RQ + h * 128 + i]; kv = pr[RK + h * 128 + i] * 0.08838834764831845f; fv = gam; }
            else {
                qv = siluf(pr[HQ + h * 128 + i]);
                const float z = pr[(dir ? HFB : HFF) + h * 128 + i];
                const float lb = lbv[e];
                fv = lb + (1.0f - lb) * sigmf(z); kv = 1.0f - fv;
            }
            sq[idx] = qv; sk[idx] = kv; sf[idx] = fv;
        }
        float vv[16];
#pragma unroll
        for (int s = 0; s < 16; ++s) {
            const int pos = p0 + s;
            int row;
            if (pos < LCTX) row = NLAT + b * LCTX + (dir ? (LCTX - 1 - pos) : pos);
            else { const int t = pos - LCTX; row = b * T + (dir ? (T - 1 - t) : t); }
            vv[s] = p.P[(long)row * INC + voff];
        }
        __syncthreads();
#pragma unroll
        for (int s = 0; s < 16; ++s) {
            float o = 0.f;
            const float v = vv[s];
#pragma unroll
            for (int i4 = 0; i4 < 8; ++i4) {
                const float4 f4 = ld4(sf + s * 128 + part * 32 + i4 * 4), k4 = ld4(sk + s * 128 + part * 32 + i4 * 4), q4 = ld4(sq + s * 128 + part * 32 + i4 * 4);
                S[i4 * 4 + 0] = fmaf(f4.x, S[i4 * 4 + 0], k4.x * v); o = fmaf(S[i4 * 4 + 0], q4.x, o);
                S[i4 * 4 + 1] = fmaf(f4.y, S[i4 * 4 + 1], k4.y * v); o = fmaf(S[i4 * 4 + 1], q4.y, o);
                S[i4 * 4 + 2] = fmaf(f4.z, S[i4 * 4 + 2], k4.z * v); o = fmaf(S[i4 * 4 + 2], q4.z, o);
                S[i4 * 4 + 3] = fmaf(f4.w, S[i4 * 4 + 3], k4.w * v); o = fmaf(S[i4 * 4 + 3], q4.w, o);
            }
            op[(part * 16 + s) * 128 + j] = o;
        }
        __syncthreads();
#pragma unroll
        for (int e = 0; e < 4; ++e) {
            const int idx = tid + e * NTH, s = idx >> 7, jj = idx & 127;
            const int pos = p0 + s;
            int row;
            if (pos < LCTX) row = NLAT + b * LCTX + (dir ? (LCTX - 1 - pos) : pos);
            else { const int t = pos - LCTX; row = b * T + (dir ? (T - 1 - t) : t); }
            const float o = (op[(0 * 16 + s) * 128 + jj] + op[(1 * 16 + s) * 128 + jj]) + (op[(2 * 16 + s) * 128 + jj] + op[(3 * 16 + s) * 128 + jj]);
            p.oscan[((long)(mixer * 2 + dir) * R + row) * 512 + h * 128 + jj] = o;
        }
    }
    (void)outp;
}

__device__ __forceinline__ void ph_mixers(const Params& p, int l, int bid, int nb, float* smem, LAS unsigned char* lds) {
    const bool need_ctx = l < DEPTH - 1;
    const float LOG2E = 1.4426950408889634f;
    const float cM = 0.07216878364870323f * LOG2E, cS = 0.08838834764831845f * LOG2E;
#ifndef DIAG_NAIVE
#define DIAG_NAIVE 0
#endif
    if (DIAG_NAIVE) {
        const int tid = otid(), lane = tid & 63, wid = tid >> 6;
        const int nrows = need_ctx ? R : NLAT;
        const int n_mla = (DIAG_NAIVE & 1) ? (nrows / 8) * 4 : ((DIAG_NAIVE & 4) && need_ctx ? (NCTX / 8) * 4 : 0), n_swa = (DIAG_NAIVE & 2) ? (nrows / 4) * 4 : 0;
        const int mla_r0 = (DIAG_NAIVE & 1) ? 0 : NLAT;
        for (int t = bid * NWV + wid; t < n_mla + n_swa; t += nb * NWV) {
            if (t < n_mla) mla_task(p, t & 3, mla_r0 + (t >> 2) * 8, lane);
            else { const int s2 = t - n_mla; swa_task(p, l, s2 & 3, (s2 >> 2) * 4, lane); }
        }
        __syncthreads();
    }
    if (!(DIAG_NAIVE & 1))
    for (int u = bid; u < 256; u += nb) {
        const int b = u >> 7, h = (u >> 5) & 3, qb = u & 31;
        const AttnSrc a{p.Q2b, 768, h * 192, p.Kn, 512, h * 128, p.Krb, 64, p.VtM, R, h * 128, p.mix, D, 1024 + h * 128};
        attn_unit<true>(a, b * T + qb * 128, NLAT + b * LCTX, b * T, 64, false, qb * 128, 0, true, -INFINITY, cM, lds);
    }
    if (!(DIAG_NAIVE & 2))
    for (int u = bid; u < 256; u += nb) {
        const int b = u >> 7, h = (u >> 5) & 3, qb = u & 31, q0 = qb * 128;
        const int ts = (q0 - 128) < 0 ? 0 : (q0 - 128), te = (q0 + 256) > T ? T : (q0 + 256);
        const AttnSrc a{p.sqb, 512, h * 128, p.skb, 256, (h >> 1) * 128, nullptr, 0, p.svT, R, (h >> 1) * 128, p.mix, D, h * 128};
        attn_unit<false>(a, b * T + q0, NLAT + b * LCTX, b * T + ts, (te - ts) / 64, true, q0, ts, false, p.swa_sink[l * 4 + h] * LOG2E, cS, lds);
    }
    if (need_ctx) {
        for (int u = nb - 1 - bid; u < 32; u += nb) {
            const int v = u & 15, b = v >> 3, h = (v >> 1) & 3, qb = v & 1;
            const int qrow0 = NLAT + b * LCTX + qb * 128;
            int nl0 = 0; asm volatile("" : "+s"(nl0));
            if (u < 16) { if (DIAG_NAIVE & 5) continue; const AttnSrc a{p.Q2b, 768, h * 192, p.Kn, 512, h * 128, p.Krb, 64, p.VtM, R, h * 128, p.mix, D, 1024 + h * 128};
                attn_unit<true>(a, qrow0, NLAT + b * LCTX, 0, nl0, false, 0, 0, false, -INFINITY, cM, lds); }
            else { if (DIAG_NAIVE & 2) continue; const AttnSrc a{p.sqb, 512, h * 128, p.skb, 256, (h >> 1) * 128, nullptr, 0, p.svT, R, (h >> 1) * 128, p.mix, D, h * 128};
                attn_unit<false>(a, qrow0, NLAT + b * LCTX, 0, nl0, false, 0, 0, false, p.swa_sink[l * 4 + h] * LOG2E, cS, lds); }
        }
    }
    __syncthreads();
    if (bid < 32) scan_unit(p, l, bid, smem);
}

__device__ __forceinline__ void ph_mixpost(const Params& p, int l, int bid, int nb) {
    const int tid = otid(), lane = tid & 63, wid = tid >> 6;
    for (int r = bid * NWV + wid; r < R; r += nb * NWV) {
        const float* pr = p.P + (long)r * INC;
#pragma unroll
        for (int h = 0; h < 4; ++h) {
            {
                const float* o0 = p.oscan + ((long)(0 * 2 + 0) * R + r) * 512 + h * 128;
                const float* o1 = p.oscan + ((long)(0 * 2 + 1) * R + r) * 512 + h * 128;
                const float a = o0[lane] + o1[lane], b = o0[lane + 64] + o1[lane + 64];
                const float mean = wsum(a + b) * (1.0f / 128.0f);
                const float da = a - mean, db = b - mean;
                const float rstd = rsqrtf(wsum(da * da + db * db) * (1.0f / 128.0f) + EPS);
                const int c = h * 128 + lane;
                p.mix[(long)r * D + 512 + c] = f2bf(siluf(pr[RG + c]) * (da * rstd * p.ret_gn[l * 512 + c]));
                p.mix[(long)r * D + 512 + c + 64] = f2bf(siluf(pr[RG + c + 64]) * (db * rstd * p.ret_gn[l * 512 + c + 64]));
            }
            {
                const float* o0 = p.oscan + ((long)(1 * 2 + 0) * R + r) * 512 + h * 128;
                const float* o1 = p.oscan + ((long)(1 * 2 + 1) * R + r) * 512 + h * 128;
                const float a = o0[lane] + o1[lane], b = o0[lane + 64] + o1[lane + 64];
                const float rs = rsqrtf(wsum(a * a + b * b) * (1.0f / 128.0f) + EPS);
                const int c = h * 128 + lane;
                p.mix[(long)r * D + 1536 + c] = f2bf(siluf(pr[HG + c]) * (a * rs * p.hgrn_gn[l * 512 + c]));
                p.mix[(long)r * D + 1536 + c + 64] = f2bf(siluf(pr[HG + c + 64]) * (b * rs * p.hgrn_gn[l * 512 + c + 64]));
            }
        }
    }
}

__device__ __forceinline__ void ph_post1(const Params& p, int l, int bid, int nb, float* smem) {
    const int tid = otid(), lane = tid & 63, wid = tid >> 6;
    const int nrows = (l < DEPTH - 1) ? R : NLAT;
    for (int r = bid * NWV + wid; r < nrows; r += nb * NWV) {
        const float* mv = p.modv + ((long)l * 3 + mod_row(r)) * 6 * D;
        Row x, o; row_load(x, p.xc + (long)r * D, lane); row_load(o, p.ob + (long)r * D, lane);
#pragma unroll
        for (int i = 0; i < 8; ++i) {
            const float4 g = ld4(mv + 2 * D + (i * 64 + lane) * 4);
            x.v[i].x = ALPHA * x.v[i].x + g.x * o.v[i].x; x.v[i].y = ALPHA * x.v[i].y + g.y * o.v[i].y;
            x.v[i].z = ALPHA * x.v[i].z + g.z * o.v[i].z; x.v[i].w = ALPHA * x.v[i].w + g.w * o.v[i].w;
        }
        float mean, rstd; row_stats(x, mean, rstd);
        row_affine(x, mean, rstd, p.ln1_g + l * D, p.ln1_b + l * D, lane);
        row_store(x, p.xc + (long)r * D, lane);
        row_stats(x, mean, rstd);
        row_modulate(x, mean, rstd, mv + 3 * D, mv + 4 * D, lane);
        row_store_bf16(x, p.hb + (long)r * D, lane);
        float* hrow = smem + wid * D;
#pragma unroll
        for (int i = 0; i < 8; ++i) st4(hrow + (i * 64 + lane) * 4, x.v[i]);
        asm volatile("s_waitcnt lgkmcnt(0)" ::: "memory");
        float acc = 0.f;
        if (lane < 36) {
            const float* wp = (lane < 32) ? (p.w_re + (long)l * D * 32 + lane) : (p.w_rg + (long)l * D * 4 + (lane - 32));
            const int wst = (lane < 32) ? 32 : 4;
#pragma unroll 8
            for (int k = 0; k < D; ++k) acc = fmaf(hrow[k], wp[(long)k * wst], acc);
        }
        asm volatile("" ::: "memory");
        float lg[4], le[32];
#pragma unroll
        for (int g = 0; g < 4; ++g) lg[g] = __shfl(acc, 32 + g);
#pragma unroll
        for (int e = 0; e < 32; ++e) le[e] = __shfl(acc, e);
        int grp = 0; float gm = lg[0];
#pragma unroll
        for (int g = 1; g < 4; ++g) if (lg[g] > gm) { gm = lg[g]; grp = g; }
        float zs = 0.f;
#pragma unroll
        for (int g = 0; g < 4; ++g) zs += expf(lg[g] - gm);
        const float pgrp = 1.0f / zs;
        float ev[8];
#pragma unroll
        for (int e = 0; e < 8; ++e) { ev[e] = (grp == 0) ? le[e] : (grp == 1) ? le[8 + e] : (grp == 2) ? le[16 + e] : le[24 + e]; }
        int i0 = 0; float v0 = ev[0];
#pragma unroll
        for (int e = 1; e < 8; ++e) if (ev[e] > v0) { v0 = ev[e]; i0 = e; }
        int i1 = -1; float v1 = -INFINITY;
#pragma unroll
        for (int e = 0; e < 8; ++e) if (e != i0 && ev[e] > v1) { v1 = ev[e]; i1 = e; }
        const float e1 = expf(v1 - v0);
        const float g0 = pgrp / (1.0f + e1), g1 = pgrp * e1 / (1.0f + e1);
        if (lane == 0) {
            p.eid[r * 2 + 0] = grp * 8 + i0; p.eid[r * 2 + 1] = grp * 8 + i1;
            p.gate[r * 2 + 0] = g0; p.gate[r * 2 + 1] = g1;
        }
    }
}

__device__ __forceinline__ void ph_sort(const Params& p, int l, int bid, int* smem) {
    if (bid != 0) return;
    const int tid = otid(), lane = tid & 63, wid = tid >> 6;
    const int ntok = (l < DEPTH - 1) ? R : NLAT;
    const int nch = ntok / 64;
    int* cnt = smem;
    int* pst = smem + 136 * 32;
    int* tot = pst + 32;
    for (int i = tid; i < NSLOT; i += NTH) p.slot_tok[i] = -1;
    for (int c = wid; c < nch; c += NWV) {
        const int t = c * 64 + lane;
        const int e0 = p.eid[t * 2], e1 = p.eid[t * 2 + 1];
        for (int e = 0; e < 32; ++e) {
            const unsigned long long mk = __ballot(e0 == e || e1 == e);
            if (lane == 0) cnt[c * 32 + e] = __popcll(mk);
        }
    }
    __threadfence_block();
    __syncthreads();
    if (tid < 32) {
        int run = 0;
        for (int c = 0; c < nch; ++c) { const int v = cnt[c * 32 + tid]; cnt[c * 32 + tid] = run; run += v; }
        tot[tid] = run;
    }
    __syncthreads();
    if (tid == 0) {
        int ps = 0;
        for (int e = 0; e < 32; ++e) { pst[e] = ps; ps += (tot[e] + 255) / 256 * 256; }
        p.tile_e[NTILE] = ps / 256;
        int e = 0;
        for (int b = 0; b < NTILE; ++b) {
            const int s = b * 256;
            while (e < 32 && s >= pst[e] + (tot[e] + 255) / 256 * 256) ++e;
            p.tile_e[b] = (e < 32) ? e : -1;
        }
    }
    __syncthreads();
    for (int c = wid; c < nch; c += NWV) {
        const int t = c * 64 + lane;
        const int e0 = p.eid[t * 2], e1 = p.eid[t * 2 + 1];
        for (int e = 0; e < 32; ++e) {
            const unsigned long long mk = __ballot(e0 == e || e1 == e);
            const int rank = __popcll(mk & ((1ull << lane) - 1ull));
            if (e0 == e || e1 == e) {
                const int slot = pst[e] + cnt[c * 32 + e] + rank;
                p.slot_tok[slot] = t;
                p.slot_of[t * 2 + (e1 == e ? 1 : 0)] = slot;
            }
        }
    }
}

__device__ __forceinline__ void ph_gather(const Params& p, int bid, int nb) {
    const int tid = otid(), lane = tid & 63, wid = tid >> 6;
    const int nslots = p.tile_e[NTILE] * 256;
    for (int s0 = bid * NWV + wid; s0 < nslots; s0 += nb * NWV) {
        const int src = p.slot_tok[s0];
        u32x4* d = (u32x4*)(p.xs + (long)s0 * D);
        if (src >= 0) { const u32x4* sp = (const u32x4*)(p.hb + (long)src * D);
#pragma unroll
            for (int i = 0; i < 4; ++i) d[i * 64 + lane] = sp[i * 64 + lane]; }
        else { const u32x4 z = {0u, 0u, 0u, 0u};
#pragma unroll
            for (int i = 0; i < 4; ++i) d[i * 64 + lane] = z; }
    }
}

__device__ __forceinline__ void ph_post2(const Params& p, int l, int bid, int nb) {
    const int tid = otid(), lane = tid & 63, wid = tid >> 6;
    const int nrows = (l < DEPTH - 1) ? R : NLAT;
    for (int r = bid * NWV + wid; r < nrows; r += nb * NWV) {
        const float* mv = p.modv + ((long)l * 3 + mod_row(r)) * 6 * D;
        const int s0 = p.slot_of[r * 2], s1 = p.slot_of[r * 2 + 1];
        const float g0 = p.gate[r * 2], g1 = p.gate[r * 2 + 1];
        Row x, y0, y1; row_load(x, p.xc + (long)r * D, lane); row_load(y0, p.Ys + (long)s0 * D, lane); row_load(y1, p.Ys + (long)s1 * D, lane);
#pragma unroll
        for (int i = 0; i < 8; ++i) {
            const float4 g = ld4(mv + 5 * D + (i * 64 + lane) * 4);
            x.v[i].x = ALPHA * x.v[i].x + g.x * (g0 * y0.v[i].x + g1 * y1.v[i].x); x.v[i].y = ALPHA * x.v[i].y + g.y * (g0 * y0.v[i].y + g1 * y1.v[i].y);
            x.v[i].z = ALPHA * x.v[i].z + g.z * (g0 * y0.v[i].z + g1 * y1.v[i].z); x.v[i].w = ALPHA * x.v[i].w + g.w * (g0 * y0.v[i].w + g1 * y1.v[i].w);
        }
        float mean, rstd; row_stats(x, mean, rstd);
        row_affine(x, mean, rstd, p.ln2_g + l * D, p.ln2_b + l * D, lane);
        if (l == DEPTH - 1) row_store(x, p.out + (long)r * D, lane);
        else row_store(x, p.xc + (long)r * D, lane);
    }
}

constexpr int PH_PER_LAYER = 13, N_PHASES = 1 + DEPTH * PH_PER_LAYER;
constexpr int LDS_MAIN = 128 * 1024, LDS_BYTES = LDS_MAIN + 256;

__global__ void __launch_bounds__(NTH, 2) fwd(Params p) {
    extern __shared__ __attribute__((aligned(16))) unsigned char lds_raw[];
    float* smem = (float*)lds_raw;
    LAS unsigned char* ldsp = (LAS unsigned char*)lds_raw;
    const int bid = blockIdx.x, nb = gridDim.x;
    const int vcu = (nb % 8 == 0) ? (bid % 8) * (nb / 8) + bid / 8 : bid;
#if ONE_LAUNCH
    if (threadIdx.x == 0) *(uint4*)(lds_raw + LDS_MAIN) = make_uint4(0u, 0u, 0u, 0u);
    __syncthreads();
    XcdBarrier bar = xcd_barrier_post(p.bar, (volatile LAS unsigned*)(ldsp + LDS_MAIN));
#define SEAM(k) do { if ((k) + 1 < p.ph_hi) xcd_barrier(bar); } while (0)
#else
#define SEAM(k) do { } while (0)
#endif
#define IN(k) (p.ph_lo <= (k) && (k) < p.ph_hi)
    if (IN(0)) { ph_prologue(p, bid, nb, smem); SEAM(0); }
    for (int l = 0; l < DEPTH; ++l) {
        const int k0 = 1 + l * PH_PER_LAYER;
        const int mrows = (l < DEPTH - 1) ? R : NLAT;
        if (IN(k0 + 0)) { ph_lnmod(p, l, bid, nb); SEAM(k0 + 0); }
        if (IN(k0 + 1)) {
            pg8::Gemm g{p.hb, p.WinT + (long)l * INP * D, R, INP, D}; pg8::StaticOrder S; S.init(R, INP, nb, bid);
            pg8::EpiF32 E{p.P, INC, INC};
            pg8::gemm_phase(ldsp, g, S, E); SEAM(k0 + 1);
        }
        if (IN(k0 + 2)) { ph_prep(p, l, bid, nb); SEAM(k0 + 2); }
        if (IN(k0 + 3)) {
            { pg8::Gemm g{p.cqn, p.WuqT + (long)l * 768 * 384, R, 768, 384}; pg8::StaticOrder S; S.init(R, 768, nb, bid); pg8::EpiBf16 E{p.Q2b, 768}; pg8::gemm_phase(ldsp, g, S, E); }
            { pg8::Gemm g{p.ckvn, p.WukvT + (long)l * 1024 * 256, R, 512, 256}; pg8::StaticOrder S; S.init(R, 512, nb, bid); pg8::EpiBf16 E{p.Kn, 512}; pg8::gemm_phase(ldsp, g, S, E); }
            { pg8::Gemm g{p.WukvT + (long)l * 1024 * 256 + 512 * 256, p.ckvn, 512, R, 256}; pg8::StaticOrder S; S.init(512, R, nb, bid); pg8::EpiBf16 E{p.VtM, R}; pg8::gemm_phase(ldsp, g, S, E); }
            SEAM(k0 + 3);
        }
        if (IN(k0 + 4)) { ph_mixers(p, l, bid, nb, smem, ldsp); SEAM(k0 + 4); }
        if (IN(k0 + 5)) { ph_mixpost(p, l, bid, nb); SEAM(k0 + 5); }
        if (IN(k0 + 6)) {
            pg8::Gemm g{p.mix, p.WoutT + (long)l * D * D, mrows, D, D}; pg8::StaticOrder S; S.init(mrows, D, nb, bid);
            pg8::EpiF32 E{p.ob, D, D};
            pg8::gemm_phase(ldsp, g, S, E); SEAM(k0 + 6);
        }
        if (IN(k0 + 7)) { ph_post1(p, l, bid, nb, smem); SEAM(k0 + 7); }
        if (IN(k0 + 8)) { ph_sort(p, l, bid, (int*)smem); SEAM(k0 + 8); }
        if (IN(k0 + 9)) { ph_gather(p, bid, nb); SEAM(k0 + 9); }
        if (IN(k0 + 10)) {
            pg8::Gemm g{p.xs, p.W13T + (long)l * NEXP * 1024 * D, NSLOT, 1024, D};
            pg8::MoeOrder S{4, p.tile_e[NTILE] * 4, nb, vcu, (size_t)1024 * D * 2, p.tile_e};
            pg8::EpiSwiglu E{p.act, FF};
            pg8::gemm_phase(ldsp, g, S, E); SEAM(k0 + 10);
        }
        if (IN(k0 + 11)) {
            pg8::Gemm g{p.act, p.W2T + (long)l * NEXP * D * FF, NSLOT, D, FF};
            pg8::MoeOrder S{8, p.tile_e[NTILE] * 8, nb, vcu, (size_t)D * FF * 2, p.tile_e};
            pg8::EpiF32 E{p.Ys, D, D};
            pg8::gemm_phase(ldsp, g, S, E); SEAM(k0 + 11);
        }
        if (IN(k0 + 12)) { ph_post2(p, l, bid, nb); SEAM(k0 + 12); }
    }
}

static inline size_t al256(size_t v) { return (v + 255) & ~(size_t)255; }

extern "C" void kernel_launch(void* const* d_in, const int* in_sizes, int n_in, void* d_out, int out_size, void* d_ws, size_t ws_size, hipStream_t stream) {
    static int grid = 0;
    if (grid == 0) {
        int dev = 0, cus = 0, per_cu = 0;
        hipGetDevice(&dev);
        hipDeviceGetAttribute(&cus, hipDeviceAttributeMultiprocessorCount, dev);
        hipFuncSetAttribute((const void*)fwd, hipFuncAttributeMaxDynamicSharedMemorySize, LDS_BYTES);
        hipOccupancyMaxActiveBlocksPerMultiprocessor(&per_cu, (const void*)fwd, NTH, LDS_BYTES);
        (void)hipGetLastError();
        if (cus <= 0) cus = 256;
        grid = cus;
        if (per_cu < 1) fprintf(stderr, "kernel_launch: occupancy query reports %d\n", per_cu);
    }
    Params p{};
    const float* const* in = (const float* const*)d_in;
    p.x = in[0]; p.c = in[1]; p.ctx = in[2]; p.c_ctx = in[3]; p.w_ada = in[4]; p.b_ada = in[5]; p.w_in = in[6]; p.swa_sink = in[7];
    p.ret_s = in[8]; p.ret_gn = in[9]; p.q_norm = in[10]; p.kv_norm = in[11]; p.w_uq = in[12]; p.w_ukv = in[13]; p.lb_logits = in[14];
    p.hgrn_gn = in[15]; p.w_out = in[16]; p.ln1_g = in[17]; p.ln1_b = in[18]; p.w_rg = in[19]; p.w_re = in[20]; p.w1 = in[21]; p.w3 = in[22];
    p.w2 = in[23]; p.ln2_g = in[24]; p.ln2_b = in[25];
    p.out = (float*)d_out;
    unsigned char* ws = (unsigned char*)d_ws; size_t off = 0;
    auto carve = [&](size_t bytes) { unsigned char* q = ws + off; off = al256(off + bytes); return q; };
    p.bar = (unsigned*)carve(XCD_BAR_WORDS * 4);
    p.modv = (float*)carve((size_t)DEPTH * 3 * 6 * D * 4);
    p.xc = (float*)carve((size_t)R * D * 4);
    p.hb = (bf16_t*)carve((size_t)R * D * 2);
    p.P = (float*)carve((size_t)R * INC * 4);
    p.Ys = p.P;
    p.cqn = (bf16_t*)carve((size_t)R * 384 * 2);
    p.ckvn = (bf16_t*)carve((size_t)R * 256 * 2);
    p.Q2b = (bf16_t*)carve((size_t)R * 768 * 2);
    p.Kn = (bf16_t*)carve((size_t)R * 512 * 2);
    p.VtM = (bf16_t*)carve((size_t)512 * R * 2);
    p.Krb = (bf16_t*)carve((size_t)R * 64 * 2);
    p.sqb = (bf16_t*)carve((size_t)R * 512 * 2);
    p.skb = (bf16_t*)carve((size_t)R * 256 * 2);
    p.svT = (bf16_t*)carve((size_t)256 * R * 2);
    p.oscan = (float*)carve((size_t)4 * R * 512 * 4);
    p.mix = (bf16_t*)carve((size_t)R * D * 2);
    p.ob = (float*)carve((size_t)R * D * 4);
    p.xs = (bf16_t*)carve((size_t)NSLOT * D * 2);
    p.act = (bf16_t*)carve((size_t)NSLOT * FF * 2);
    p.gate = (float*)carve((size_t)R * 2 * 4);
    p.eid = (int*)carve((size_t)R * 2 * 4);
    p.slot_of = (int*)carve((size_t)R * 2 * 4);
    p.slot_tok = (int*)carve((size_t)NSLOT * 4);
    p.tile_e = (int*)carve((size_t)(NTILE + 1) * 4);
    p.WinT = (bf16_t*)carve((size_t)DEPTH * INP * D * 2);
    p.WoutT = (bf16_t*)carve((size_t)DEPTH * D * D * 2);
    p.WuqT = (bf16_t*)carve((size_t)DEPTH * 768 * 384 * 2);
    p.WukvT = (bf16_t*)carve((size_t)DEPTH * 1024 * 256 * 2);
    p.W13T = (bf16_t*)carve((size_t)DEPTH * NEXP * 1024 * D * 2);
    p.W2T = (bf16_t*)carve((size_t)DEPTH * NEXP * D * FF * 2);
    if (off > ws_size) { fprintf(stderr, "kernel_launch: workspace too small: need %zu have %zu\n", off, ws_size); return; }
    hipMemsetAsync(p.bar, 0, XCD_BAR_WORDS * 4, stream);
#if ONE_LAUNCH
    p.ph_lo = 0; p.ph_hi = N_PHASES;
    hipLaunchKernelGGL(fwd, dim3(grid), dim3(NTH), LDS_BYTES, stream, p);
#else
    for (int k = 0; k < N_PHASES; ++k) {
        p.ph_lo = k; p.ph_hi = k + 1;
        hipLaunchKernelGGL(fwd, dim3(grid), dim3(NTH), LDS_BYTES, stream, p);
    }
#endif
}
```

```cpp
#include <hip/hip_runtime.h>
#include <cstdio>
#include <cstdint>

#ifndef DIAG_NAIVE
#define DIAG_NAIVE 0
#endif
#ifndef DUPMASK
#define DUPMASK 0
#endif
#ifndef ONE_LAUNCH
#define ONE_LAUNCH 1
#endif

constexpr int D = 2048, NBATCH = 2, T = 4096, LCTX = 256, DEPTH = 2;
constexpr int NLAT = NBATCH * T, NCTX = NBATCH * LCTX, R = NLAT + NCTX;
constexpr int INC = 6208;
constexpr int SQ = 0, SK = 512, SV = 768, RQ = 1024, RK = 1536, RV = 2048, RG = 2560, CQ = 3072, CKV = 3456, KR = 3584,
              HQ = 3648, HFF = 4160, HFB = 4672, HI = 5184, HG = 5696;
constexpr int NEXP = 32, FF = 512;
constexpr int NSLOT = 25600, NTILE = NSLOT / 256;
constexpr int INP = 6400;
constexpr float EPS = 1e-6f;
constexpr float ALPHA = 1.41421356237309515f;
constexpr int NTH = 512, NWV = 8;

typedef float f32x16 __attribute__((ext_vector_type(16)));
typedef unsigned short bf16_t;
typedef short bf16x8 __attribute__((ext_vector_type(8)));
typedef float f32x4 __attribute__((ext_vector_type(4)));
typedef unsigned u32x4 __attribute__((ext_vector_type(4)));
typedef unsigned u32x2 __attribute__((ext_vector_type(2)));

#define XB_TMO      128
#define XB_XCNT(j)  (256  + 64 * (j))
#define XB_XSUB(j)  (1280 + 64 * (j))
#define XB_XGEN(j)  (2304 + 64 * (j))
#define XB_TOP      3328
#define XB_TOPGEN   3392
#define XCD_BAR_WORDS 3456
#define XB_SPIN_CAP (1u << 18)
#define LAS __attribute__((address_space(3)))

__device__ __forceinline__ unsigned xb_ld(unsigned* p)              { return __hip_atomic_load(p, __ATOMIC_RELAXED, __HIP_MEMORY_SCOPE_AGENT); }
__device__ __forceinline__ unsigned xb_add(unsigned* p, unsigned v) { return __hip_atomic_fetch_add(p, v, __ATOMIC_RELAXED, __HIP_MEMORY_SCOPE_AGENT); }
__device__ __forceinline__ unsigned xb_xcc_id() { return (unsigned)__builtin_amdgcn_s_getreg((3 << 11) | 20) & 0xFu; }
#define XB_SPIN(cond, bar) do { unsigned _sp = 0; while (cond) { __builtin_amdgcn_s_sleep(1); \
    if ((++_sp & 255u) == 0u) { if (xb_ld(&(bar)[XB_TMO])) break; if (_sp > XB_SPIN_CAP) { atomicAdd(&(bar)[XB_TMO], 1u); break; } } } } while (0)

struct XcdBarrier { unsigned* bar; unsigned x; volatile LAS unsigned* st; };

__device__ __forceinline__ XcdBarrier xcd_barrier_post(unsigned* bar, volatile LAS unsigned* st) {
    XcdBarrier b; b.bar = bar; b.x = xb_xcc_id(); b.st = st;
    if (threadIdx.x == 0) (void)xb_add(&bar[XB_XCNT(b.x)], 1u);
    return b;
}
__device__ __forceinline__ void xcd_barrier_complete(unsigned* bar, unsigned x, unsigned& nloc, unsigned& nx) {
    const unsigned G = gridDim.x * gridDim.y * gridDim.z;
    unsigned sum, cnt, mine, sp = 0u;
    for (;;) {
        sum = 0u; cnt = 0u; mine = 0u;
#pragma unroll
        for (unsigned j = 0; j < 16; ++j) { const unsigned c = xb_ld(&bar[XB_XCNT(j)]); sum += c; cnt += (c > 0u) ? 1u : 0u; mine = (j == x) ? c : mine; }
        if (sum == G) break;
        __builtin_amdgcn_s_sleep(1);
        if ((++sp & 255u) == 0u) { if (xb_ld(&bar[XB_TMO])) break; if (sp > XB_SPIN_CAP) { atomicAdd(&bar[XB_TMO], 1u); break; } }
    }
    nloc = mine > 0u ? mine : 1u; nx = cnt > 0u ? cnt : 1u;
}
__device__ __forceinline__ void xcd_barrier(const XcdBarrier& b) {
    asm volatile("s_waitcnt vmcnt(0)" ::: "memory");
    __syncthreads();
    if (threadIdx.x == 0) {
        unsigned* bar = b.bar;
        __builtin_amdgcn_s_waitcnt(0);
        unsigned nloc = b.st[0], nx = b.st[1];
        if (nloc == 0u) { xcd_barrier_complete(bar, b.x, nloc, nx); b.st[0] = nloc; b.st[1] = nx; }
        const unsigned old = xb_add(&bar[XB_XSUB(b.x)], 1u);
        const unsigned gen = old / nloc;
        if (old + 1u == (gen + 1u) * nloc) {
            __builtin_amdgcn_fence(__ATOMIC_RELEASE, "agent");
            asm volatile("s_waitcnt vmcnt(0)" ::: "memory");
            const unsigned og = xb_add(&bar[XB_TOP], 1u);
            const unsigned tg = og / nx;
            if (og + 1u == (tg + 1u) * nx) xb_add(&bar[XB_TOPGEN], 1u);
            else XB_SPIN(xb_ld(&bar[XB_TOPGEN]) == tg, bar);
            __builtin_amdgcn_fence(__ATOMIC_ACQUIRE, "agent");
            xb_add(&bar[XB_XGEN(b.x)], 1u);
            asm volatile("s_waitcnt vmcnt(0)" ::: "memory");
        } else {
            XB_SPIN(xb_ld(&bar[XB_XGEN(b.x)]) == gen, bar);
            __builtin_amdgcn_fence(__ATOMIC_ACQUIRE, "agent");
            asm volatile("s_waitcnt vmcnt(0)" ::: "memory");
        }
    }
    __syncthreads();
}

struct Params {
    const float *x, *c, *ctx, *c_ctx, *w_ada, *b_ada, *w_in, *swa_sink, *ret_s, *ret_gn, *q_norm, *kv_norm, *w_uq, *w_ukv,
                *lb_logits, *hgrn_gn, *w_out, *ln1_g, *ln1_b, *w_rg, *w_re, *w1, *w3, *w2, *ln2_g, *ln2_b;
    float* out;
    unsigned* bar;
    float *modv, *xc, *P, *sst, *sA, *ob, *Ys, *gate;
    bf16_t *hb, *cqn, *ckvn, *mix, *xs, *act, *Q2b, *Kn, *VtM, *Krb, *sqb, *skb, *svT;
    bf16_t *WinT, *WoutT, *WuqT, *WukvT, *W13T, *W2T;
    int *eid, *slot_of, *slot_tok, *tile_e;
    int ph_lo, ph_hi;
};

__device__ __forceinline__ int otid() { int t = threadIdx.x; asm volatile("" : "+v"(t)); return t; }
__device__ __forceinline__ float wsum(float v) {
#pragma unroll
    for (int o = 32; o > 0; o >>= 1) v += __shfl_xor(v, o);
    return v;
}
__device__ __forceinline__ float siluf(float v) { return v / (1.0f + expf(-v)); }
__device__ __forceinline__ float sigmf(float v) { return 1.0f / (1.0f + expf(-v)); }
__device__ __forceinline__ int mod_row(int r) { return r < NLAT ? (r >= T ? 1 : 0) : 2; }
__device__ __forceinline__ float4 ld4(const float* p) { return *(const float4*)p; }
__device__ __forceinline__ bf16_t f2bf(float f) { unsigned u = __float_as_uint(f); u += 0x7FFFu + ((u >> 16) & 1u); return (bf16_t)(u >> 16); }
__device__ __forceinline__ unsigned cvt_pk_bf16(float lo, float hi) { unsigned r; asm volatile("v_cvt_pk_bf16_f32 %0, %1, %2" : "=v"(r) : "v"(lo), "v"(hi)); return r; }
__device__ __forceinline__ void st4(float* p, float4 v) { *(float4*)p = v; }

namespace pg8 {
constexpr int BM = 256, BK = 64, HALF = 128, HTB = HALF * BK * 2, STAGE_BYTES = 8 * HTB, NXCD = 8, WGM = 8;
__host__ __device__ __forceinline__ int lds_byte(int r, int c) { const int st = (r >> 4) * 2 + (c >> 5), rr = r & 15, cc = c & 31, ob = rr * 64 + cc * 2; return st * 1024 + (ob ^ (((ob >> 9) & 1) << 5)); }
__host__ __device__ __forceinline__ void stage_rc(int b, int& R, int& C) { const int st = b / 1024, sb = b % 1024, swz = sb ^ (((sb >> 9) & 1) << 5); R = (st >> 1) * 16 + swz / 64; C = (st & 1) * 32 + (swz % 64) / 2; }
struct Unit { int pm, pn; };
struct Gemm { const bf16_t* A; const bf16_t* Bt; int M, N, K; };
struct StaticOrder {
    int nM, nN, nwg, G, c;
    __device__ void init(int M, int N, int G_, int c_) { nM = M / BM; nN = N / BM; nwg = nM * nN; G = G_; c = c_; }
    __device__ bool next(int i, Unit& u) const {
        const long L = (long)i * G + c; if (L >= nwg) return false;
        int wgid = (int)L; { const int q = nwg / NXCD, r = nwg % NXCD, xcd = wgid % NXCD, off = wgid / NXCD; wgid = (xcd < r ? xcd * (q + 1) : r * (q + 1) + (xcd - r) * q) + off; }
        const int nig = WGM * nN, gid = wgid / nig, fm = gid * WGM, gsz = (nM - fm) < WGM ? (nM - fm) : WGM;
        u.pm = fm + ((wgid % nig) % gsz); u.pn = (wgid % nig) / gsz; return true;
    }
    __device__ __forceinline__ size_t boff(const Unit& u, size_t tstep) const { return (size_t)u.pn * tstep; }
};
struct MoeOrder {
    int npn, nunits, G, c; size_t estride; const int* tile_e;
    __device__ bool next(int i, Unit& u) const { const long L = (long)i * G + c; if (L >= nunits) return false; u.pm = (int)(L / npn); u.pn = (int)(L % npn); return true; }
    __device__ __forceinline__ size_t boff(const Unit& u, size_t tstep) const { return (size_t)tile_e[u.pm] * estride + (size_t)u.pn * tstep; }
};
struct EpiF32 {
    float* C; int ldc; int ncols;
    __device__ __forceinline__ void operator()(const f32x4 (&acc)[2][2][4][2], const Unit& u, int wr, int wc, int fr, int fq) const {
        const int row0 = u.pm * BM + wr * 64 + fr, col0 = u.pn * BM + wc * 32 + 4 * fq;
#pragma unroll
        for (int ai = 0; ai < 2; ++ai)
#pragma unroll
            for (int m = 0; m < 4; ++m) { float* rowp = C + (size_t)(row0 + ai * HALF + m * 16) * ldc + col0;
#pragma unroll
                for (int bj = 0; bj < 2; ++bj)
#pragma unroll
                    for (int n = 0; n < 2; ++n) if (col0 + bj * HALF + n * 16 < ncols) *(f32x4*)(rowp + bj * HALF + n * 16) = acc[ai][bj][m][n]; }
    }
};
struct EpiBf16 {
    bf16_t* O; int ldc;
    __device__ __forceinline__ void operator()(const f32x4 (&acc)[2][2][4][2], const Unit& u, int wr, int wc, int fr, int fq) const {
        const int row0 = u.pm * BM + wr * 64 + fr, col0 = u.pn * BM + wc * 32 + 4 * fq;
#pragma unroll
        for (int ai = 0; ai < 2; ++ai)
#pragma unroll
            for (int m = 0; m < 4; ++m) { bf16_t* rowp = O + (size_t)(row0 + ai * HALF + m * 16) * ldc + col0;
#pragma unroll
                for (int bj = 0; bj < 2; ++bj)
#pragma unroll
                    for (int n = 0; n < 2; ++n) { const f32x4 v = acc[ai][bj][m][n]; u32x2 w; w.x = cvt_pk_bf16(v[0], v[1]); w.y = cvt_pk_bf16(v[2], v[3]); *(u32x2*)(rowp + bj * HALF + n * 16) = w; } }
    }
};
struct EpiSwiglu {
    bf16_t* O; int ldc;
    __device__ __forceinline__ void operator()(const f32x4 (&acc)[2][2][4][2], const Unit& u, int wr, int wc, int fr, int fq) const {
        const int row0 = u.pm * BM + wr * 64 + fr, col0 = u.pn * HALF + wc * 32 + 4 * fq;
#pragma unroll
        for (int ai = 0; ai < 2; ++ai)
#pragma unroll
            for (int m = 0; m < 4; ++m) { bf16_t* rowp = O + (size_t)(row0 + ai * HALF + m * 16) * ldc + col0;
#pragma unroll
                for (int n = 0; n < 2; ++n) { const f32x4 g = acc[ai][0][m][n], v = acc[ai][1][m][n]; float r[4];
#pragma unroll
                    for (int j = 0; j < 4; ++j) r[j] = g[j] / (1.0f + __expf(-g[j])) * v[j];
                    u32x2 w; w.x = cvt_pk_bf16(r[0], r[1]); w.y = cvt_pk_bf16(r[2], r[3]); *(u32x2*)(rowp + n * 16) = w; } }
    }
};
template <class Epi, class Sched>
__device__ __forceinline__ void gemm_phase(LAS unsigned char* lds, const Gemm g, const Sched& S, const Epi& E) {
    const int tid = otid(), wid = __builtin_amdgcn_readfirstlane(tid >> 6), lane = tid & 63, wr = wid >> 2, wc = wid & 3, fr = lane & 15, fq = lane >> 4;
    const int K = g.K, nt = K / BK;
    unsigned voffA[2], voffB[2];
#pragma unroll
    for (int i = 0; i < 2; ++i) { int R_, C_; stage_rc(tid * 16 + i * 8192, R_, C_); voffA[i] = (unsigned)(R_ * K + C_) * 2u; voffB[i] = voffA[i]; }
    const size_t kstep = (size_t)(BK * 2);
    const size_t hstep = (size_t)HALF * K * 2;
    const size_t tstep = 2 * hstep;
    const unsigned ldsw = (unsigned)wid * 1024u;
    const int aoff = lds_byte(wr * 64 + fr, fq * 8), boff = lds_byte(wc * 32 + fr, fq * 8);
#define PG8_SA(b, h) (((b) * 2 + (h)) * HTB)
#define PG8_SB(b, h) ((4 + (b) * 2 + (h)) * HTB)
#define PG8_STAGE(bufoff, gbase, voff) do { _Pragma("unroll") for (int _i = 0; _i < 2; ++_i) \
        __builtin_amdgcn_global_load_lds((const unsigned*)((const char*)(gbase) + (voff)[_i]), (LAS unsigned*)(lds + (bufoff) + ldsw + _i * 8192), 16, 0, 0); } while (0)
#define PG8_LDA(dst, b, h) do { _Pragma("unroll") for (int m = 0; m < 4; ++m) _Pragma("unroll") for (int k = 0; k < 2; ++k) dst[m][k] = *(const LAS bf16x8*)(lds + PG8_SA(b, h) + aoff + m * 2048 + k * 1024); } while (0)
#define PG8_LDB(dst, b, h) do { _Pragma("unroll") for (int n = 0; n < 2; ++n) _Pragma("unroll") for (int k = 0; k < 2; ++k) dst[n][k] = *(const LAS bf16x8*)(lds + PG8_SB(b, h) + boff + n * 2048 + k * 1024); } while (0)
#define PG8_MMA(ai, bj, At, Bt) do { __builtin_amdgcn_s_setprio(1); _Pragma("unroll") for (int m = 0; m < 4; ++m) _Pragma("unroll") for (int n = 0; n < 2; ++n) _Pragma("unroll") for (int k = 0; k < 2; ++k) \
        acc[ai][bj][m][n] = __builtin_amdgcn_mfma_f32_16x16x32_bf16(Bt[n][k], At[m][k], acc[ai][bj][m][n], 0, 0, 0); __builtin_amdgcn_s_setprio(0); } while (0)
#define PG8_WAIT_V(n) asm volatile("s_waitcnt vmcnt(" #n ")" ::: "memory")
#define PG8_WAIT_L(n) asm volatile("s_waitcnt lgkmcnt(" #n ")" ::: "memory")
#define PG8_BAR __builtin_amdgcn_s_barrier()
#define PG8_SCHED __builtin_amdgcn_sched_barrier(0)
    Unit cur, nxt; int ui = 0;
    if (!S.next(0, cur)) return;
    f32x4 acc[2][2][4][2];
#pragma unroll
    for (int a = 0; a < 2; ++a)
#pragma unroll
        for (int b = 0; b < 2; ++b)
#pragma unroll
            for (int m = 0; m < 4; ++m)
#pragma unroll
                for (int n = 0; n < 2; ++n) acc[a][b][m][n] = (f32x4){0.f, 0.f, 0.f, 0.f};
    bf16x8 At[4][2], B0[2][2], B1[2][2];
    const char* cA = (const char*)g.A + (size_t)cur.pm * tstep; const char* cB = (const char*)g.Bt + S.boff(cur, tstep);
    PG8_STAGE(PG8_SB(0, 0), cB, voffB); PG8_STAGE(PG8_SA(0, 0), cA, voffA); PG8_STAGE(PG8_SB(0, 1), cB + hstep, voffB); PG8_STAGE(PG8_SA(0, 1), cA + hstep, voffA);
    if (wr == 1) PG8_BAR;
    PG8_WAIT_V(4); PG8_BAR;
    PG8_STAGE(PG8_SB(1, 0), cB + kstep, voffB); PG8_STAGE(PG8_SA(1, 0), cA + kstep, voffA); PG8_STAGE(PG8_SB(1, 1), cB + hstep + kstep, voffB);
    PG8_WAIT_V(6); PG8_BAR;
    for (;;) {
        const bool has_next = S.next(ui + 1, nxt);
        const char* nA = has_next ? (const char*)g.A + (size_t)nxt.pm * tstep : cA; const char* nB = has_next ? (const char*)g.Bt + S.boff(nxt, tstep) : cB;
        for (int t = 0; t < nt; t += 2) {
            const bool last = (t == nt - 2);
            const char* a1 = cA + (size_t)(t + 1) * kstep;
            const char* a2 = last ? nA : cA + (size_t)(t + 2) * kstep; const char* b2 = last ? nB : cB + (size_t)(t + 2) * kstep;
            const char* a3 = a2 + kstep; const char* b3 = b2 + kstep;
            PG8_LDB(B0, 0, 0); PG8_SCHED; PG8_LDA(At, 0, 0); PG8_STAGE(PG8_SA(1, 1), a1 + hstep, voffA);
            PG8_WAIT_L(8); PG8_BAR; PG8_WAIT_L(0); PG8_MMA(0, 0, At, B0); PG8_BAR; PG8_SCHED;
            PG8_LDB(B1, 0, 1); PG8_STAGE(PG8_SB(0, 0), b2, voffB);
            PG8_BAR; PG8_WAIT_L(0); PG8_MMA(0, 1, At, B1); PG8_BAR;
            PG8_LDA(At, 0, 1); PG8_STAGE(PG8_SA(0, 0), a2, voffA);
            PG8_BAR; PG8_WAIT_L(0); PG8_MMA(1, 0, At, B0); PG8_BAR; PG8_SCHED;
            PG8_STAGE(PG8_SB(0, 1), b2 + hstep, voffB);
            PG8_WAIT_V(6); PG8_BAR; PG8_MMA(1, 1, At, B1); PG8_BAR;
            PG8_LDB(B0, 1, 0); PG8_SCHED; PG8_LDA(At, 1, 0); PG8_STAGE(PG8_SA(0, 1), a2 + hstep, voffA);
            PG8_WAIT_L(8); PG8_BAR; PG8_WAIT_L(0); PG8_MMA(0, 0, At, B0); PG8_BAR; PG8_SCHED;
            PG8_LDB(B1, 1, 1); PG8_STAGE(PG8_SB(1, 0), b3, voffB);
            PG8_BAR; PG8_WAIT_L(0); PG8_MMA(0, 1, At, B1); PG8_BAR;
            PG8_LDA(At, 1, 1); PG8_STAGE(PG8_SA(1, 0), a3, voffA);
            PG8_BAR; PG8_WAIT_L(0); PG8_MMA(1, 0, At, B0); PG8_BAR; PG8_SCHED;
            PG8_STAGE(PG8_SB(1, 1), b3 + hstep, voffB);
            PG8_WAIT_V(6); PG8_BAR; PG8_MMA(1, 1, At, B1); PG8_BAR;
        }
        E(acc, cur, wr, wc, fr, fq);
        if (!has_next) break;
#pragma unroll
        for (int a = 0; a < 2; ++a)
#pragma unroll
            for (int b = 0; b < 2; ++b)
#pragma unroll
                for (int m = 0; m < 4; ++m)
#pragma unroll
                    for (int n = 0; n < 2; ++n) acc[a][b][m][n] = (f32x4){0.f, 0.f, 0.f, 0.f};
        cur = nxt; cA = nA; cB = nB; ++ui;
    }
    PG8_WAIT_V(0);
    if (wr == 0) PG8_BAR;
    PG8_BAR;
#undef PG8_SA
#undef PG8_SB
#undef PG8_STAGE
#undef PG8_LDA
#undef PG8_LDB
#undef PG8_MMA
#undef PG8_WAIT_V
#undef PG8_WAIT_L
#undef PG8_BAR
#undef PG8_SCHED
}
}

struct ConvDesc { const float* src; bf16_t* dst; int K, N, ldk, nblk, nmul, noff, nmat; long sstride, dstride; };
__device__ __forceinline__ void conv_wT(const ConvDesc& d, int bid, int nb, float* smem) {
    const int tid = otid();
    const int tk = d.K / 64, tn = d.N / 64, per = tk * tn;
    for (int u = bid; u < d.nmat * per; u += nb) {
        const int mat = u / per, t = u % per, kt = t / tn, ntl = t % tn;
        const float* s = d.src + (long)mat * d.sstride + (long)(kt * 64) * d.N + ntl * 64;
        __syncthreads();
#pragma unroll
        for (int ps = 0; ps < 2; ++ps) {
            const int kk = (tid >> 4) + ps * 32, n4 = (tid & 15) * 4;
            const float4 v = ld4(s + (long)kk * d.N + n4);
            smem[kk * 65 + n4 + 0] = v.x; smem[kk * 65 + n4 + 1] = v.y; smem[kk * 65 + n4 + 2] = v.z; smem[kk * 65 + n4 + 3] = v.w;
        }
        __syncthreads();
        const int n = tid >> 3, k8 = (tid & 7) * 8;
        u32x4 w;
        w.x = cvt_pk_bf16(smem[(k8 + 0) * 65 + n], smem[(k8 + 1) * 65 + n]); w.y = cvt_pk_bf16(smem[(k8 + 2) * 65 + n], smem[(k8 + 3) * 65 + n]);
        w.z = cvt_pk_bf16(smem[(k8 + 4) * 65 + n], smem[(k8 + 5) * 65 + n]); w.w = cvt_pk_bf16(smem[(k8 + 6) * 65 + n], smem[(k8 + 7) * 65 + n]);
        const int gn = ntl * 64 + n;
        const int drow = (d.nblk < 0) ? (((gn >> 7) & 1) * 512 + (gn >> 8) * 128 + (gn & 127)) : ((gn / d.nblk) * d.nmul + d.noff + gn % d.nblk);
        *(u32x4*)(d.dst + (long)mat * d.dstride + (long)drow * d.ldk + kt * 64 + k8) = w;
    }
}

__device__ __forceinline__ void ph_prologue(const Params& p, int bid, int nb, float* smem) {
    const int tid = otid();
    {
        const long n4 = (long)R * D / 4, nl4 = (long)NLAT * D / 4;
        for (long i = (long)bid * NTH + tid; i < n4; i += (long)nb * NTH) {
            float4 v = (i < nl4) ? ld4(p.x + i * 4) : ld4(p.ctx + (i - nl4) * 4);
            st4(p.xc + i * 4, v);
        }
    }
    {
        const ConvDesc c_in{p.w_in, p.WinT, D, INC, D, 1 << 30, 0, 0, DEPTH, (long)D * INC, (long)INP * D};
        conv_wT(c_in, bid, nb, smem);
        const ConvDesc c_out{p.w_out, p.WoutT, D, D, D, 1 << 30, 0, 0, DEPTH, (long)D * D, (long)D * D};
        conv_wT(c_out, bid, nb, smem);
        const ConvDesc c_uq{p.w_uq, p.WuqT, 384, 768, 384, 1 << 30, 0, 0, DEPTH, 384L * 768, 768L * 384};
        conv_wT(c_uq, bid, nb, smem);
        const ConvDesc c_ukv{p.w_ukv, p.WukvT, 128, 1024, 256, -1, 0, 0, DEPTH, 128L * 1024, 1024L * 256};
        conv_wT(c_ukv, bid, nb, smem);
        const ConvDesc c_w1{p.w1, p.W13T, D, FF, D, 128, 256, 0, DEPTH * NEXP, (long)D * FF, 1024L * D};
        conv_wT(c_w1, bid, nb, smem);
        const ConvDesc c_w3{p.w3, p.W13T, D, FF, D, 128, 256, 128, DEPTH * NEXP, (long)D * FF, 1024L * D};
        conv_wT(c_w3, bid, nb, smem);
        const ConvDesc c_w2{p.w2, p.W2T, FF, D, FF, 1 << 30, 0, 0, DEPTH * NEXP, (long)FF * D, (long)D * FF};
        conv_wT(c_w2, bid, nb, smem);
        const u32x4 z = {0u, 0u, 0u, 0u};
        for (long i = (long)bid * NTH + tid; i < (long)DEPTH * (INP - INC) * D / 8; i += (long)nb * NTH) {
            const long per = (long)(INP - INC) * D / 8; const int l = (int)(i / per); const long o = i % per;
            *(u32x4*)(p.WinT + (long)l * INP * D + (long)INC * D + o * 8) = z;
        }
        for (long i = (long)bid * NTH + tid; i < (long)DEPTH * 1024 * 16; i += (long)nb * NTH) {
            const long row = i / 16; const int c8 = (int)(i % 16) * 8;
            *(u32x4*)(p.WukvT + row * 256 + 128 + c8) = z;
        }
    }
    for (int u = bid; u < DEPTH * 24; u += nb) {
        const int l = u / 24, jb = u % 24;
        __syncthreads();
        for (int i = tid; i < 3 * D; i += NTH) {
            const int r = i / D, k = i % D;
            const float cv = (r < 2) ? p.c[r * D + k] : p.c_ctx[k];
            smem[i] = siluf(cv);
        }
        __syncthreads();
        const int j = jb * NTH + tid;
        const float* w = p.w_ada + (long)l * D * (6 * D) + j;
        float a0 = 0.f, a1 = 0.f, a2 = 0.f;
#pragma unroll 8
        for (int k = 0; k < D; ++k) {
            const float wv = w[(long)k * (6 * D)];
            a0 = fmaf(smem[k], wv, a0); a1 = fmaf(smem[D + k], wv, a1); a2 = fmaf(smem[2 * D + k], wv, a2);
        }
        const float bv = p.b_ada[l * 6 * D + j];
        float* mv = p.modv + (long)l * 3 * 6 * D;
        mv[0 * 6 * D + j] = a0 + bv; mv[1 * 6 * D + j] = a1 + bv; mv[2 * 6 * D + j] = a2 + bv;
    }
}

struct Row { float4 v[8]; };
__device__ __forceinline__ void row_load(Row& r, const float* p, int lane) {
#pragma unroll
    for (int i = 0; i < 8; ++i) r.v[i] = ld4(p + (i * 64 + lane) * 4);
}
__device__ __forceinline__ void row_store(const Row& r, float* p, int lane) {
#pragma unroll
    for (int i = 0; i < 8; ++i) st4(p + (i * 64 + lane) * 4, r.v[i]);
}
__device__ __forceinline__ void row_store_bf16(const Row& r, bf16_t* p, int lane) {
#pragma unroll
    for (int i = 0; i < 8; ++i) { u32x2 w; w.x = cvt_pk_bf16(r.v[i].x, r.v[i].y); w.y = cvt_pk_bf16(r.v[i].z, r.v[i].w); *(u32x2*)(p + (i * 64 + lane) * 4) = w; }
}
__device__ __forceinline__ void row_stats(const Row& r, float& mean, float& rstd) {
    float s = 0.f;
#pragma unroll
    for (int i = 0; i < 8; ++i) s += (r.v[i].x + r.v[i].y) + (r.v[i].z + r.v[i].w);
    mean = wsum(s) * (1.0f / D);
    float q = 0.f;
#pragma unroll
    for (int i = 0; i < 8; ++i) { const float a = r.v[i].x - mean, b = r.v[i].y - mean, c = r.v[i].z - mean, d = r.v[i].w - mean; q += (a * a + b * b) + (c * c + d * d); }
    rstd = rsqrtf(wsum(q) * (1.0f / D) + EPS);
}
__device__ __forceinline__ void row_modulate(Row& r, float mean, float rstd, const float* sh, const float* sc, int lane) {
#pragma unroll
    for (int i = 0; i < 8; ++i) {
        const int c = (i * 64 + lane) * 4;
        const float4 s = ld4(sc + c), h = ld4(sh + c);
        r.v[i].x = (r.v[i].x - mean) * rstd * (1.f + s.x) + h.x; r.v[i].y = (r.v[i].y - mean) * rstd * (1.f + s.y) + h.y;
        r.v[i].z = (r.v[i].z - mean) * rstd * (1.f + s.z) + h.z; r.v[i].w = (r.v[i].w - mean) * rstd * (1.f + s.w) + h.w;
    }
}
__device__ __forceinline__ void row_affine(Row& r, float mean, float rstd, const float* g, const float* b, int lane) {
#pragma unroll
    for (int i = 0; i < 8; ++i) {
        const int c = (i * 64 + lane) * 4;
        const float4 s = ld4(g + c), h = ld4(b + c);
        r.v[i].x = (r.v[i].x - mean) * rstd * s.x + h.x; r.v[i].y = (r.v[i].y - mean) * rstd * s.y + h.y;
        r.v[i].z = (r.v[i].z - mean) * rstd * s.z + h.z; r.v[i].w = (r.v[i].w - mean) * rstd * s.w + h.w;
    }
}

__device__ __forceinline__ void ph_lnmod(const Params& p, int l, int bid, int nb) {
    const int tid = otid(), lane = tid & 63, wid = tid >> 6;
    for (int r = bid * NWV + wid; r < R; r += nb * NWV) {
        Row x; row_load(x, p.xc + (long)r * D, lane);
        float mean, rstd; row_stats(x, mean, rstd);
        const float* mv = p.modv + ((long)l * 3 + mod_row(r)) * 6 * D;
        row_modulate(x, mean, rstd, mv + 0 * D, mv + 1 * D, lane);
        row_store_bf16(x, p.hb + (long)r * D, lane);
    }
}

__device__ __forceinline__ void ph_prep(const Params& p, int l, int bid, int nb) {
    const int tid = otid(), lane = tid & 63, wid = tid >> 6;
    for (int rr = 0; rr < 8 * (R / 64); ++rr) {
        const int grp = rr >> 3;
        const int g64 = bid + (grp) * nb; if (g64 >= R / 64) break;
        const int r = g64 * 64 + wid * 8 + (rr & 7);
        const float* pr = p.P + (long)r * INC;
        const bool lat = r < NLAT;
        const int t = r % T; const float rowi = (float)(t / 64), coli = (float)(t % 64);
        {
            float sn = 0.f, cs = 1.f;
            if (lat) { const int f = lane & 31; const float inv = powf(10000.0f, -(float)f / 32.0f); sincosf((lane < 32 ? rowi : coli) * inv, &sn, &cs); }
#pragma unroll
            for (int h = 0; h < 6; ++h) {
                const float x1 = pr[SQ + h * 128 + lane], x2 = pr[SQ + h * 128 + lane + 64];
                const bf16_t y1 = f2bf(x1 * cs - x2 * sn), y2 = f2bf(x2 * cs + x1 * sn);
                bf16_t* d = (h < 4) ? (p.sqb + (long)r * 512 + h * 128) : (p.skb + (long)r * 256 + (h - 4) * 128);
                d[lane] = y1; d[lane + 64] = y2;
            }
#pragma unroll
            for (int i = 0; i < 4; ++i) p.svT[(long)(i * 64 + lane) * R + r] = f2bf(pr[SV + i * 64 + lane]);
        }
        if (lane < 32) {
            float sn = 0.f, cs = 1.f;
            if (lat) { const int f = lane & 15; const float inv = powf(10000.0f, -(float)f / 16.0f); sincosf((lane < 16 ? rowi : coli) * inv, &sn, &cs); }
            const float x1 = pr[KR + lane], x2 = pr[KR + lane + 32];
            p.Krb[(long)r * 64 + lane] = f2bf(x1 * cs - x2 * sn); p.Krb[(long)r * 64 + lane + 32] = f2bf(x2 * cs + x1 * sn);
        }
        {
            float v[6]; float s = 0.f;
#pragma unroll
            for (int i = 0; i < 6; ++i) { v[i] = pr[CQ + i * 64 + lane]; s += v[i] * v[i]; }
            const float rs = rsqrtf(wsum(s) * (1.0f / 384.0f) + EPS);
#pragma unroll
            for (int i = 0; i < 6; ++i) p.cqn[(long)r * 384 + i * 64 + lane] = f2bf(v[i] * rs * p.q_norm[l * 384 + i * 64 + lane]);
            const float a = pr[CKV + lane], b = pr[CKV + 64 + lane];
            const float rs2 = rsqrtf(wsum(a * a + b * b) * (1.0f / 128.0f) + EPS);
            p.ckvn[(long)r * 256 + lane] = f2bf(a * rs2 * p.kv_norm[l * 128 + lane]);
            p.ckvn[(long)r * 256 + 64 + lane] = f2bf(b * rs2 * p.kv_norm[l * 128 + 64 + lane]);
            p.ckvn[(long)r * 256 + 128 + lane] = 0; p.ckvn[(long)r * 256 + 192 + lane] = 0;
        }
    }
}

struct AttnSrc {
    const bf16_t* Q; int ldq, qoff;
    const bf16_t* K1; int ldk1, k1off;
    const bf16_t* K2; int ldk2;
    const bf16_t* Vt; int ldv, voff;
    bf16_t* O; int ldo, ooff;
};
template <bool MLA>
__device__ __forceinline__ void attn_unit(const AttnSrc& a, int qrow0, int ctxrow0, int locrow0, int nloc, bool win, int tq0, int tk0, bool rope_q,
                                          float sink_l2, float c, LAS unsigned char* lds) {
    constexpr int KSTR = MLA ? 400 : 272, NKS = MLA ? 6 : 4, VSTR = 144, KBYTES = 64 * KSTR, BUFB = KBYTES + 128 * VSTR, NCH = MLA ? 5 : 4;
    const int tid = otid(), lane = tid & 63, wid = tid >> 6, fr = lane & 15, fq = lane >> 4;
    const int ntiles = 4 + nloc;
    bf16x8 qf[NKS];
    {
        const bf16_t* qp = a.Q + (long)(qrow0 + wid * 16 + fr) * a.ldq + a.qoff + fq * 8;
#pragma unroll
        for (int ks = 0; ks < NKS; ++ks) qf[ks] = *(const bf16x8*)(qp + ks * 32);
        if (MLA && rope_q) {
            const int t = tq0 + wid * 16 + fr; const float rowi = (float)(t / 64), coli = (float)(t % 64);
#pragma unroll
            for (int e = 0; e < 8; ++e) {
                const int i = fq * 8 + e, f = i & 15;
                const float inv = powf(10000.0f, -(float)f / 16.0f);
                const float ang = (i < 16 ? rowi : coli) * inv;
                float sn, cs; sincosf(ang, &sn, &cs);
                const float x1 = __uint_as_float(((unsigned)(unsigned short)qf[4][e]) << 16), x2 = __uint_as_float(((unsigned)(unsigned short)qf[5][e]) << 16);
                qf[4][e] = (short)f2bf(x1 * cs - x2 * sn); qf[5][e] = (short)f2bf(x2 * cs + x1 * sn);
            }
        }
    }
    f32x4 o[8];
#pragma unroll
    for (int dt = 0; dt < 8; ++dt) o[dt] = (f32x4){0.f, 0.f, 0.f, 0.f};
    float m = -INFINITY, l = 0.f;
    u32x4 rg[NCH];
#define ATT_LOAD(keyrow0) do { \
        const int kr_ = (keyrow0); \
        rg[0] = *(const u32x4*)(a.K1 + (long)(kr_ + (tid >> 4)) * a.ldk1 + a.k1off + (tid & 15) * 8); \
        rg[1] = *(const u32x4*)(a.K1 + (long)(kr_ + 32 + (tid >> 4)) * a.ldk1 + a.k1off + (tid & 15) * 8); \
        if (MLA) { rg[2] = *(const u32x4*)(a.K2 + (long)(kr_ + (tid >> 3)) * a.ldk2 + (tid & 7) * 8); \
                   rg[3] = *(const u32x4*)(a.Vt + (long)(a.voff + (tid >> 3)) * a.ldv + kr_ + (tid & 7) * 8); \
                   rg[NCH - 1] = *(const u32x4*)(a.Vt + (long)(a.voff + 64 + (tid >> 3)) * a.ldv + kr_ + (tid & 7) * 8); } \
        else { rg[2] = *(const u32x4*)(a.Vt + (long)(a.voff + (tid >> 3)) * a.ldv + kr_ + (tid & 7) * 8); \
               rg[NCH - 1] = *(const u32x4*)(a.Vt + (long)(a.voff + 64 + (tid >> 3)) * a.ldv + kr_ + (tid & 7) * 8); } } while (0)
#define ATT_STORE(buf) do { LAS unsigned char* b_ = (buf); \
        *(LAS u32x4*)(b_ + (tid >> 4) * KSTR + (tid & 15) * 16) = rg[0]; \
        *(LAS u32x4*)(b_ + (32 + (tid >> 4)) * KSTR + (tid & 15) * 16) = rg[1]; \
        if (MLA) { *(LAS u32x4*)(b_ + (tid >> 3) * KSTR + 256 + (tid & 7) * 16) = rg[2]; \
                   *(LAS u32x4*)(b_ + KBYTES + (tid >> 3) * VSTR + (tid & 7) * 16) = rg[3]; \
                   *(LAS u32x4*)(b_ + KBYTES + (64 + (tid >> 3)) * VSTR + (tid & 7) * 16) = rg[NCH - 1]; } \
        else { *(LAS u32x4*)(b_ + KBYTES + (tid >> 3) * VSTR + (tid & 7) * 16) = rg[2]; \
               *(LAS u32x4*)(b_ + KBYTES + (64 + (tid >> 3)) * VSTR + (tid & 7) * 16) = rg[NCH - 1]; } } while (0)
#define ATT_KEYROW(i) ((i) < 4 ? ctxrow0 + 64 * (i) : locrow0 + 64 * ((i) - 4))
    __syncthreads();
    ATT_LOAD(ATT_KEYROW(0));
    ATT_STORE(lds);
    __syncthreads();
    for (int t = 0; t < ntiles; ++t) {
        LAS unsigned char* buf = lds + (t & 1) * BUFB;
        if (t + 1 < ntiles) ATT_LOAD(ATT_KEYROW(t + 1));
        f32x4 s[4];
#pragma unroll
        for (int kt = 0; kt < 4; ++kt) {
            s[kt] = (f32x4){0.f, 0.f, 0.f, 0.f};
#pragma unroll
            for (int ks = 0; ks < NKS; ++ks) {
                const bf16x8 kf = *(const LAS bf16x8*)(buf + (kt * 16 + fr) * KSTR + ks * 64 + fq * 16);
                s[kt] = __builtin_amdgcn_mfma_f32_16x16x32_bf16(kf, qf[ks], s[kt], 0, 0, 0);
            }
        }
        if (win && t >= 4) {
            const int tq = tq0 + wid * 16 + fr, tkb = tk0 + 64 * (t - 4) + 4 * fq;
#pragma unroll
            for (int kt = 0; kt < 4; ++kt)
#pragma unroll
                for (int j = 0; j < 4; ++j) { const int d = tkb + kt * 16 + j - tq; if (d < -128 || d > 128) s[kt][j] = -INFINITY; }
        }
        float mx = fmaxf(fmaxf(fmaxf(s[0][0], s[0][1]), fmaxf(s[0][2], s[0][3])), fmaxf(fmaxf(s[1][0], s[1][1]), fmaxf(s[1][2], s[1][3])));
        mx = fmaxf(mx, fmaxf(fmaxf(fmaxf(s[2][0], s[2][1]), fmaxf(s[2][2], s[2][3])), fmaxf(fmaxf(s[3][0], s[3][1]), fmaxf(s[3][2], s[3][3]))));
        mx = fmaxf(mx, __shfl_xor(mx, 16)); mx = fmaxf(mx, __shfl_xor(mx, 32));
        const float mn = fmaxf(m, mx * c);
        const float alpha = __builtin_amdgcn_exp2f(m - mn);
        m = mn;
        float ps = 0.f;
#pragma unroll
        for (int kt = 0; kt < 4; ++kt)
#pragma unroll
            for (int j = 0; j < 4; ++j) { const float pv = __builtin_amdgcn_exp2f(fmaf(s[kt][j], c, -mn)); s[kt][j] = pv; ps += pv; }
        l = l * alpha + ps;
#pragma unroll
        for (int dt = 0; dt < 8; ++dt) o[dt] = o[dt] * alpha;
#pragma unroll
        for (int s2 = 0; s2 < 2; ++s2) {
            u32x4 pk; pk.x = cvt_pk_bf16(s[2 * s2][0], s[2 * s2][1]); pk.y = cvt_pk_bf16(s[2 * s2][2], s[2 * s2][3]);
            pk.z = cvt_pk_bf16(s[2 * s2 + 1][0], s[2 * s2 + 1][1]); pk.w = cvt_pk_bf16(s[2 * s2 + 1][2], s[2 * s2 + 1][3]);
            const bf16x8 pf = __builtin_bit_cast(bf16x8, pk);
#pragma unroll
            for (int dt = 0; dt < 8; ++dt) {
                const LAS unsigned char* vp = buf + KBYTES + (dt * 16 + fr) * VSTR + (32 * s2 + 4 * fq) * 2;
                const u32x2 lo = *(const LAS u32x2*)vp, hi = *(const LAS u32x2*)(vp + 32);
                u32x4 vv; vv.x = lo.x; vv.y = lo.y; vv.z = hi.x; vv.w = hi.y;
                o[dt] = __builtin_amdgcn_mfma_f32_16x16x32_bf16(__builtin_bit_cast(bf16x8, vv), pf, o[dt], 0, 0, 0);
            }
        }
        __syncthreads();
        if (t + 1 < ntiles) ATT_STORE(lds + ((t + 1) & 1) * BUFB);
        __syncthreads();
    }
#undef ATT_LOAD
#undef ATT_STORE
#undef ATT_KEYROW
    l += __shfl_xor(l, 16); l += __shfl_xor(l, 32);
    if (sink_l2 > -INFINITY) { const float mn = fmaxf(m, sink_l2); const float alpha = __builtin_amdgcn_exp2f(m - mn); l = l * alpha + __builtin_amdgcn_exp2f(sink_l2 - mn);
#pragma unroll
        for (int dt = 0; dt < 8; ++dt) o[dt] = o[dt] * alpha; }
    const float il = 1.0f / l;
    bf16_t* op = a.O + (long)(qrow0 + wid * 16 + fr) * a.ldo + a.ooff + 4 * fq;
#pragma unroll
    for (int dt = 0; dt < 8; ++dt) { u32x2 w; w.x = cvt_pk_bf16(o[dt][0] * il, o[dt][1] * il); w.y = cvt_pk_bf16(o[dt][2] * il, o[dt][3] * il); *(u32x2*)(op + dt * 16) = w; }
}


__device__ __forceinline__ float bf2f(bf16_t v) { return __uint_as_float(((unsigned)v) << 16); }
#define OSM_UPDATE(S, M_, L_, A0, A1, V0, V1) do { const float mn_ = fmaxf(M_, S); const float cr_ = expf(M_ - mn_); const float pp_ = expf((S) - mn_); \
    L_ = L_ * cr_ + pp_; A0 = A0 * cr_ + pp_ * (V0); A1 = A1 * cr_ + pp_ * (V1); M_ = mn_; } while (0)
__device__ __forceinline__ void swa_task(const Params& p, int l, int h, int r0, int lane) {
    constexpr int QW = 4;
    const float scale = 0.08838834764831845f;
    const bool lat = r0 < NLAT;
    const int b = lat ? r0 / T : (r0 - NLAT) / LCTX;
    const int kvh = h >> 1;
    float q0[QW], q1[QW], m[QW], ls[QW], a0[QW], a1[QW];
#pragma unroll
    for (int i = 0; i < QW; ++i) {
        const bf16_t* q = p.sqb + (long)(r0 + i) * 512 + h * 128;
        q0[i] = bf2f(q[lane]) * scale; q1[i] = bf2f(q[lane + 64]) * scale; m[i] = -INFINITY; ls[i] = 0.f; a0[i] = 0.f; a1[i] = 0.f;
    }
    for (int j = 0; j < LCTX; ++j) {
        const long rk = NLAT + b * LCTX + j;
        const float k0 = bf2f(p.skb[rk * 256 + kvh * 128 + lane]), k1 = bf2f(p.skb[rk * 256 + kvh * 128 + 64 + lane]);
        const float v0 = bf2f(p.svT[(long)(kvh * 128 + lane) * R + rk]), v1 = bf2f(p.svT[(long)(kvh * 128 + 64 + lane) * R + rk]);
#pragma unroll
        for (int i = 0; i < QW; ++i) { const float s = wsum(q0[i] * k0 + q1[i] * k1); OSM_UPDATE(s, m[i], ls[i], a0[i], a1[i], v0, v1); }
    }
    if (lat) {
        const int t0 = r0 % T;
        const int lo = (t0 - 128) < 0 ? 0 : (t0 - 128), hi = (t0 + QW - 1 + 128) > (T - 1) ? (T - 1) : (t0 + QW - 1 + 128);
        for (int tk = lo; tk <= hi; ++tk) {
            const long rk = b * T + tk;
            const float k0 = bf2f(p.skb[rk * 256 + kvh * 128 + lane]), k1 = bf2f(p.skb[rk * 256 + kvh * 128 + 64 + lane]);
            const float v0 = bf2f(p.svT[(long)(kvh * 128 + lane) * R + rk]), v1 = bf2f(p.svT[(long)(kvh * 128 + 64 + lane) * R + rk]);
#pragma unroll
            for (int i = 0; i < QW; ++i) {
                const int d = tk - (t0 + i);
                if (d >= -128 && d <= 128) { const float s = wsum(q0[i] * k0 + q1[i] * k1); OSM_UPDATE(s, m[i], ls[i], a0[i], a1[i], v0, v1); }
            }
        }
    }
    const float sk = p.swa_sink[l * 4 + h];
#pragma unroll
    for (int i = 0; i < QW; ++i) {
        OSM_UPDATE(sk, m[i], ls[i], a0[i], a1[i], 0.f, 0.f);
        bf16_t* o = p.mix + (long)(r0 + i) * D + h * 128;
        const float il = 1.0f / ls[i];
        o[lane] = f2bf(a0[i] * il); o[lane + 64] = f2bf(a1[i] * il);
    }
}
__device__ __forceinline__ void mla_task(const Params& p, int h, int r0, int lane) {
    constexpr int QW = 8;
    const float scale = 0.07216878364870323f;
    const bool lat = r0 < NLAT;
    const int b = lat ? r0 / T : (r0 - NLAT) / LCTX;
    float q0[QW], q1[QW], q2[QW], m[QW], ls[QW], a0[QW], a1[QW];
#pragma unroll
    for (int i = 0; i < QW; ++i) {
        const bf16_t* q = p.Q2b + (long)(r0 + i) * 768 + h * 192;
        q0[i] = bf2f(q[lane]) * scale; q1[i] = bf2f(q[lane + 64]) * scale;
        float qr = bf2f(q[128 + lane]);
        if (lat) {
            const int t = (r0 + i) % T; const float rowi = (float)(t / 64), coli = (float)(t % 64);
            const int ii = lane & 31, f = ii & 15;
            const float inv = powf(10000.0f, -(float)f / 16.0f);
            const float ang = (ii < 16 ? rowi : coli) * inv;
            float sn, cs; sincosf(ang, &sn, &cs);
            const float other = __shfl_xor(qr, 32);
            qr = (lane < 32) ? (qr * cs - other * sn) : (qr * cs + other * sn);
        }
        q2[i] = qr * scale; m[i] = -INFINITY; ls[i] = 0.f; a0[i] = 0.f; a1[i] = 0.f;
    }
    const int nkeys = lat ? (LCTX + T) : LCTX;
    for (int j = 0; j < nkeys; ++j) {
        const long rk = (j < LCTX) ? (NLAT + b * LCTX + j) : (b * T + (j - LCTX));
        const float k0 = bf2f(p.Kn[rk * 512 + h * 128 + lane]), k1 = bf2f(p.Kn[rk * 512 + h * 128 + 64 + lane]);
        const float v0 = bf2f(p.VtM[(long)(h * 128 + lane) * R + rk]), v1 = bf2f(p.VtM[(long)(h * 128 + 64 + lane) * R + rk]);
        const float k2 = bf2f(p.Krb[rk * 64 + lane]);
#pragma unroll
        for (int i = 0; i < QW; ++i) { const float s = wsum(q0[i] * k0 + q1[i] * k1 + q2[i] * k2); OSM_UPDATE(s, m[i], ls[i], a0[i], a1[i], v0, v1); }
    }
#pragma unroll
    for (int i = 0; i < QW; ++i) {
        bf16_t* o = p.mix + (long)(r0 + i) * D + 1024 + h * 128;
        const float il = 1.0f / ls[i];
        o[lane] = f2bf(a0[i] * il); o[lane + 64] = f2bf(a1[i] * il);
    }
}

typedef float f32x2 __attribute__((ext_vector_type(2)));
constexpr int NCHK = (LCTX + T) / 64;
__device__ __forceinline__ int scan_row(int b, int dir, int pos) {
    if (pos < LCTX) return NLAT + b * LCTX + (dir ? (LCTX - 1 - pos) : pos);
    const int t = pos - LCTX; return b * T + (dir ? (T - 1 - t) : t);
}
__device__ __forceinline__ float hgrn_lb(const Params& p, int l, int dir, int hi) {
    if (l == 0) return 0.f;
    const float l0 = p.lb_logits[(0 * 2 + dir) * 512 + hi], l1 = p.lb_logits[(1 * 2 + dir) * 512 + hi];
    const float mx = fmaxf(l0, l1), e0 = expf(l0 - mx), e1 = expf(l1 - mx);
    return e1 / (e0 + e1);
}
template <int MIXER>
__device__ __forceinline__ void scan_s1(const Params& p, int l, int bu, float* smem) {
    const int tid = otid(), q4 = tid >> 7, j = tid & 127;
    const int u = bu * 4 + q4, sl = u / NCHK, c = u % NCHK;
    const int b = sl >> 3, h = (sl >> 1) & 3, dir = sl & 1, sq = MIXER * 16 + sl;
    float* kb = smem + q4 * 2048;
    float* fb = kb + 1024;
    f32x2 S[64];
#pragma unroll
    for (int i = 0; i < 64; ++i) S[i] = (f32x2){0.f, 0.f};
    const float gam = (MIXER == 0) ? (1.0f - exp2f(-p.ret_s[(l * 2 + dir) * 4 + h])) : 0.f;
    const float lb = (MIXER == 1) ? hgrn_lb(p, l, dir, h * 128 + j) : 0.f;
    const int koff = (MIXER == 0 ? RK : (dir ? HFB : HFF)) + h * 128 + j, voff = (MIXER == 0 ? RV : HI) + h * 128 + j;
    float ap = 1.f;
    float kr[8], vr[8];
#pragma unroll
    for (int s = 0; s < 8; ++s) { const float* pr = p.P + (long)scan_row(b, dir, c * 64 + s) * INC; kr[s] = pr[koff]; vr[s] = pr[voff]; }
    for (int bt = 0; bt < 8; ++bt) {
        __syncthreads();
        float vv[8];
#pragma unroll
        for (int s = 0; s < 8; ++s) {
            vv[s] = vr[s];
            if (MIXER == 0) kb[s * 128 + j] = kr[s] * 0.08838834764831845f;
            else { const float f = lb + (1.0f - lb) * sigmf(kr[s]); kb[s * 128 + j] = 1.0f - f; fb[s * 128 + j] = f; ap *= f; }
        }
        __syncthreads();
        if (bt < 7) {
#pragma unroll
            for (int s = 0; s < 8; ++s) { const float* pr = p.P + (long)scan_row(b, dir, c * 64 + (bt + 1) * 8 + s) * INC; kr[s] = pr[koff]; vr[s] = pr[voff]; }
        }
#pragma unroll
        for (int s = 0; s < 8; ++s) {
            const f32x2 v2 = (f32x2){vv[s], vv[s]};
#pragma unroll
            for (int i4 = 0; i4 < 32; ++i4) {
                const float4 k4 = ld4(kb + s * 128 + i4 * 4);
                if (MIXER == 0) { S[i4 * 2] = S[i4 * 2] * gam + (f32x2){k4.x, k4.y} * v2; S[i4 * 2 + 1] = S[i4 * 2 + 1] * gam + (f32x2){k4.z, k4.w} * v2; }
                else { const float4 f4 = ld4(fb + s * 128 + i4 * 4);
                    S[i4 * 2] = S[i4 * 2] * (f32x2){f4.x, f4.y} + (f32x2){k4.x, k4.y} * v2; S[i4 * 2 + 1] = S[i4 * 2 + 1] * (f32x2){f4.z, f4.w} + (f32x2){k4.z, k4.w} * v2; }
            }
        }
    }
    if (MIXER == 0) { float g2 = gam * gam; g2 *= g2; g2 *= g2; g2 *= g2; g2 *= g2; ap = g2 * g2; }
    float* up = p.sst + ((long)(sq * NCHK + c) * 128) * 128 + j;
#pragma unroll
    for (int i = 0; i < 64; ++i) { up[(long)(2 * i) * 128] = S[i].x; up[(long)(2 * i + 1) * 128] = S[i].y; }
    p.sA[(long)(sq * NCHK + c) * 128 + j] = ap;
}
__device__ __forceinline__ void ph_scan2(const Params& p, int bid, int nb) {
    const int tid = otid();
    for (int e = bid * NTH + tid; e < 32 * 16384; e += nb * NTH) {
        const int sq = e >> 14, ij = e & 16383, i = ij >> 7;
        float* base = p.sst + (long)sq * NCHK * 16384 + ij;
        const float* A = p.sA + (long)sq * NCHK * 128 + i;
        float S = 0.f;
#pragma unroll 4
        for (int c = 0; c < NCHK; ++c) { const float uv = base[(long)c * 16384]; base[(long)c * 16384] = S; S = fmaf(A[c * 128], S, uv); }
    }
}
template <int MIXER>
__device__ __forceinline__ void scan_s3(const Params& p, int l, int bu, float* smem) {
    const int tid = otid(), half = tid >> 8, grp = tid >> 7, dirn = grp & 1, j = tid & 127, lane = tid & 63;
    const int u = bu * 2 + half, b = u / (4 * NCHK), rem = u % (4 * NCHK), h = rem / NCHK, rb = rem % NCHK;
    const int sq = MIXER * 16 + (b * 4 + h) * 2 + dirn;
    const int cidx = dirn ? (rb < 4 ? 3 - rb : 71 - rb) : rb;
    const int row0 = rb < 4 ? NLAT + b * LCTX + rb * 64 : b * T + (rb - 4) * 64;
    float* qb = smem + grp * 3072;
    float* kb = qb + 1024;
    float* fb = kb + 1024;
    float* ob = smem + 12288 + half * 8192;
    f32x2 S[64];
    {
        const float* sp = p.sst + ((long)(sq * NCHK + cidx) * 128) * 128 + j;
#pragma unroll
        for (int i = 0; i < 64; ++i) { S[i].x = sp[(long)(2 * i) * 128]; S[i].y = sp[(long)(2 * i + 1) * 128]; }
    }
    const float gam = (MIXER == 0) ? (1.0f - exp2f(-p.ret_s[(l * 2 + dirn) * 4 + h])) : 0.f;
    const float lb = (MIXER == 1) ? hgrn_lb(p, l, dirn, h * 128 + j) : 0.f;
    const int qoff = (MIXER == 0 ? RQ : HQ) + h * 128 + j, koff = (MIXER == 0 ? RK : (dirn ? HFB : HFF)) + h * 128 + j, voff = (MIXER == 0 ? RV : HI) + h * 128 + j;
    constexpr int NB = 4;
    float qr[NB], kr[NB], vr[NB];
#pragma unroll
    for (int s = 0; s < NB; ++s) { const int lr = dirn ? 63 - s : s; const float* pr = p.P + (long)(row0 + lr) * INC; qr[s] = pr[qoff]; kr[s] = pr[koff]; vr[s] = pr[voff]; }
    for (int bt = 0; bt < 64 / NB; ++bt) {
        __syncthreads();
        float vv[NB];
#pragma unroll
        for (int s = 0; s < NB; ++s) {
            vv[s] = vr[s];
            if (MIXER == 0) { qb[s * 128 + j] = qr[s]; kb[s * 128 + j] = kr[s] * 0.08838834764831845f; }
            else { const float f = lb + (1.0f - lb) * sigmf(kr[s]); qb[s * 128 + j] = siluf(qr[s]); kb[s * 128 + j] = 1.0f - f; fb[s * 128 + j] = f; }
        }
        __syncthreads();
        if (bt < 64 / NB - 1) {
#pragma unroll
            for (int s = 0; s < NB; ++s) { const int st = (bt + 1) * NB + s, lr = dirn ? 63 - st : st; const float* pr = p.P + (long)(row0 + lr) * INC; qr[s] = pr[qoff]; kr[s] = pr[koff]; vr[s] = pr[voff]; }
        }
#pragma unroll
        for (int s = 0; s < NB; ++s) {
            const f32x2 v2 = (f32x2){vv[s], vv[s]};
            f32x2 o2 = (f32x2){0.f, 0.f};
#pragma unroll
            for (int i4 = 0; i4 < 32; ++i4) {
                const float4 k4 = ld4(kb + s * 128 + i4 * 4), q4 = ld4(qb + s * 128 + i4 * 4);
                if (MIXER == 0) { S[i4 * 2] = S[i4 * 2] * gam + (f32x2){k4.x, k4.y} * v2; S[i4 * 2 + 1] = S[i4 * 2 + 1] * gam + (f32x2){k4.z, k4.w} * v2; }
                else { const float4 f4 = ld4(fb + s * 128 + i4 * 4);
                    S[i4 * 2] = S[i4 * 2] * (f32x2){f4.x, f4.y} + (f32x2){k4.x, k4.y} * v2; S[i4 * 2 + 1] = S[i4 * 2 + 1] * (f32x2){f4.z, f4.w} + (f32x2){k4.z, k4.w} * v2; }
                o2 += S[i4 * 2] * (f32x2){q4.x, q4.y}; o2 += S[i4 * 2 + 1] * (f32x2){q4.z, q4.w};
            }
            const int st = bt * NB + s, lr = dirn ? 63 - st : st;
            const float o = o2.x + o2.y;
            float* op = ob + lr * 128 + j;
            const bool first = dirn ? (lr >= 32) : (lr < 32);
            if (first) *op = o; else *op += o;
        }
    }
    __syncthreads();
    {
        const int w = (tid >> 6) & 3;
        for (int rr = 0; rr < 16; ++rr) {
            const int lr = w * 16 + rr, r = row0 + lr;
            const float a = ob[lr * 128 + lane], bq = ob[lr * 128 + 64 + lane];
            const float* pr = p.P + (long)r * INC;
            const int cc = h * 128 + lane;
            if (MIXER == 0) {
                const float mean = wsum(a + bq) * (1.0f / 128.0f);
                const float da = a - mean, db = bq - mean;
                const float rstd = rsqrtf(wsum(da * da + db * db) * (1.0f / 128.0f) + EPS);
                p.mix[(long)r * D + 512 + cc] = f2bf(siluf(pr[RG + cc]) * (da * rstd * p.ret_gn[l * 512 + cc]));
                p.mix[(long)r * D + 512 + cc + 64] = f2bf(siluf(pr[RG + cc + 64]) * (db * rstd * p.ret_gn[l * 512 + cc + 64]));
            } else {
                const float rs = rsqrtf(wsum(a * a + bq * bq) * (1.0f / 128.0f) + EPS);
                p.mix[(long)r * D + 1536 + cc] = f2bf(siluf(pr[HG + cc]) * (a * rs * p.hgrn_gn[l * 512 + cc]));
                p.mix[(long)r * D + 1536 + cc + 64] = f2bf(siluf(pr[HG + cc + 64]) * (bq * rs * p.hgrn_gn[l * 512 + cc + 64]));
            }
        }
    }
}
__device__ __forceinline__ void ph_scan3(const Params& p, int l, int bid, int nb, float* smem) {
    constexpr int NBU = 2 * 4 * NCHK / 2;
    for (int bu = bid; bu < 2 * NBU; bu += nb) {
        if (bu < NBU) scan_s3<0>(p, l, bu, smem); else scan_s3<1>(p, l, bu - NBU, smem);
    }
}

__device__ __forceinline__ void ph_mixers(const Params& p, int l, int bid, int nb, float* smem, LAS unsigned char* lds) {
    const bool need_ctx = l < DEPTH - 1;
    const float LOG2E = 1.4426950408889634f;
    const float cM = 0.07216878364870323f * LOG2E, cS = 0.08838834764831845f * LOG2E;
#ifndef DIAG_NAIVE
#define DIAG_NAIVE 0
#endif
    if (DIAG_NAIVE) {
        const int tid = otid(), lane = tid & 63, wid = tid >> 6;
        const int nrows = need_ctx ? R : NLAT;
        const int n_mla = (DIAG_NAIVE & 1) ? (nrows / 8) * 4 : ((DIAG_NAIVE & 4) && need_ctx ? (NCTX / 8) * 4 : 0), n_swa = (DIAG_NAIVE & 2) ? (nrows / 4) * 4 : 0;
        const int mla_r0 = (DIAG_NAIVE & 1) ? 0 : NLAT;
        for (int t = bid * NWV + wid; t < n_mla + n_swa; t += nb * NWV) {
            if (t < n_mla) mla_task(p, t & 3, mla_r0 + (t >> 2) * 8, lane);
            else { const int s2 = t - n_mla; swa_task(p, l, s2 & 3, (s2 >> 2) * 4, lane); }
        }
        __syncthreads();
    }
    if (!(DIAG_NAIVE & 1))
    for (int u = bid; u < 256; u += nb) {
        const int b = u >> 7, h = (u >> 5) & 3, qb = u & 31;
        const AttnSrc a{p.Q2b, 768, h * 192, p.Kn, 512, h * 128, p.Krb, 64, p.VtM, R, h * 128, p.mix, D, 1024 + h * 128};
        attn_unit<true>(a, b * T + qb * 128, NLAT + b * LCTX, b * T, 64, false, qb * 128, 0, true, -INFINITY, cM, lds);
    }
    if (!(DIAG_NAIVE & 2))
    for (int u = bid; u < 256; u += nb) {
        const int b = u >> 7, h = (u >> 5) & 3, qb = u & 31, q0 = qb * 128;
        const int ts = (q0 - 128) < 0 ? 0 : (q0 - 128), te = (q0 + 256) > T ? T : (q0 + 256);
        const AttnSrc a{p.sqb, 512, h * 128, p.skb, 256, (h >> 1) * 128, nullptr, 0, p.svT, R, (h >> 1) * 128, p.mix, D, h * 128};
        attn_unit<false>(a, b * T + q0, NLAT + b * LCTX, b * T + ts, (te - ts) / 64, true, q0, ts, false, p.swa_sink[l * 4 + h] * LOG2E, cS, lds);
    }
    if (need_ctx) {
        for (int u = nb - 1 - bid; u < 32; u += nb) {
            const int v = u & 15, b = v >> 3, h = (v >> 1) & 3, qb = v & 1;
            const int qrow0 = NLAT + b * LCTX + qb * 128;
            int nl0 = 0; asm volatile("" : "+s"(nl0));
            if (u < 16) { if (DIAG_NAIVE & 5) continue; const AttnSrc a{p.Q2b, 768, h * 192, p.Kn, 512, h * 128, p.Krb, 64, p.VtM, R, h * 128, p.mix, D, 1024 + h * 128};
                attn_unit<true>(a, qrow0, NLAT + b * LCTX, 0, nl0, false, 0, 0, false, -INFINITY, cM, lds); }
            else { if (DIAG_NAIVE & 2) continue; const AttnSrc a{p.sqb, 512, h * 128, p.skb, 256, (h >> 1) * 128, nullptr, 0, p.svT, R, (h >> 1) * 128, p.mix, D, h * 128};
                attn_unit<false>(a, qrow0, NLAT + b * LCTX, 0, nl0, false, 0, 0, false, p.swa_sink[l * 4 + h] * LOG2E, cS, lds); }
        }
    }
    __syncthreads();
    {
        constexpr int NBU1 = 16 * NCHK / 4;
        for (int bu = bid; bu < 2 * NBU1; bu += nb) { if (bu < NBU1) scan_s1<0>(p, l, bu, smem); else scan_s1<1>(p, l, bu - NBU1, smem); }
    }
}

__device__ __forceinline__ void ph_post1(const Params& p, int l, int bid, int nb, float* smem) {
    const int tid = otid(), lane = tid & 63, wid = tid >> 6;
    const int nrows = (l < DEPTH - 1) ? R : NLAT;
    for (int r = bid * NWV + wid; r < nrows; r += nb * NWV) {
        const float* mv = p.modv + ((long)l * 3 + mod_row(r)) * 6 * D;
        Row x, o; row_load(x, p.xc + (long)r * D, lane); row_load(o, p.ob + (long)r * D, lane);
#pragma unroll
        for (int i = 0; i < 8; ++i) {
            const float4 g = ld4(mv + 2 * D + (i * 64 + lane) * 4);
            x.v[i].x = ALPHA * x.v[i].x + g.x * o.v[i].x; x.v[i].y = ALPHA * x.v[i].y + g.y * o.v[i].y;
            x.v[i].z = ALPHA * x.v[i].z + g.z * o.v[i].z; x.v[i].w = ALPHA * x.v[i].w + g.w * o.v[i].w;
        }
        float mean, rstd; row_stats(x, mean, rstd);
        row_affine(x, mean, rstd, p.ln1_g + l * D, p.ln1_b + l * D, lane);
        row_store(x, p.xc + (long)r * D, lane);
        row_stats(x, mean, rstd);
        row_modulate(x, mean, rstd, mv + 3 * D, mv + 4 * D, lane);
        row_store_bf16(x, p.hb + (long)r * D, lane);
        float* hrow = smem + wid * D;
#pragma unroll
        for (int i = 0; i < 8; ++i) st4(hrow + (i * 64 + lane) * 4, x.v[i]);
        asm volatile("s_waitcnt lgkmcnt(0)" ::: "memory");
        float acc = 0.f;
        if (lane < 36) {
            const float* wp = (lane < 32) ? (p.w_re + (long)l * D * 32 + lane) : (p.w_rg + (long)l * D * 4 + (lane - 32));
            const int wst = (lane < 32) ? 32 : 4;
#pragma unroll 8
            for (int k = 0; k < D; ++k) acc = fmaf(hrow[k], wp[(long)k * wst], acc);
        }
        asm volatile("" ::: "memory");
        float lg[4], le[32];
#pragma unroll
        for (int g = 0; g < 4; ++g) lg[g] = __shfl(acc, 32 + g);
#pragma unroll
        for (int e = 0; e < 32; ++e) le[e] = __shfl(acc, e);
        int grp = 0; float gm = lg[0];
#pragma unroll
        for (int g = 1; g < 4; ++g) if (lg[g] > gm) { gm = lg[g]; grp = g; }
        float zs = 0.f;
#pragma unroll
        for (int g = 0; g < 4; ++g) zs += expf(lg[g] - gm);
        const float pgrp = 1.0f / zs;
        float ev[8];
#pragma unroll
        for (int e = 0; e < 8; ++e) { ev[e] = (grp == 0) ? le[e] : (grp == 1) ? le[8 + e] : (grp == 2) ? le[16 + e] : le[24 + e]; }
        int i0 = 0; float v0 = ev[0];
#pragma unroll
        for (int e = 1; e < 8; ++e) if (ev[e] > v0) { v0 = ev[e]; i0 = e; }
        int i1 = -1; float v1 = -INFINITY;
#pragma unroll
        for (int e = 0; e < 8; ++e) if (e != i0 && ev[e] > v1) { v1 = ev[e]; i1 = e; }
        const float e1 = expf(v1 - v0);
        const float g0 = pgrp / (1.0f + e1), g1 = pgrp * e1 / (1.0f + e1);
        if (lane == 0) {
            p.eid[r * 2 + 0] = grp * 8 + i0; p.eid[r * 2 + 1] = grp * 8 + i1;
            p.gate[r * 2 + 0] = g0; p.gate[r * 2 + 1] = g1;
        }
    }
}

__device__ __forceinline__ void ph_sort(const Params& p, int l, int bid, int* smem) {
    if (bid != 0) return;
    const int tid = otid(), lane = tid & 63, wid = tid >> 6;
    const int ntok = (l < DEPTH - 1) ? R : NLAT;
    const int nch = ntok / 64;
    int* cnt = smem;
    int* pst = smem + 136 * 32;
    int* tot = pst + 32;
    for (int i = tid; i < NSLOT; i += NTH) p.slot_tok[i] = -1;
    for (int c = wid; c < nch; c += NWV) {
        const int t = c * 64 + lane;
        const int e0 = p.eid[t * 2], e1 = p.eid[t * 2 + 1];
        for (int e = 0; e < 32; ++e) {
            const unsigned long long mk = __ballot(e0 == e || e1 == e);
            if (lane == 0) cnt[c * 32 + e] = __popcll(mk);
        }
    }
    __threadfence_block();
    __syncthreads();
    if (tid < 32) {
        int run = 0;
        for (int c = 0; c < nch; ++c) { const int v = cnt[c * 32 + tid]; cnt[c * 32 + tid] = run; run += v; }
        tot[tid] = run;
    }
    __syncthreads();
    if (tid == 0) {
        int ps = 0;
        for (int e = 0; e < 32; ++e) { pst[e] = ps; ps += (tot[e] + 255) / 256 * 256; }
        p.tile_e[NTILE] = ps / 256;
        int e = 0;
        for (int b = 0; b < NTILE; ++b) {
            const int s = b * 256;
            while (e < 32 && s >= pst[e] + (tot[e] + 255) / 256 * 256) ++e;
            p.tile_e[b] = (e < 32) ? e : -1;
        }
    }
    __syncthreads();
    for (int c = wid; c < nch; c += NWV) {
        const int t = c * 64 + lane;
        const int e0 = p.eid[t * 2], e1 = p.eid[t * 2 + 1];
        for (int e = 0; e < 32; ++e) {
            const unsigned long long mk = __ballot(e0 == e || e1 == e);
            const int rank = __popcll(mk & ((1ull << lane) - 1ull));
            if (e0 == e || e1 == e) {
                const int slot = pst[e] + cnt[c * 32 + e] + rank;
                p.slot_tok[slot] = t;
                p.slot_of[t * 2 + (e1 == e ? 1 : 0)] = slot;
            }
        }
    }
}

__device__ __forceinline__ void ph_gather(const Params& p, int bid, int nb) {
    const int tid = otid(), lane = tid & 63, wid = tid >> 6;
    const int nslots = p.tile_e[NTILE] * 256;
    for (int s0 = bid * NWV + wid; s0 < nslots; s0 += nb * NWV) {
        const int src = p.slot_tok[s0];
        u32x4* d = (u32x4*)(p.xs + (long)s0 * D);
        if (src >= 0) { const u32x4* sp = (const u32x4*)(p.hb + (long)src * D);
#pragma unroll
            for (int i = 0; i < 4; ++i) d[i * 64 + lane] = sp[i * 64 + lane]; }
        else { const u32x4 z = {0u, 0u, 0u, 0u};
#pragma unroll
            for (int i = 0; i < 4; ++i) d[i * 64 + lane] = z; }
    }
}

__device__ __forceinline__ void ph_post2(const Params& p, int l, int bid, int nb) {
    const int tid = otid(), lane = tid & 63, wid = tid >> 6;
    const int nrows = (l < DEPTH - 1) ? R : NLAT;
    for (int r = bid * NWV + wid; r < nrows; r += nb * NWV) {
        const float* mv = p.modv + ((long)l * 3 + mod_row(r)) * 6 * D;
        const int s0 = p.slot_of[r * 2], s1 = p.slot_of[r * 2 + 1];
        const float g0 = p.gate[r * 2], g1 = p.gate[r * 2 + 1];
        Row x, y0, y1; row_load(x, p.xc + (long)r * D, lane); row_load(y0, p.Ys + (long)s0 * D, lane); row_load(y1, p.Ys + (long)s1 * D, lane);
#pragma unroll
        for (int i = 0; i < 8; ++i) {
            const float4 g = ld4(mv + 5 * D + (i * 64 + lane) * 4);
            x.v[i].x = ALPHA * x.v[i].x + g.x * (g0 * y0.v[i].x + g1 * y1.v[i].x); x.v[i].y = ALPHA * x.v[i].y + g.y * (g0 * y0.v[i].y + g1 * y1.v[i].y);
            x.v[i].z = ALPHA * x.v[i].z + g.z * (g0 * y0.v[i].z + g1 * y1.v[i].z); x.v[i].w = ALPHA * x.v[i].w + g.w * (g0 * y0.v[i].w + g1 * y1.v[i].w);
        }
        float mean, rstd; row_stats(x, mean, rstd);
        row_affine(x, mean, rstd, p.ln2_g + l * D, p.ln2_b + l * D, lane);
        if (l == DEPTH - 1) row_store(x, p.out + (long)r * D, lane);
        else row_store(x, p.xc + (long)r * D, lane);
    }
}

constexpr int PH_PER_LAYER = 14, N_PHASES = 1 + DEPTH * PH_PER_LAYER;
constexpr int LDS_MAIN = 128 * 1024, LDS_BYTES = LDS_MAIN + 256;

__global__ void __launch_bounds__(NTH, 2) fwd(Params p) {
    extern __shared__ __attribute__((aligned(16))) unsigned char lds_raw[];
    float* smem = (float*)lds_raw;
    LAS unsigned char* ldsp = (LAS unsigned char*)lds_raw;
    const int bid = blockIdx.x, nb = gridDim.x;
    const int vcu = (nb % 8 == 0) ? (bid % 8) * (nb / 8) + bid / 8 : bid;
#if ONE_LAUNCH
    if (threadIdx.x == 0) *(uint4*)(lds_raw + LDS_MAIN) = make_uint4(0u, 0u, 0u, 0u);
    __syncthreads();
    XcdBarrier bar = xcd_barrier_post(p.bar, (volatile LAS unsigned*)(ldsp + LDS_MAIN));
#define SEAM(k) do { if ((k) + 1 < p.ph_hi) xcd_barrier(bar); } while (0)
#else
#define SEAM(k) do { } while (0)
#endif
#define IN(k) (p.ph_lo <= (k) && (k) < p.ph_hi)
    if (IN(0)) { ph_prologue(p, bid, nb, smem); if (DUPMASK & 1) { __syncthreads(); ph_prologue(p, bid, nb, smem); } SEAM(0); }
    for (int l = 0; l < DEPTH; ++l) {
        const int k0 = 1 + l * PH_PER_LAYER;
        const int mrows = (l < DEPTH - 1) ? R : NLAT;
        if (IN(k0 + 0)) { ph_lnmod(p, l, bid, nb); if (DUPMASK & 16) ph_lnmod(p, l, bid, nb); SEAM(k0 + 0); }
        if (IN(k0 + 1)) {
            pg8::Gemm g{p.hb, p.WinT + (long)l * INP * D, R, INP, D}; pg8::StaticOrder S; S.init(R, INP, nb, bid);
            pg8::EpiF32 E{p.P, INC, INC};
            pg8::gemm_phase(ldsp, g, S, E); if (DUPMASK & 2) pg8::gemm_phase(ldsp, g, S, E); SEAM(k0 + 1);
        }
        if (IN(k0 + 2)) { ph_prep(p, l, bid, nb); if (DUPMASK & 16) ph_prep(p, l, bid, nb); SEAM(k0 + 2); }
        if (IN(k0 + 3)) {
            { pg8::Gemm g{p.cqn, p.WuqT + (long)l * 768 * 384, R, 768, 384}; pg8::StaticOrder S; S.init(R, 768, nb, bid); pg8::EpiBf16 E{p.Q2b, 768}; pg8::gemm_phase(ldsp, g, S, E); if (DUPMASK & 2) pg8::gemm_phase(ldsp, g, S, E); }
            { pg8::Gemm g{p.ckvn, p.WukvT + (long)l * 1024 * 256, R, 512, 256}; pg8::StaticOrder S; S.init(R, 512, nb, bid); pg8::EpiBf16 E{p.Kn, 512}; pg8::gemm_phase(ldsp, g, S, E); if (DUPMASK & 2) pg8::gemm_phase(ldsp, g, S, E); }
            { pg8::Gemm g{p.WukvT + (long)l * 1024 * 256 + 512 * 256, p.ckvn, 512, R, 256}; pg8::StaticOrder S; S.init(512, R, nb, bid); pg8::EpiBf16 E{p.VtM, R}; pg8::gemm_phase(ldsp, g, S, E); if (DUPMASK & 2) pg8::gemm_phase(ldsp, g, S, E); }
            SEAM(k0 + 3);
        }
        if (IN(k0 + 4)) { ph_mixers(p, l, bid, nb, smem, ldsp); if (DUPMASK & 4) { __syncthreads(); ph_mixers(p, l, bid, nb, smem, ldsp); } SEAM(k0 + 4); }
        if (IN(k0 + 5)) { ph_scan2(p, bid, nb); SEAM(k0 + 5); }
        if (IN(k0 + 6)) { ph_scan3(p, l, bid, nb, smem); SEAM(k0 + 6); }
        if (IN(k0 + 7)) {
            pg8::Gemm g{p.mix, p.WoutT + (long)l * D * D, mrows, D, D}; pg8::StaticOrder S; S.init(mrows, D, nb, bid);
            pg8::EpiF32 E{p.ob, D, D};
            pg8::gemm_phase(ldsp, g, S, E); if (DUPMASK & 2) pg8::gemm_phase(ldsp, g, S, E); SEAM(k0 + 7);
        }
        if (IN(k0 + 8)) { ph_post1(p, l, bid, nb, smem); SEAM(k0 + 8); }
        if (IN(k0 + 9)) { ph_sort(p, l, bid, (int*)smem); SEAM(k0 + 9); }
        if (IN(k0 + 10)) { ph_gather(p, bid, nb); if (DUPMASK & 16) ph_gather(p, bid, nb); SEAM(k0 + 10); }
        if (IN(k0 + 11)) {
            pg8::Gemm g{p.xs, p.W13T + (long)l * NEXP * 1024 * D, NSLOT, 1024, D};
            pg8::MoeOrder S{4, p.tile_e[NTILE] * 4, nb, vcu, (size_t)1024 * D * 2, p.tile_e};
            pg8::EpiSwiglu E{p.act, FF};
            pg8::gemm_phase(ldsp, g, S, E); if (DUPMASK & 2) pg8::gemm_phase(ldsp, g, S, E); SEAM(k0 + 11);
        }
        if (IN(k0 + 12)) {
            pg8::Gemm g{p.act, p.W2T + (long)l * NEXP * D * FF, NSLOT, D, FF};
            pg8::MoeOrder S{8, p.tile_e[NTILE] * 8, nb, vcu, (size_t)D * FF * 2, p.tile_e};
            pg8::EpiF32 E{p.Ys, D, D};
            pg8::gemm_phase(ldsp, g, S, E); if (DUPMASK & 2) pg8::gemm_phase(ldsp, g, S, E); SEAM(k0 + 12);
        }
        if (IN(k0 + 13)) { ph_post2(p, l, bid, nb); SEAM(k0 + 13); }
    }
}

static inline size_t al256(size_t v) { return (v + 255) & ~(size_t)255; }

extern "C" void kernel_launch(void* const* d_in, const int* in_sizes, int n_in, void* d_out, int out_size, void* d_ws, size_t ws_size, hipStream_t stream) {
    static int grid = 0;
    if (grid == 0) {
        int dev = 0, cus = 0, per_cu = 0;
        hipGetDevice(&dev);
        hipDeviceGetAttribute(&cus, hipDeviceAttributeMultiprocessorCount, dev);
        hipFuncSetAttribute((const void*)fwd, hipFuncAttributeMaxDynamicSharedMemorySize, LDS_BYTES);
        hipOccupancyMaxActiveBlocksPerMultiprocessor(&per_cu, (const void*)fwd, NTH, LDS_BYTES);
        (void)hipGetLastError();
        if (cus <= 0) cus = 256;
        grid = cus;
        if (per_cu < 1) fprintf(stderr, "kernel_launch: occupancy query reports %d\n", per_cu);
    }
    Params p{};
    const float* const* in = (const float* const*)d_in;
    p.x = in[0]; p.c = in[1]; p.ctx = in[2]; p.c_ctx = in[3]; p.w_ada = in[4]; p.b_ada = in[5]; p.w_in = in[6]; p.swa_sink = in[7];
    p.ret_s = in[8]; p.ret_gn = in[9]; p.q_norm = in[10]; p.kv_norm = in[11]; p.w_uq = in[12]; p.w_ukv = in[13]; p.lb_logits = in[14];
    p.hgrn_gn = in[15]; p.w_out = in[16]; p.ln1_g = in[17]; p.ln1_b = in[18]; p.w_rg = in[19]; p.w_re = in[20]; p.w1 = in[21]; p.w3 = in[22];
    p.w2 = in[23]; p.ln2_g = in[24]; p.ln2_b = in[25];
    p.out = (float*)d_out;
    unsigned char* ws = (unsigned char*)d_ws; size_t off = 0;
    auto carve = [&](size_t bytes) { unsigned char* q = ws + off; off = al256(off + bytes); return q; };
    p.bar = (unsigned*)carve(XCD_BAR_WORDS * 4);
    p.modv = (float*)carve((size_t)DEPTH * 3 * 6 * D * 4);
    p.xc = (float*)carve((size_t)R * D * 4);
    p.hb = (bf16_t*)carve((size_t)R * D * 2);
    p.P = (float*)carve((size_t)R * INC * 4);
    p.Ys = p.P;
    p.cqn = (bf16_t*)carve((size_t)R * 384 * 2);
    p.ckvn = (bf16_t*)carve((size_t)R * 256 * 2);
    p.Q2b = (bf16_t*)carve((size_t)R * 768 * 2);
    p.Kn = (bf16_t*)carve((size_t)R * 512 * 2);
    p.VtM = (bf16_t*)carve((size_t)512 * R * 2);
    p.Krb = (bf16_t*)carve((size_t)R * 64 * 2);
    p.sqb = (bf16_t*)carve((size_t)R * 512 * 2);
    p.skb = (bf16_t*)carve((size_t)R * 256 * 2);
    p.svT = (bf16_t*)carve((size_t)256 * R * 2);
    p.sst = (float*)carve((size_t)32 * NCHK * 16384 * 4);
    p.sA = (float*)carve((size_t)32 * NCHK * 128 * 4);
    p.mix = (bf16_t*)carve((size_t)R * D * 2);
    p.ob = p.sst;
    p.xs = (bf16_t*)carve((size_t)NSLOT * D * 2);
    p.act = (bf16_t*)carve((size_t)NSLOT * FF * 2);
    p.gate = (float*)carve((size_t)R * 2 * 4);
    p.eid = (int*)carve((size_t)R * 2 * 4);
    p.slot_of = (int*)carve((size_t)R * 2 * 4);
    p.slot_tok = (int*)carve((size_t)NSLOT * 4);
    p.tile_e = (int*)carve((size_t)(NTILE + 1) * 4);
    p.WinT = (bf16_t*)carve((size_t)DEPTH * INP * D * 2);
    p.WoutT = (bf16_t*)carve((size_t)DEPTH * D * D * 2);
    p.WuqT = (bf16_t*)carve((size_t)DEPTH * 768 * 384 * 2);
    p.WukvT = (bf16_t*)carve((size_t)DEPTH * 1024 * 256 * 2);
    p.W13T = (bf16_t*)carve((size_t)DEPTH * NEXP * 1024 * D * 2);
    p.W2T = (bf16_t*)carve((size_t)DEPTH * NEXP * D * FF * 2);
    if (off > ws_size) { fprintf(stderr, "kernel_launch: workspace too small: need %zu have %zu\n", off, ws_size); return; }
    hipMemsetAsync(p.bar, 0, XCD_BAR_WORDS * 4, stream);
#if ONE_LAUNCH
    p.ph_lo = 0; p.ph_hi = N_PHASES;
    hipLaunchKernelGGL(fwd, dim3(grid), dim3(NTH), LDS_BYTES, stream, p);
#else
    for (int k = 0; k < N_PHASES; ++k) {
        p.ph_lo = k; p.ph_hi = k + 1;
        hipLaunchKernelGGL(fwd, dim3(grid), dim3(NTH), LDS_BYTES, stream, p);
    }
#endif
}
```

```cpp
#include <hip/hip_runtime.h>
#include <cstdio>
#include <cstdint>

#ifndef DIAG_NAIVE
#define DIAG_NAIVE 0
#endif
#ifndef DUPMASK
#define DUPMASK 0
#endif
#ifndef ONE_LAUNCH
#define ONE_LAUNCH 1
#endif

constexpr int D = 2048, NBATCH = 2, T = 4096, LCTX = 256, DEPTH = 2;
constexpr int NLAT = NBATCH * T, NCTX = NBATCH * LCTX, R = NLAT + NCTX;
constexpr int INC = 6208;
constexpr int SQ = 0, SK = 512, SV = 768, RQ = 1024, RK = 1536, RV = 2048, RG = 2560, CQ = 3072, CKV = 3456, KR = 3584,
              HQ = 3648, HFF = 4160, HFB = 4672, HI = 5184, HG = 5696;
constexpr int NEXP = 32, FF = 512;
constexpr int NSLOT = 25600, NTILE = NSLOT / 256;
constexpr int INP = 6400;
constexpr float EPS = 1e-6f;
constexpr float ALPHA = 1.41421356237309515f;
constexpr int NTH = 512, NWV = 8;

typedef float f32x16 __attribute__((ext_vector_type(16)));
typedef unsigned short bf16_t;
typedef short bf16x8 __attribute__((ext_vector_type(8)));
typedef float f32x4 __attribute__((ext_vector_type(4)));
typedef unsigned u32x4 __attribute__((ext_vector_type(4)));
typedef unsigned u32x2 __attribute__((ext_vector_type(2)));

#define XB_TMO      128
#define XB_XCNT(j)  (256  + 64 * (j))
#define XB_XSUB(j)  (1280 + 64 * (j))
#define XB_XGEN(j)  (2304 + 64 * (j))
#define XB_TOP      3328
#define XB_TOPGEN   3392
#define XCD_BAR_WORDS 3456
#define XB_SPIN_CAP (1u << 18)
#define LAS __attribute__((address_space(3)))

__device__ __forceinline__ unsigned xb_ld(unsigned* p)              { return __hip_atomic_load(p, __ATOMIC_RELAXED, __HIP_MEMORY_SCOPE_AGENT); }
__device__ __forceinline__ unsigned xb_add(unsigned* p, unsigned v) { return __hip_atomic_fetch_add(p, v, __ATOMIC_RELAXED, __HIP_MEMORY_SCOPE_AGENT); }
__device__ __forceinline__ unsigned xb_xcc_id() { return (unsigned)__builtin_amdgcn_s_getreg((3 << 11) | 20) & 0xFu; }
#define XB_SPIN(cond, bar) do { unsigned _sp = 0; while (cond) { __builtin_amdgcn_s_sleep(1); \
    if ((++_sp & 255u) == 0u) { if (xb_ld(&(bar)[XB_TMO])) break; if (_sp > XB_SPIN_CAP) { atomicAdd(&(bar)[XB_TMO], 1u); break; } } } } while (0)

struct XcdBarrier { unsigned* bar; unsigned x; volatile LAS unsigned* st; };

__device__ __forceinline__ XcdBarrier xcd_barrier_post(unsigned* bar, volatile LAS unsigned* st) {
    XcdBarrier b; b.bar = bar; b.x = xb_xcc_id(); b.st = st;
    if (threadIdx.x == 0) (void)xb_add(&bar[XB_XCNT(b.x)], 1u);
    return b;
}
__device__ __forceinline__ void xcd_barrier_complete(unsigned* bar, unsigned x, unsigned& nloc, unsigned& nx) {
    const unsigned G = gridDim.x * gridDim.y * gridDim.z;
    unsigned sum, cnt, mine, sp = 0u;
    for (;;) {
        sum = 0u; cnt = 0u; mine = 0u;
#pragma unroll
        for (unsigned j = 0; j < 16; ++j) { const unsigned c = xb_ld(&bar[XB_XCNT(j)]); sum += c; cnt += (c > 0u) ? 1u : 0u; mine = (j == x) ? c : mine; }
        if (sum == G) break;
        __builtin_amdgcn_s_sleep(1);
        if ((++sp & 255u) == 0u) { if (xb_ld(&bar[XB_TMO])) break; if (sp > XB_SPIN_CAP) { atomicAdd(&bar[XB_TMO], 1u); break; } }
    }
    nloc = mine > 0u ? mine : 1u; nx = cnt > 0u ? cnt : 1u;
}
__device__ __forceinline__ void xcd_barrier(const XcdBarrier& b) {
    asm volatile("s_waitcnt vmcnt(0)" ::: "memory");
    __syncthreads();
    if (threadIdx.x == 0) {
        unsigned* bar = b.bar;
        __builtin_amdgcn_s_waitcnt(0);
        unsigned nloc = b.st[0], nx = b.st[1];
        if (nloc == 0u) { xcd_barrier_complete(bar, b.x, nloc, nx); b.st[0] = nloc; b.st[1] = nx; }
        const unsigned old = xb_add(&bar[XB_XSUB(b.x)], 1u);
        const unsigned gen = old / nloc;
        if (old + 1u == (gen + 1u) * nloc) {
            __builtin_amdgcn_fence(__ATOMIC_RELEASE, "agent");
            asm volatile("s_waitcnt vmcnt(0)" ::: "memory");
            const unsigned og = xb_add(&bar[XB_TOP], 1u);
            const unsigned tg = og / nx;
            if (og + 1u == (tg + 1u) * nx) xb_add(&bar[XB_TOPGEN], 1u);
            else XB_SPIN(xb_ld(&bar[XB_TOPGEN]) == tg, bar);
            __builtin_amdgcn_fence(__ATOMIC_ACQUIRE, "agent");
            xb_add(&bar[XB_XGEN(b.x)], 1u);
            asm volatile("s_waitcnt vmcnt(0)" ::: "memory");
        } else {
            XB_SPIN(xb_ld(&bar[XB_XGEN(b.x)]) == gen, bar);
            __builtin_amdgcn_fence(__ATOMIC_ACQUIRE, "agent");
            asm volatile("s_waitcnt vmcnt(0)" ::: "memory");
        }
    }
    __syncthreads();
}

struct Params {
    const float *x, *c, *ctx, *c_ctx, *w_ada, *b_ada, *w_in, *swa_sink, *ret_s, *ret_gn, *q_norm, *kv_norm, *w_uq, *w_ukv,
                *lb_logits, *hgrn_gn, *w_out, *ln1_g, *ln1_b, *w_rg, *w_re, *w1, *w3, *w2, *ln2_g, *ln2_b;
    float* out;
    unsigned* bar;
    float *modv, *xc, *P, *sst, *sA, *ob, *Ys, *gate;
    bf16_t *hb, *cqn, *ckvn, *mix, *xs, *act, *Q2b, *Kn, *VtM, *Krb, *sqb, *skb, *svT;
    bf16_t *WinT, *WoutT, *WuqT, *WukvT, *W13T, *W2T;
    int *eid, *slot_of, *slot_tok, *tile_e;
    int ph_lo, ph_hi;
};

__device__ __forceinline__ int otid() { int t = threadIdx.x; asm volatile("" : "+v"(t)); return t; }
__device__ __forceinline__ float wsum(float v) {
#pragma unroll
    for (int o = 32; o > 0; o >>= 1) v += __shfl_xor(v, o);
    return v;
}
__device__ __forceinline__ float siluf(float v) { return v / (1.0f + expf(-v)); }
__device__ __forceinline__ float sigmf(float v) { return 1.0f / (1.0f + expf(-v)); }
__device__ __forceinline__ int mod_row(int r) { return r < NLAT ? (r >= T ? 1 : 0) : 2; }
__device__ __forceinline__ float4 ld4(const float* p) { return *(const float4*)p; }
__device__ __forceinline__ bf16_t f2bf(float f) { unsigned u = __float_as_uint(f); u += 0x7FFFu + ((u >> 16) & 1u); return (bf16_t)(u >> 16); }
__device__ __forceinline__ unsigned cvt_pk_bf16(float lo, float hi) { unsigned r; asm volatile("v_cvt_pk_bf16_f32 %0, %1, %2" : "=v"(r) : "v"(lo), "v"(hi)); return r; }
__device__ __forceinline__ void st4(float* p, float4 v) { *(float4*)p = v; }

namespace pg8 {
constexpr int BM = 256, BK = 64, HALF = 128, HTB = HALF * BK * 2, STAGE_BYTES = 8 * HTB, NXCD = 8, WGM = 8;
__host__ __device__ __forceinline__ int lds_byte(int r, int c) { const int st = (r >> 4) * 2 + (c >> 5), rr = r & 15, cc = c & 31, ob = rr * 64 + cc * 2; return st * 1024 + (ob ^ (((ob >> 9) & 1) << 5)); }
__host__ __device__ __forceinline__ void stage_rc(int b, int& R, int& C) { const int st = b / 1024, sb = b % 1024, swz = sb ^ (((sb >> 9) & 1) << 5); R = (st >> 1) * 16 + swz / 64; C = (st & 1) * 32 + (swz % 64) / 2; }
struct Unit { int pm, pn; };
struct Gemm { const bf16_t* A; const bf16_t* Bt; int M, N, K; };
struct StaticOrder {
    int nM, nN, nwg, G, c;
    __device__ void init(int M, int N, int G_, int c_) { nM = M / BM; nN = N / BM; nwg = nM * nN; G = G_; c = c_; }
    __device__ bool next(int i, Unit& u) const {
        const long L = (long)i * G + c; if (L >= nwg) return false;
        int wgid = (int)L; { const int q = nwg / NXCD, r = nwg % NXCD, xcd = wgid % NXCD, off = wgid / NXCD; wgid = (xcd < r ? xcd * (q + 1) : r * (q + 1) + (xcd - r) * q) + off; }
        const int nig = WGM * nN, gid = wgid / nig, fm = gid * WGM, gsz = (nM - fm) < WGM ? (nM - fm) : WGM;
        u.pm = fm + ((wgid % nig) % gsz); u.pn = (wgid % nig) / gsz; return true;
    }
    __device__ __forceinline__ size_t boff(const Unit& u, size_t tstep) const { return (size_t)u.pn * tstep; }
};
struct MoeOrder {
    int npn, nunits, G, c; size_t estride; const int* tile_e;
    __device__ bool next(int i, Unit& u) const { const long L = (long)i * G + c; if (L >= nunits) return false; u.pm = (int)(L / npn); u.pn = (int)(L % npn); return true; }
    __device__ __forceinline__ size_t boff(const Unit& u, size_t tstep) const { return (size_t)tile_e[u.pm] * estride + (size_t)u.pn * tstep; }
};
struct EpiF32 {
    float* C; int ldc; int ncols;
    __device__ __forceinline__ void operator()(const f32x4 (&acc)[2][2][4][2], const Unit& u, int wr, int wc, int fr, int fq) const {
        const int row0 = u.pm * BM + wr * 64 + fr, col0 = u.pn * BM + wc * 32 + 4 * fq;
#pragma unroll
        for (int ai = 0; ai < 2; ++ai)
#pragma unroll
            for (int m = 0; m < 4; ++m) { float* rowp = C + (size_t)(row0 + ai * HALF + m * 16) * ldc + col0;
#pragma unroll
                for (int bj = 0; bj < 2; ++bj)
#pragma unroll
                    for (int n = 0; n < 2; ++n) if (col0 + bj * HALF + n * 16 < ncols) *(f32x4*)(rowp + bj * HALF + n * 16) = acc[ai][bj][m][n]; }
    }
};
struct EpiBf16 {
    bf16_t* O; int ldc;
    __device__ __forceinline__ void operator()(const f32x4 (&acc)[2][2][4][2], const Unit& u, int wr, int wc, int fr, int fq) const {
        const int row0 = u.pm * BM + wr * 64 + fr, col0 = u.pn * BM + wc * 32 + 4 * fq;
#pragma unroll
        for (int ai = 0; ai < 2; ++ai)
#pragma unroll
            for (int m = 0; m < 4; ++m) { bf16_t* rowp = O + (size_t)(row0 + ai * HALF + m * 16) * ldc + col0;
#pragma unroll
                for (int bj = 0; bj < 2; ++bj)
#pragma unroll
                    for (int n = 0; n < 2; ++n) { const f32x4 v = acc[ai][bj][m][n]; u32x2 w; w.x = cvt_pk_bf16(v[0], v[1]); w.y = cvt_pk_bf16(v[2], v[3]); *(u32x2*)(rowp + bj * HALF + n * 16) = w; } }
    }
};
struct EpiSwiglu {
    bf16_t* O; int ldc;
    __device__ __forceinline__ void operator()(const f32x4 (&acc)[2][2][4][2], const Unit& u, int wr, int wc, int fr, int fq) const {
        const int row0 = u.pm * BM + wr * 64 + fr, col0 = u.pn * HALF + wc * 32 + 4 * fq;
#pragma unroll
        for (int ai = 0; ai < 2; ++ai)
#pragma unroll
            for (int m = 0; m < 4; ++m) { bf16_t* rowp = O + (size_t)(row0 + ai * HALF + m * 16) * ldc + col0;
#pragma unroll
                for (int n = 0; n < 2; ++n) { const f32x4 g = acc[ai][0][m][n], v = acc[ai][1][m][n]; float r[4];
#pragma unroll
                    for (int j = 0; j < 4; ++j) r[j] = g[j] / (1.0f + __expf(-g[j])) * v[j];
                    u32x2 w; w.x = cvt_pk_bf16(r[0], r[1]); w.y = cvt_pk_bf16(r[2], r[3]); *(u32x2*)(rowp + n * 16) = w; } }
    }
};
template <class Epi, class Sched>
__device__ __forceinline__ void gemm_phase(LAS unsigned char* lds, const Gemm g, const Sched& S, const Epi& E) {
    const int tid = otid(), wid = __builtin_amdgcn_readfirstlane(tid >> 6), lane = tid & 63, wr = wid >> 2, wc = wid & 3, fr = lane & 15, fq = lane >> 4;
    const int K = g.K, nt = K / BK;
    unsigned voffA[2], voffB[2];
#pragma unroll
    for (int i = 0; i < 2; ++i) { int R_, C_; stage_rc(tid * 16 + i * 8192, R_, C_); voffA[i] = (unsigned)(R_ * K + C_) * 2u; voffB[i] = voffA[i]; }
    const size_t kstep = (size_t)(BK * 2);
    const size_t hstep = (size_t)HALF * K * 2;
    const size_t tstep = 2 * hstep;
    const unsigned ldsw = (unsigned)wid * 1024u;
    const int aoff = lds_byte(wr * 64 + fr, fq * 8), boff = lds_byte(wc * 32 + fr, fq * 8);
#define PG8_SA(b, h) (((b) * 2 + (h)) * HTB)
#define PG8_SB(b, h) ((4 + (b) * 2 + (h)) * HTB)
#define PG8_STAGE(bufoff, gbase, voff) do { _Pragma("unroll") for (int _i = 0; _i < 2; ++_i) \
        __builtin_amdgcn_global_load_lds((const unsigned*)((const char*)(gbase) + (voff)[_i]), (LAS unsigned*)(lds + (bufoff) + ldsw + _i * 8192), 16, 0, 0); } while (0)
#define PG8_LDA(dst, b, h) do { _Pragma("unroll") for (int m = 0; m < 4; ++m) _Pragma("unroll") for (int k = 0; k < 2; ++k) dst[m][k] = *(const LAS bf16x8*)(lds + PG8_SA(b, h) + aoff + m * 2048 + k * 1024); } while (0)
#define PG8_LDB(dst, b, h) do { _Pragma("unroll") for (int n = 0; n < 2; ++n) _Pragma("unroll") for (int k = 0; k < 2; ++k) dst[n][k] = *(const LAS bf16x8*)(lds + PG8_SB(b, h) + boff + n * 2048 + k * 1024); } while (0)
#define PG8_MMA(ai, bj, At, Bt) do { __builtin_amdgcn_s_setprio(1); _Pragma("unroll") for (int m = 0; m < 4; ++m) _Pragma("unroll") for (int n = 0; n < 2; ++n) _Pragma("unroll") for (int k = 0; k < 2; ++k) \
        acc[ai][bj][m][n] = __builtin_amdgcn_mfma_f32_16x16x32_bf16(Bt[n][k], At[m][k], acc[ai][bj][m][n], 0, 0, 0); __builtin_amdgcn_s_setprio(0); } while (0)
#define PG8_WAIT_V(n) asm volatile("s_waitcnt vmcnt(" #n ")" ::: "memory")
#define PG8_WAIT_L(n) asm volatile("s_waitcnt lgkmcnt(" #n ")" ::: "memory")
#define PG8_BAR __builtin_amdgcn_s_barrier()
#define PG8_SCHED __builtin_amdgcn_sched_barrier(0)
    Unit cur, nxt; int ui = 0;
    if (!S.next(0, cur)) return;
    f32x4 acc[2][2][4][2];
#pragma unroll
    for (int a = 0; a < 2; ++a)
#pragma unroll
        for (int b = 0; b < 2; ++b)
#pragma unroll
            for (int m = 0; m < 4; ++m)
#pragma unroll
                for (int n = 0; n < 2; ++n) acc[a][b][m][n] = (f32x4){0.f, 0.f, 0.f, 0.f};
    bf16x8 At[4][2], B0[2][2], B1[2][2];
    const char* cA = (const char*)g.A + (size_t)cur.pm * tstep; const char* cB = (const char*)g.Bt + S.boff(cur, tstep);
    PG8_STAGE(PG8_SB(0, 0), cB, voffB); PG8_STAGE(PG8_SA(0, 0), cA, voffA); PG8_STAGE(PG8_SB(0, 1), cB + hstep, voffB); PG8_STAGE(PG8_SA(0, 1), cA + hstep, voffA);
    if (wr == 1) PG8_BAR;
    PG8_WAIT_V(4); PG8_BAR;
    PG8_STAGE(PG8_SB(1, 0), cB + kstep, voffB); PG8_STAGE(PG8_SA(1, 0), cA + kstep, voffA); PG8_STAGE(PG8_SB(1, 1), cB + hstep + kstep, voffB);
    PG8_WAIT_V(6); PG8_BAR;
    for (;;) {
        const bool has_next = S.next(ui + 1, nxt);
        const char* nA = has_next ? (const char*)g.A + (size_t)nxt.pm * tstep : cA; const char* nB = has_next ? (const char*)g.Bt + S.boff(nxt, tstep) : cB;
        for (int t = 0; t < nt; t += 2) {
            const bool last = (t == nt - 2);
            const char* a1 = cA + (size_t)(t + 1) * kstep;
            const char* a2 = last ? nA : cA + (size_t)(t + 2) * kstep; const char* b2 = last ? nB : cB + (size_t)(t + 2) * kstep;
            const char* a3 = a2 + kstep; const char* b3 = b2 + kstep;
            PG8_LDB(B0, 0, 0); PG8_SCHED; PG8_LDA(At, 0, 0); PG8_STAGE(PG8_SA(1, 1), a1 + hstep, voffA);
            PG8_WAIT_L(8); PG8_BAR; PG8_WAIT_L(0); PG8_MMA(0, 0, At, B0); PG8_BAR; PG8_SCHED;
            PG8_LDB(B1, 0, 1); PG8_STAGE(PG8_SB(0, 0), b2, voffB);
            PG8_BAR; PG8_WAIT_L(0); PG8_MMA(0, 1, At, B1); PG8_BAR;
            PG8_LDA(At, 0, 1); PG8_STAGE(PG8_SA(0, 0), a2, voffA);
            PG8_BAR; PG8_WAIT_L(0); PG8_MMA(1, 0, At, B0); PG8_BAR; PG8_SCHED;
            PG8_STAGE(PG8_SB(0, 1), b2 + hstep, voffB);
            PG8_WAIT_V(6); PG8_BAR; PG8_MMA(1, 1, At, B1); PG8_BAR;
            PG8_LDB(B0, 1, 0); PG8_SCHED; PG8_LDA(At, 1, 0); PG8_STAGE(PG8_SA(0, 1), a2 + hstep, voffA);
            PG8_WAIT_L(8); PG8_BAR; PG8_WAIT_L(0); PG8_MMA(0, 0, At, B0); PG8_BAR; PG8_SCHED;
            PG8_LDB(B1, 1, 1); PG8_STAGE(PG8_SB(1, 0), b3, voffB);
            PG8_BAR; PG8_WAIT_L(0); PG8_MMA(0, 1, At, B1); PG8_BAR;
            PG8_LDA(At, 1, 1); PG8_STAGE(PG8_SA(1, 0), a3, voffA);
            PG8_BAR; PG8_WAIT_L(0); PG8_MMA(1, 0, At, B0); PG8_BAR; PG8_SCHED;
            PG8_STAGE(PG8_SB(1, 1), b3 + hstep, voffB);
            PG8_WAIT_V(6); PG8_BAR; PG8_MMA(1, 1, At, B1); PG8_BAR;
        }
        E(acc, cur, wr, wc, fr, fq);
        if (!has_next) break;
#pragma unroll
        for (int a = 0; a < 2; ++a)
#pragma unroll
            for (int b = 0; b < 2; ++b)
#pragma unroll
                for (int m = 0; m < 4; ++m)
#pragma unroll
                    for (int n = 0; n < 2; ++n) acc[a][b][m][n] = (f32x4){0.f, 0.f, 0.f, 0.f};
        cur = nxt; cA = nA; cB = nB; ++ui;
    }
    PG8_WAIT_V(0);
    if (wr == 0) PG8_BAR;
    PG8_BAR;
#undef PG8_SA
#undef PG8_SB
#undef PG8_STAGE
#undef PG8_LDA
#undef PG8_LDB
#undef PG8_MMA
#undef PG8_WAIT_V
#undef PG8_WAIT_L
#undef PG8_BAR
#undef PG8_SCHED
}
}

struct ConvDesc { const float* src; bf16_t* dst; int K, N, ldk, nblk, nmul, noff, nmat; long sstride, dstride; };
__device__ __forceinline__ void conv_wT(const ConvDesc& d, int bid, int nb, float* smem) {
    const int tid = otid();
    const int tk = d.K / 64, tn = d.N / 64, per = tk * tn;
    for (int u = bid; u < d.nmat * per; u += nb) {
        const int mat = u / per, t = u % per, kt = t / tn, ntl = t % tn;
        const float* s = d.src + (long)mat * d.sstride + (long)(kt * 64) * d.N + ntl * 64;
        __syncthreads();
#pragma unroll
        for (int ps = 0; ps < 2; ++ps) {
            const int kk = (tid >> 4) + ps * 32, n4 = (tid & 15) * 4;
            const float4 v = ld4(s + (long)kk * d.N + n4);
            smem[kk * 65 + n4 + 0] = v.x; smem[kk * 65 + n4 + 1] = v.y; smem[kk * 65 + n4 + 2] = v.z; smem[kk * 65 + n4 + 3] = v.w;
        }
        __syncthreads();
        const int n = tid >> 3, k8 = (tid & 7) * 8;
        u32x4 w;
        w.x = cvt_pk_bf16(smem[(k8 + 0) * 65 + n], smem[(k8 + 1) * 65 + n]); w.y = cvt_pk_bf16(smem[(k8 + 2) * 65 + n], smem[(k8 + 3) * 65 + n]);
        w.z = cvt_pk_bf16(smem[(k8 + 4) * 65 + n], smem[(k8 + 5) * 65 + n]); w.w = cvt_pk_bf16(smem[(k8 + 6) * 65 + n], smem[(k8 + 7) * 65 + n]);
        const int gn = ntl * 64 + n;
        const int drow = (d.nblk < 0) ? (((gn >> 7) & 1) * 512 + (gn >> 8) * 128 + (gn & 127)) : ((gn / d.nblk) * d.nmul + d.noff + gn % d.nblk);
        *(u32x4*)(d.dst + (long)mat * d.dstride + (long)drow * d.ldk + kt * 64 + k8) = w;
    }
}

__device__ __forceinline__ void conv_first(const Params& p, int bid, int nb, float* smem) {
    const ConvDesc c_in{p.w_in, p.WinT, D, INC, D, 1 << 30, 0, 0, 1, (long)D * INC, (long)INP * D};
    conv_wT(c_in, bid, nb, smem);
    const ConvDesc c_uq{p.w_uq, p.WuqT, 384, 768, 384, 1 << 30, 0, 0, 1, 384L * 768, 768L * 384};
    conv_wT(c_uq, bid, nb, smem);
    const ConvDesc c_ukv{p.w_ukv, p.WukvT, 128, 1024, 256, -1, 0, 0, 1, 128L * 1024, 1024L * 256};
    conv_wT(c_ukv, bid, nb, smem);
}
__device__ __forceinline__ void conv_rest(const Params& p, int bid, int nb, float* smem) {
    const ConvDesc c_out{p.w_out, p.WoutT, D, D, D, 1 << 30, 0, 0, DEPTH, (long)D * D, (long)D * D};
    conv_wT(c_out, bid, nb, smem);
    const ConvDesc c_in{p.w_in + (long)D * INC, p.WinT + (long)INP * D, D, INC, D, 1 << 30, 0, 0, DEPTH - 1, (long)D * INC, (long)INP * D};
    conv_wT(c_in, bid, nb, smem);
    const ConvDesc c_uq{p.w_uq + 384L * 768, p.WuqT + 768L * 384, 384, 768, 384, 1 << 30, 0, 0, DEPTH - 1, 384L * 768, 768L * 384};
    conv_wT(c_uq, bid, nb, smem);
    const ConvDesc c_ukv{p.w_ukv + 128L * 1024, p.WukvT + 1024L * 256, 128, 1024, 256, -1, 0, 0, DEPTH - 1, 128L * 1024, 1024L * 256};
    conv_wT(c_ukv, bid, nb, smem);
}
__device__ __forceinline__ void conv_moe(const Params& p, int l, int bid, int nb, float* smem) {
    const ConvDesc c_w1{p.w1 + (long)l * NEXP * D * FF, p.W13T + (long)l * NEXP * 1024 * D, D, FF, D, 128, 256, 0, NEXP, (long)D * FF, 1024L * D};
    conv_wT(c_w1, bid, nb, smem);
    const ConvDesc c_w3{p.w3 + (long)l * NEXP * D * FF, p.W13T + (long)l * NEXP * 1024 * D, D, FF, D, 128, 256, 128, NEXP, (long)D * FF, 1024L * D};
    conv_wT(c_w3, bid, nb, smem);
    const ConvDesc c_w2{p.w2 + (long)l * NEXP * FF * D, p.W2T + (long)l * NEXP * D * FF, FF, D, FF, 1 << 30, 0, 0, NEXP, (long)FF * D, (long)D * FF};
    conv_wT(c_w2, bid, nb, smem);
}
__device__ __forceinline__ void ph_prologue(const Params& p, int bid, int nb, float* smem) {
    const int tid = otid();
    {
        const long n4 = (long)R * D / 4, nl4 = (long)NLAT * D / 4;
        for (long i = (long)bid * NTH + tid; i < n4; i += (long)nb * NTH) {
            float4 v = (i < nl4) ? ld4(p.x + i * 4) : ld4(p.ctx + (i - nl4) * 4);
            st4(p.xc + i * 4, v);
        }
    }
    for (int u = bid; u < DEPTH * 96; u += nb) {
        const int l = u / 96, jb = u % 96;
        __syncthreads();
        for (int i = tid; i < 3 * D; i += NTH) {
            const int r = i / D, k = i % D;
            const float cv = (r < 2) ? p.c[r * D + k] : p.c_ctx[k];
            smem[i] = siluf(cv);
        }
        __syncthreads();
        const int cc = tid & 127, ks = tid >> 7;
        const float* w = p.w_ada + (long)l * D * (6 * D) + (long)(ks * 512) * (6 * D) + jb * 128 + cc;
        const float* sc = smem + ks * 512;
        float a0 = 0.f, a1 = 0.f, a2 = 0.f;
#pragma unroll 8
        for (int k = 0; k < 512; ++k) {
            const float wv = w[(long)k * (6 * D)];
            a0 = fmaf(sc[k], wv, a0); a1 = fmaf(sc[D + k], wv, a1); a2 = fmaf(sc[2 * D + k], wv, a2);
        }
        float* red = smem + 3 * D;
        red[(ks * 3 + 0) * 128 + cc] = a0; red[(ks * 3 + 1) * 128 + cc] = a1; red[(ks * 3 + 2) * 128 + cc] = a2;
        __syncthreads();
        if (tid < 384) {
            const int r = tid >> 7;
            const float v = (red[(0 * 3 + r) * 128 + cc] + red[(1 * 3 + r) * 128 + cc]) + (red[(2 * 3 + r) * 128 + cc] + red[(3 * 3 + r) * 128 + cc]);
            p.modv[((long)l * 3 + r) * 6 * D + jb * 128 + cc] = v + p.b_ada[l * 6 * D + jb * 128 + cc];
        }
    }
    __syncthreads();
    conv_first(p, bid, nb, smem);
    {
        const u32x4 z = {0u, 0u, 0u, 0u};
        for (long i = (long)bid * NTH + tid; i < (long)DEPTH * (INP - INC) * D / 8; i += (long)nb * NTH) {
            const long per = (long)(INP - INC) * D / 8; const int l = (int)(i / per); const long o = i % per;
            *(u32x4*)(p.WinT + (long)l * INP * D + (long)INC * D + o * 8) = z;
        }
        for (long i = (long)bid * NTH + tid; i < (long)DEPTH * 1024 * 16; i += (long)nb * NTH) {
            const long row = i / 16; const int c8 = (int)(i % 16) * 8;
            *(u32x4*)(p.WukvT + row * 256 + 128 + c8) = z;
        }
    }
}

struct Row { float4 v[8]; };
__device__ __forceinline__ void row_load(Row& r, const float* p, int lane) {
#pragma unroll
    for (int i = 0; i < 8; ++i) r.v[i] = ld4(p + (i * 64 + lane) * 4);
}
__device__ __forceinline__ void row_store(const Row& r, float* p, int lane) {
#pragma unroll
    for (int i = 0; i < 8; ++i) st4(p + (i * 64 + lane) * 4, r.v[i]);
}
__device__ __forceinline__ void row_store_bf16(const Row& r, bf16_t* p, int lane) {
#pragma unroll
    for (int i = 0; i < 8; ++i) { u32x2 w; w.x = cvt_pk_bf16(r.v[i].x, r.v[i].y); w.y = cvt_pk_bf16(r.v[i].z, r.v[i].w); *(u32x2*)(p + (i * 64 + lane) * 4) = w; }
}
__device__ __forceinline__ void row_stats(const Row& r, float& mean, float& rstd) {
    float s = 0.f;
#pragma unroll
    for (int i = 0; i < 8; ++i) s += (r.v[i].x + r.v[i].y) + (r.v[i].z + r.v[i].w);
    mean = wsum(s) * (1.0f / D);
    float q = 0.f;
#pragma unroll
    for (int i = 0; i < 8; ++i) { const float a = r.v[i].x - mean, b = r.v[i].y - mean, c = r.v[i].z - mean, d = r.v[i].w - mean; q += (a * a + b * b) + (c * c + d * d); }
    rstd = rsqrtf(wsum(q) * (1.0f / D) + EPS);
}
__device__ __forceinline__ void row_modulate(Row& r, float mean, float rstd, const float* sh, const float* sc, int lane) {
#pragma unroll
    for (int i = 0; i < 8; ++i) {
        const int c = (i * 64 + lane) * 4;
        const float4 s = ld4(sc + c), h = ld4(sh + c);
        r.v[i].x = (r.v[i].x - mean) * rstd * (1.f + s.x) + h.x; r.v[i].y = (r.v[i].y - mean) * rstd * (1.f + s.y) + h.y;
        r.v[i].z = (r.v[i].z - mean) * rstd * (1.f + s.z) + h.z; r.v[i].w = (r.v[i].w - mean) * rstd * (1.f + s.w) + h.w;
    }
}
__device__ __forceinline__ void row_affine(Row& r, float mean, float rstd, const float* g, const float* b, int lane) {
#pragma unroll
    for (int i = 0; i < 8; ++i) {
        const int c = (i * 64 + lane) * 4;
        const float4 s = ld4(g + c), h = ld4(b + c);
        r.v[i].x = (r.v[i].x - mean) * rstd * s.x + h.x; r.v[i].y = (r.v[i].y - mean) * rstd * s.y + h.y;
        r.v[i].z = (r.v[i].z - mean) * rstd * s.z + h.z; r.v[i].w = (r.v[i].w - mean) * rstd * s.w + h.w;
    }
}

__device__ __forceinline__ void ph_lnmod(const Params& p, int l, int bid, int nb) {
    const int tid = otid(), lane = tid & 63, wid = tid >> 6;
    for (int r = bid * NWV + wid; r < R; r += nb * NWV) {
        Row x; row_load(x, p.xc + (long)r * D, lane);
        float mean, rstd; row_stats(x, mean, rstd);
        const float* mv = p.modv + ((long)l * 3 + mod_row(r)) * 6 * D;
        row_modulate(x, mean, rstd, mv + 0 * D, mv + 1 * D, lane);
        row_store_bf16(x, p.hb + (long)r * D, lane);
    }
}

__device__ __forceinline__ void ph_prep(const Params& p, int l, int bid, int nb) {
    const int tid = otid(), lane = tid & 63, wid = tid >> 6;
    for (int rr = 0; rr < 8 * (R / 64); ++rr) {
        const int grp = rr >> 3;
        const int g64 = bid + (grp) * nb; if (g64 >= R / 64) break;
        const int r = g64 * 64 + wid * 8 + (rr & 7);
        const float* pr = p.P + (long)r * INC;
        const bool lat = r < NLAT;
        const int t = r % T; const float rowi = (float)(t / 64), coli = (float)(t % 64);
        {
            float sn = 0.f, cs = 1.f;
            if (lat) { const int f = lane & 31; const float inv = powf(10000.0f, -(float)f / 32.0f); sincosf((lane < 32 ? rowi : coli) * inv, &sn, &cs); }
#pragma unroll
            for (int h = 0; h < 6; ++h) {
                const float x1 = pr[SQ + h * 128 + lane], x2 = pr[SQ + h * 128 + lane + 64];
                const bf16_t y1 = f2bf(x1 * cs - x2 * sn), y2 = f2bf(x2 * cs + x1 * sn);
                bf16_t* d = (h < 4) ? (p.sqb + (long)r * 512 + h * 128) : (p.skb + (long)r * 256 + (h - 4) * 128);
                d[lane] = y1; d[lane + 64] = y2;
            }
#pragma unroll
            for (int i = 0; i < 4; ++i) p.svT[(long)(i * 64 + lane) * R + r] = f2bf(pr[SV + i * 64 + lane]);
        }
        if (lane < 32) {
            float sn = 0.f, cs = 1.f;
            if (lat) { const int f = lane & 15; const float inv = powf(10000.0f, -(float)f / 16.0f); sincosf((lane < 16 ? rowi : coli) * inv, &sn, &cs); }
            const float x1 = pr[KR + lane], x2 = pr[KR + lane + 32];
            p.Krb[(long)r * 64 + lane] = f2bf(x1 * cs - x2 * sn); p.Krb[(long)r * 64 + lane + 32] = f2bf(x2 * cs + x1 * sn);
        }
        {
            float v[6]; float s = 0.f;
#pragma unroll
            for (int i = 0; i < 6; ++i) { v[i] = pr[CQ + i * 64 + lane]; s += v[i] * v[i]; }
            const float rs = rsqrtf(wsum(s) * (1.0f / 384.0f) + EPS);
#pragma unroll
            for (int i = 0; i < 6; ++i) p.cqn[(long)r * 384 + i * 64 + lane] = f2bf(v[i] * rs * p.q_norm[l * 384 + i * 64 + lane]);
            const float a = pr[CKV + lane], b = pr[CKV + 64 + lane];
            const float rs2 = rsqrtf(wsum(a * a + b * b) * (1.0f / 128.0f) + EPS);
            p.ckvn[(long)r * 256 + lane] = f2bf(a * rs2 * p.kv_norm[l * 128 + lane]);
            p.ckvn[(long)r * 256 + 64 + lane] = f2bf(b * rs2 * p.kv_norm[l * 128 + 64 + lane]);
            p.ckvn[(long)r * 256 + 128 + lane] = 0; p.ckvn[(long)r * 256 + 192 + lane] = 0;
        }
    }
}

struct AttnSrc {
    const bf16_t* Q; int ldq, qoff;
    const bf16_t* K1; int ldk1, k1off;
    const bf16_t* K2; int ldk2;
    const bf16_t* Vt; int ldv, voff;
    bf16_t* O; int ldo, ooff;
};
template <bool MLA>
__device__ __forceinline__ void attn_unit(const AttnSrc& a, int qrow0, int ctxrow0, int locrow0, int nloc, bool win, int tq0, int tk0, bool rope_q,
                                          float sink_l2, float c, LAS unsigned char* lds) {
    constexpr int KSTR = MLA ? 400 : 272, NKS = MLA ? 6 : 4, VSTR = 144, KBYTES = 64 * KSTR, BUFB = KBYTES + 128 * VSTR, NCH = MLA ? 5 : 4;
    const int tid = otid(), lane = tid & 63, wid = tid >> 6, fr = lane & 15, fq = lane >> 4;
    const int ntiles = 4 + nloc;
    bf16x8 qf[NKS];
    {
        const bf16_t* qp = a.Q + (long)(qrow0 + wid * 16 + fr) * a.ldq + a.qoff + fq * 8;
#pragma unroll
        for (int ks = 0; ks < NKS; ++ks) qf[ks] = *(const bf16x8*)(qp + ks * 32);
        if (MLA && rope_q) {
            const int t = tq0 + wid * 16 + fr; const float rowi = (float)(t / 64), coli = (float)(t % 64);
#pragma unroll
            for (int e = 0; e < 8; ++e) {
                const int i = fq * 8 + e, f = i & 15;
                const float inv = powf(10000.0f, -(float)f / 16.0f);
                const float ang = (i < 16 ? rowi : coli) * inv;
                float sn, cs; sincosf(ang, &sn, &cs);
                const float x1 = __uint_as_float(((unsigned)(unsigned short)qf[4][e]) << 16), x2 = __uint_as_float(((unsigned)(unsigned short)qf[5][e]) << 16);
                qf[4][e] = (short)f2bf(x1 * cs - x2 * sn); qf[5][e] = (short)f2bf(x2 * cs + x1 * sn);
            }
        }
    }
    f32x4 o[8];
#pragma unroll
    for (int dt = 0; dt < 8; ++dt) o[dt] = (f32x4){0.f, 0.f, 0.f, 0.f};
    float m = -INFINITY, l = 0.f;
    u32x4 rg[NCH];
#define ATT_LOAD(keyrow0) do { \
        const int kr_ = (keyrow0); \
        rg[0] = *(const u32x4*)(a.K1 + (long)(kr_ + (tid >> 4)) * a.ldk1 + a.k1off + (tid & 15) * 8); \
        rg[1] = *(const u32x4*)(a.K1 + (long)(kr_ + 32 + (tid >> 4)) * a.ldk1 + a.k1off + (tid & 15) * 8); \
        if (MLA) { rg[2] = *(const u32x4*)(a.K2 + (long)(kr_ + (tid >> 3)) * a.ldk2 + (tid & 7) * 8); \
                   rg[3] = *(const u32x4*)(a.Vt + (long)(a.voff + (tid >> 3)) * a.ldv + kr_ + (tid & 7) * 8); \
                   rg[NCH - 1] = *(const u32x4*)(a.Vt + (long)(a.voff + 64 + (tid >> 3)) * a.ldv + kr_ + (tid & 7) * 8); } \
        else { rg[2] = *(const u32x4*)(a.Vt + (long)(a.voff + (tid >> 3)) * a.ldv + kr_ + (tid & 7) * 8); \
               rg[NCH - 1] = *(const u32x4*)(a.Vt + (long)(a.voff + 64 + (tid >> 3)) * a.ldv + kr_ + (tid & 7) * 8); } } while (0)
#define ATT_STORE(buf) do { LAS unsigned char* b_ = (buf); \
        *(LAS u32x4*)(b_ + (tid >> 4) * KSTR + (tid & 15) * 16) = rg[0]; \
        *(LAS u32x4*)(b_ + (32 + (tid >> 4)) * KSTR + (tid & 15) * 16) = rg[1]; \
        if (MLA) { *(LAS u32x4*)(b_ + (tid >> 3) * KSTR + 256 + (tid & 7) * 16) = rg[2]; \
                   *(LAS u32x4*)(b_ + KBYTES + (tid >> 3) * VSTR + (tid & 7) * 16) = rg[3]; \
                   *(LAS u32x4*)(b_ + KBYTES + (64 + (tid >> 3)) * VSTR + (tid & 7) * 16) = rg[NCH - 1]; } \
        else { *(LAS u32x4*)(b_ + KBYTES + (tid >> 3) * VSTR + (tid & 7) * 16) = rg[2]; \
               *(LAS u32x4*)(b_ + KBYTES + (64 + (tid >> 3)) * VSTR + (tid & 7) * 16) = rg[NCH - 1]; } } while (0)
#define ATT_KEYROW(i) ((i) < 4 ? ctxrow0 + 64 * (i) : locrow0 + 64 * ((i) - 4))
    __syncthreads();
    ATT_LOAD(ATT_KEYROW(0));
    ATT_STORE(lds);
    __syncthreads();
    for (int t = 0; t < ntiles; ++t) {
        LAS unsigned char* buf = lds + (t & 1) * BUFB;
        if (t + 1 < ntiles) ATT_LOAD(ATT_KEYROW(t + 1));
        f32x4 s[4];
#pragma unroll
        for (int kt = 0; kt < 4; ++kt) {
            s[kt] = (f32x4){0.f, 0.f, 0.f, 0.f};
#pragma unroll
            for (int ks = 0; ks < NKS; ++ks) {
                const bf16x8 kf = *(const LAS bf16x8*)(buf + (kt * 16 + fr) * KSTR + ks * 64 + fq * 16);
                s[kt] = __builtin_amdgcn_mfma_f32_16x16x32_bf16(kf, qf[ks], s[kt], 0, 0, 0);
            }
        }
        if (win && t >= 4) {
            const int tq = tq0 + wid * 16 + fr, tkb = tk0 + 64 * (t - 4) + 4 * fq;
#pragma unroll
            for (int kt = 0; kt < 4; ++kt)
#pragma unroll
                for (int j = 0; j < 4; ++j) { const int d = tkb + kt * 16 + j - tq; if (d < -128 || d > 128) s[kt][j] = -INFINITY; }
        }
        float mx = fmaxf(fmaxf(fmaxf(s[0][0], s[0][1]), fmaxf(s[0][2], s[0][3])), fmaxf(fmaxf(s[1][0], s[1][1]), fmaxf(s[1][2], s[1][3])));
        mx = fmaxf(mx, fmaxf(fmaxf(fmaxf(s[2][0], s[2][1]), fmaxf(s[2][2], s[2][3])), fmaxf(fmaxf(s[3][0], s[3][1]), fmaxf(s[3][2], s[3][3]))));
        mx = fmaxf(mx, __shfl_xor(mx, 16)); mx = fmaxf(mx, __shfl_xor(mx, 32));
        const float mn = fmaxf(m, mx * c);
        const float alpha = __builtin_amdgcn_exp2f(m - mn);
        m = mn;
        float ps = 0.f;
#pragma unroll
        for (int kt = 0; kt < 4; ++kt)
#pragma unroll
            for (int j = 0; j < 4; ++j) { const float pv = __builtin_amdgcn_exp2f(fmaf(s[kt][j], c, -mn)); s[kt][j] = pv; ps += pv; }
        l = l * alpha + ps;
#pragma unroll
        for (int dt = 0; dt < 8; ++dt) o[dt] = o[dt] * alpha;
#pragma unroll
        for (int s2 = 0; s2 < 2; ++s2) {
            u32x4 pk; pk.x = cvt_pk_bf16(s[2 * s2][0], s[2 * s2][1]); pk.y = cvt_pk_bf16(s[2 * s2][2], s[2 * s2][3]);
            pk.z = cvt_pk_bf16(s[2 * s2 + 1][0], s[2 * s2 + 1][1]); pk.w = cvt_pk_bf16(s[2 * s2 + 1][2], s[2 * s2 + 1][3]);
            const bf16x8 pf = __builtin_bit_cast(bf16x8, pk);
#pragma unroll
            for (int dt = 0; dt < 8; ++dt) {
                const LAS unsigned char* vp = buf + KBYTES + (dt * 16 + fr) * VSTR + (32 * s2 + 4 * fq) * 2;
                const u32x2 lo = *(const LAS u32x2*)vp, hi = *(const LAS u32x2*)(vp + 32);
                u32x4 vv; vv.x = lo.x; vv.y = lo.y; vv.z = hi.x; vv.w = hi.y;
                o[dt] = __builtin_amdgcn_mfma_f32_16x16x32_bf16(__builtin_bit_cast(bf16x8, vv), pf, o[dt], 0, 0, 0);
            }
        }
        __syncthreads();
        if (t + 1 < ntiles) ATT_STORE(lds + ((t + 1) & 1) * BUFB);
        __syncthreads();
    }
#undef ATT_LOAD
#undef ATT_STORE
#undef ATT_KEYROW
    l += __shfl_xor(l, 16); l += __shfl_xor(l, 32);
    if (sink_l2 > -INFINITY) { const float mn = fmaxf(m, sink_l2); const float alpha = __builtin_amdgcn_exp2f(m - mn); l = l * alpha + __builtin_amdgcn_exp2f(sink_l2 - mn);
#pragma unroll
        for (int dt = 0; dt < 8; ++dt) o[dt] = o[dt] * alpha; }
    const float il = 1.0f / l;
    bf16_t* op = a.O + (long)(qrow0 + wid * 16 + fr) * a.ldo + a.ooff + 4 * fq;
#pragma unroll
    for (int dt = 0; dt < 8; ++dt) { u32x2 w; w.x = cvt_pk_bf16(o[dt][0] * il, o[dt][1] * il); w.y = cvt_pk_bf16(o[dt][2] * il, o[dt][3] * il); *(u32x2*)(op + dt * 16) = w; }
}


__device__ __forceinline__ float bf2f(bf16_t v) { return __uint_as_float(((unsigned)v) << 16); }
#define OSM_UPDATE(S, M_, L_, A0, A1, V0, V1) do { const float mn_ = fmaxf(M_, S); const float cr_ = expf(M_ - mn_); const float pp_ = expf((S) - mn_); \
    L_ = L_ * cr_ + pp_; A0 = A0 * cr_ + pp_ * (V0); A1 = A1 * cr_ + pp_ * (V1); M_ = mn_; } while (0)
__device__ __forceinline__ void swa_task(const Params& p, int l, int h, int r0, int lane) {
    constexpr int QW = 4;
    const float scale = 0.08838834764831845f;
    const bool lat = r0 < NLAT;
    const int b = lat ? r0 / T : (r0 - NLAT) / LCTX;
    const int kvh = h >> 1;
    float q0[QW], q1[QW], m[QW], ls[QW], a0[QW], a1[QW];
#pragma unroll
    for (int i = 0; i < QW; ++i) {
        const bf16_t* q = p.sqb + (long)(r0 + i) * 512 + h * 128;
        q0[i] = bf2f(q[lane]) * scale; q1[i] = bf2f(q[lane + 64]) * scale; m[i] = -INFINITY; ls[i] = 0.f; a0[i] = 0.f; a1[i] = 0.f;
    }
    for (int j = 0; j < LCTX; ++j) {
        const long rk = NLAT + b * LCTX + j;
        const float k0 = bf2f(p.skb[rk * 256 + kvh * 128 + lane]), k1 = bf2f(p.skb[rk * 256 + kvh * 128 + 64 + lane]);
        const float v0 = bf2f(p.svT[(long)(kvh * 128 + lane) * R + rk]), v1 = bf2f(p.svT[(long)(kvh * 128 + 64 + lane) * R + rk]);
#pragma unroll
        for (int i = 0; i < QW; ++i) { const float s = wsum(q0[i] * k0 + q1[i] * k1); OSM_UPDATE(s, m[i], ls[i], a0[i], a1[i], v0, v1); }
    }
    if (lat) {
        const int t0 = r0 % T;
        const int lo = (t0 - 128) < 0 ? 0 : (t0 - 128), hi = (t0 + QW - 1 + 128) > (T - 1) ? (T - 1) : (t0 + QW - 1 + 128);
        for (int tk = lo; tk <= hi; ++tk) {
            const long rk = b * T + tk;
            const float k0 = bf2f(p.skb[rk * 256 + kvh * 128 + lane]), k1 = bf2f(p.skb[rk * 256 + kvh * 128 + 64 + lane]);
            const float v0 = bf2f(p.svT[(long)(kvh * 128 + lane) * R + rk]), v1 = bf2f(p.svT[(long)(kvh * 128 + 64 + lane) * R + rk]);
#pragma unroll
            for (int i = 0; i < QW; ++i) {
                const int d = tk - (t0 + i);
                if (d >= -128 && d <= 128) { const float s = wsum(q0[i] * k0 + q1[i] * k1); OSM_UPDATE(s, m[i], ls[i], a0[i], a1[i], v0, v1); }
            }
        }
    }
    const float sk = p.swa_sink[l * 4 + h];
#pragma unroll
    for (int i = 0; i < QW; ++i) {
        OSM_UPDATE(sk, m[i], ls[i], a0[i], a1[i], 0.f, 0.f);
        bf16_t* o = p.mix + (long)(r0 + i) * D + h * 128;
        const float il = 1.0f / ls[i];
        o[lane] = f2bf(a0[i] * il); o[lane + 64] = f2bf(a1[i] * il);
    }
}
__device__ __forceinline__ void mla_task(const Params& p, int h, int r0, int lane) {
    constexpr int QW = 8;
    const float scale = 0.07216878364870323f;
    const bool lat = r0 < NLAT;
    const int b = lat ? r0 / T : (r0 - NLAT) / LCTX;
    float q0[QW], q1[QW], q2[QW], m[QW], ls[QW], a0[QW], a1[QW];
#pragma unroll
    for (int i = 0; i < QW; ++i) {
        const bf16_t* q = p.Q2b + (long)(r0 + i) * 768 + h * 192;
        q0[i] = bf2f(q[lane]) * scale; q1[i] = bf2f(q[lane + 64]) * scale;
        float qr = bf2f(q[128 + lane]);
        if (lat) {
            const int t = (r0 + i) % T; const float rowi = (float)(t / 64), coli = (float)(t % 64);
            const int ii = lane & 31, f = ii & 15;
            const float inv = powf(10000.0f, -(float)f / 16.0f);
            const float ang = (ii < 16 ? rowi : coli) * inv;
            float sn, cs; sincosf(ang, &sn, &cs);
            const float other = __shfl_xor(qr, 32);
            qr = (lane < 32) ? (qr * cs - other * sn) : (qr * cs + other * sn);
        }
        q2[i] = qr * scale; m[i] = -INFINITY; ls[i] = 0.f; a0[i] = 0.f; a1[i] = 0.f;
    }
    const int nkeys = lat ? (LCTX + T) : LCTX;
    for (int j = 0; j < nkeys; ++j) {
        const long rk = (j < LCTX) ? (NLAT + b * LCTX + j) : (b * T + (j - LCTX));
        const float k0 = bf2f(p.Kn[rk * 512 + h * 128 + lane]), k1 = bf2f(p.Kn[rk * 512 + h * 128 + 64 + lane]);
        const float v0 = bf2f(p.VtM[(long)(h * 128 + lane) * R + rk]), v1 = bf2f(p.VtM[(long)(h * 128 + 64 + lane) * R + rk]);
        const float k2 = bf2f(p.Krb[rk * 64 + lane]);
#pragma unroll
        for (int i = 0; i < QW; ++i) { const float s = wsum(q0[i] * k0 + q1[i] * k1 + q2[i] * k2); OSM_UPDATE(s, m[i], ls[i], a0[i], a1[i], v0, v1); }
    }
#pragma unroll
    for (int i = 0; i < QW; ++i) {
        bf16_t* o = p.mix + (long)(r0 + i) * D + 1024 + h * 128;
        const float il = 1.0f / ls[i];
        o[lane] = f2bf(a0[i] * il); o[lane + 64] = f2bf(a1[i] * il);
    }
}

typedef float f32x2 __attribute__((ext_vector_type(2)));
constexpr int NCHK = (LCTX + T) / 64;
__device__ __forceinline__ int scan_row(int b, int dir, int pos) {
    if (pos < LCTX) return NLAT + b * LCTX + (dir ? (LCTX - 1 - pos) : pos);
    const int t = pos - LCTX; return b * T + (dir ? (T - 1 - t) : t);
}
__device__ __forceinline__ float hgrn_lb(const Params& p, int l, int dir, int hi) {
    if (l == 0) return 0.f;
    const float l0 = p.lb_logits[(0 * 2 + dir) * 512 + hi], l1 = p.lb_logits[(1 * 2 + dir) * 512 + hi];
    const float mx = fmaxf(l0, l1), e0 = expf(l0 - mx), e1 = expf(l1 - mx);
    return e1 / (e0 + e1);
}
template <int MIXER>
__device__ __forceinline__ void scan_s1(const Params& p, int l, int bu, float* smem) {
    const int tid = otid(), q4 = tid >> 7, j = tid & 127;
    const int u = bu * 4 + q4, sl = u / NCHK, c = u % NCHK;
    const int b = sl >> 3, h = (sl >> 1) & 3, dir = sl & 1, sq = MIXER * 16 + sl;
    float* kb = smem + q4 * 2048;
    float* fb = kb + 1024;
    f32x2 S[64];
#pragma unroll
    for (int i = 0; i < 64; ++i) S[i] = (f32x2){0.f, 0.f};
    const float gam = (MIXER == 0) ? (1.0f - exp2f(-p.ret_s[(l * 2 + dir) * 4 + h])) : 0.f;
    const float lb = (MIXER == 1) ? hgrn_lb(p, l, dir, h * 128 + j) : 0.f;
    const int koff = (MIXER == 0 ? RK : (dir ? HFB : HFF)) + h * 128 + j, voff = (MIXER == 0 ? RV : HI) + h * 128 + j;
    float ap = 1.f;
    float kr[8], vr[8];
#pragma unroll
    for (int s = 0; s < 8; ++s) { const float* pr = p.P + (long)scan_row(b, dir, c * 64 + s) * INC; kr[s] = pr[koff]; vr[s] = pr[voff]; }
    for (int bt = 0; bt < 8; ++bt) {
        __syncthreads();
        float vv[8];
#pragma unroll
        for (int s = 0; s < 8; ++s) {
            vv[s] = vr[s];
            if (MIXER == 0) kb[s * 128 + j] = kr[s] * 0.08838834764831845f;
            else { const float f = lb + (1.0f - lb) * sigmf(kr[s]); kb[s * 128 + j] = 1.0f - f; fb[s * 128 + j] = f; ap *= f; }
        }
        __syncthreads();
        if (bt < 7) {
#pragma unroll
            for (int s = 0; s < 8; ++s) { const float* pr = p.P + (long)scan_row(b, dir, c * 64 + (bt + 1) * 8 + s) * INC; kr[s] = pr[koff]; vr[s] = pr[voff]; }
        }
#pragma unroll
        for (int s = 0; s < 8; ++s) {
            const f32x2 v2 = (f32x2){vv[s], vv[s]};
#pragma unroll
            for (int i4 = 0; i4 < 32; ++i4) {
                const float4 k4 = ld4(kb + s * 128 + i4 * 4);
                if (MIXER == 0) { S[i4 * 2] = S[i4 * 2] * gam + (f32x2){k4.x, k4.y} * v2; S[i4 * 2 + 1] = S[i4 * 2 + 1] * gam + (f32x2){k4.z, k4.w} * v2; }
                else { const float4 f4 = ld4(fb + s * 128 + i4 * 4);
                    S[i4 * 2] = S[i4 * 2] * (f32x2){f4.x, f4.y} + (f32x2){k4.x, k4.y} * v2; S[i4 * 2 + 1] = S[i4 * 2 + 1] * (f32x2){f4.z, f4.w} + (f32x2){k4.z, k4.w} * v2; }
            }
        }
    }
    if (MIXER == 0) { float g2 = gam * gam; g2 *= g2; g2 *= g2; g2 *= g2; g2 *= g2; ap = g2 * g2; }
    float* up = p.sst + ((long)(sq * NCHK + c) * 128) * 128 + j;
#pragma unroll
    for (int i = 0; i < 64; ++i) { up[(long)(2 * i) * 128] = S[i].x; up[(long)(2 * i + 1) * 128] = S[i].y; }
    p.sA[(long)(sq * NCHK + c) * 128 + j] = ap;
}
__device__ __forceinline__ void ph_scan2(const Params& p, int bid, int nb) {
    const int tid = otid();
    for (int e = bid * NTH + tid; e < 32 * 16384; e += nb * NTH) {
        const int sq = e >> 14, ij = e & 16383, i = ij >> 7;
        float* base = p.sst + (long)sq * NCHK * 16384 + ij;
        const float* A = p.sA + (long)sq * NCHK * 128 + i;
        float S = 0.f;
#pragma unroll 4
        for (int c = 0; c < NCHK; ++c) { const float uv = base[(long)c * 16384]; base[(long)c * 16384] = S; S = fmaf(A[c * 128], S, uv); }
    }
}
template <int MIXER>
__device__ __forceinline__ void scan_s3(const Params& p, int l, int bu, float* smem) {
    const int tid = otid(), half = tid >> 8, grp = tid >> 7, dirn = grp & 1, j = tid & 127, lane = tid & 63;
    const int u = bu * 2 + half, b = u / (4 * NCHK), rem = u % (4 * NCHK), h = rem / NCHK, rb = rem % NCHK;
    const int sq = MIXER * 16 + (b * 4 + h) * 2 + dirn;
    const int cidx = dirn ? (rb < 4 ? 3 - rb : 71 - rb) : rb;
    const int row0 = rb < 4 ? NLAT + b * LCTX + rb * 64 : b * T + (rb - 4) * 64;
    float* qb = smem + grp * 3072;
    float* kb = qb + 1024;
    float* fb = kb + 1024;
    float* ob = smem + 12288 + half * 8192;
    f32x2 S[64];
    {
        const float* sp = p.sst + ((long)(sq * NCHK + cidx) * 128) * 128 + j;
#pragma unroll
        for (int i = 0; i < 64; ++i) { S[i].x = sp[(long)(2 * i) * 128]; S[i].y = sp[(long)(2 * i + 1) * 128]; }
    }
    const float gam = (MIXER == 0) ? (1.0f - exp2f(-p.ret_s[(l * 2 + dirn) * 4 + h])) : 0.f;
    const float lb = (MIXER == 1) ? hgrn_lb(p, l, dirn, h * 128 + j) : 0.f;
    const int qoff = (MIXER == 0 ? RQ : HQ) + h * 128 + j, koff = (MIXER == 0 ? RK : (dirn ? HFB : HFF)) + h * 128 + j, voff = (MIXER == 0 ? RV : HI) + h * 128 + j;
    constexpr int NB = 4;
    float qr[NB], kr[NB], vr[NB];
#pragma unroll
    for (int s = 0; s < NB; ++s) { const int lr = dirn ? 63 - s : s; const float* pr = p.P + (long)(row0 + lr) * INC; qr[s] = pr[qoff]; kr[s] = pr[koff]; vr[s] = pr[voff]; }
    for (int bt = 0; bt < 64 / NB; ++bt) {
        __syncthreads();
        float vv[NB];
#pragma unroll
        for (int s = 0; s < NB; ++s) {
            vv[s] = vr[s];
            if (MIXER == 0) { qb[s * 128 + j] = qr[s]; kb[s * 128 + j] = kr[s] * 0.08838834764831845f; }
            else { const float f = lb + (1.0f - lb) * sigmf(kr[s]); qb[s * 128 + j] = siluf(qr[s]); kb[s * 128 + j] = 1.0f - f; fb[s * 128 + j] = f; }
        }
        __syncthreads();
        if (bt < 64 / NB - 1) {
#pragma unroll
            for (int s = 0; s < NB; ++s) { const int st = (bt + 1) * NB + s, lr = dirn ? 63 - st : st; const float* pr = p.P + (long)(row0 + lr) * INC; qr[s] = pr[qoff]; kr[s] = pr[koff]; vr[s] = pr[voff]; }
        }
#pragma unroll
        for (int s = 0; s < NB; ++s) {
            const f32x2 v2 = (f32x2){vv[s], vv[s]};
            f32x2 o2 = (f32x2){0.f, 0.f};
#pragma unroll
            for (int i4 = 0; i4 < 32; ++i4) {
                const float4 k4 = ld4(kb + s * 128 + i4 * 4), q4 = ld4(qb + s * 128 + i4 * 4);
                if (MIXER == 0) { S[i4 * 2] = S[i4 * 2] * gam + (f32x2){k4.x, k4.y} * v2; S[i4 * 2 + 1] = S[i4 * 2 + 1] * gam + (f32x2){k4.z, k4.w} * v2; }
                else { const float4 f4 = ld4(fb + s * 128 + i4 * 4);
                    S[i4 * 2] = S[i4 * 2] * (f32x2){f4.x, f4.y} + (f32x2){k4.x, k4.y} * v2; S[i4 * 2 + 1] = S[i4 * 2 + 1] * (f32x2){f4.z, f4.w} + (f32x2){k4.z, k4.w} * v2; }
                o2 += S[i4 * 2] * (f32x2){q4.x, q4.y}; o2 += S[i4 * 2 + 1] * (f32x2){q4.z, q4.w};
            }
            const int st = bt * NB + s, lr = dirn ? 63 - st : st;
            const float o = o2.x + o2.y;
            float* op = ob + lr * 128 + j;
            const bool first = dirn ? (lr >= 32) : (lr < 32);
            if (first) *op = o; else *op += o;
        }
    }
    __syncthreads();
    {
        const int w = (tid >> 6) & 3;
        for (int rr = 0; rr < 16; ++rr) {
            const int lr = w * 16 + rr, r = row0 + lr;
            const float a = ob[lr * 128 + lane], bq = ob[lr * 128 + 64 + lane];
            const float* pr = p.P + (long)r * INC;
            const int cc = h * 128 + lane;
            if (MIXER == 0) {
                const float mean = wsum(a + bq) * (1.0f / 128.0f);
                const float da = a - mean, db = bq - mean;
                const float rstd = rsqrtf(wsum(da * da + db * db) * (1.0f / 128.0f) + EPS);
                p.mix[(long)r * D + 512 + cc] = f2bf(siluf(pr[RG + cc]) * (da * rstd * p.ret_gn[l * 512 + cc]));
                p.mix[(long)r * D + 512 + cc + 64] = f2bf(siluf(pr[RG + cc + 64]) * (db * rstd * p.ret_gn[l * 512 + cc + 64]));
            } else {
                const float rs = rsqrtf(wsum(a * a + bq * bq) * (1.0f / 128.0f) + EPS);
                p.mix[(long)r * D + 1536 + cc] = f2bf(siluf(pr[HG + cc]) * (a * rs * p.hgrn_gn[l * 512 + cc]));
                p.mix[(long)r * D + 1536 + cc + 64] = f2bf(siluf(pr[HG + cc + 64]) * (bq * rs * p.hgrn_gn[l * 512 + cc + 64]));
            }
        }
    }
}
__device__ __forceinline__ void ph_scan3(const Params& p, int l, int bid, int nb, float* smem) {
    constexpr int NBU = 2 * 4 * NCHK / 2;
    for (int bu = bid; bu < 2 * NBU; bu += nb) {
        if (bu < NBU) scan_s3<0>(p, l, bu, smem); else scan_s3<1>(p, l, bu - NBU, smem);
    }
}

__device__ __forceinline__ void ph_mixers(const Params& p, int l, int bid, int nb, float* smem, LAS unsigned char* lds) {
    const bool need_ctx = l < DEPTH - 1;
    const float LOG2E = 1.4426950408889634f;
    const float cM = 0.07216878364870323f * LOG2E, cS = 0.08838834764831845f * LOG2E;
#ifndef DIAG_NAIVE
#define DIAG_NAIVE 0
#endif
    if (DIAG_NAIVE) {
        const int tid = otid(), lane = tid & 63, wid = tid >> 6;
        const int nrows = need_ctx ? R : NLAT;
        const int n_mla = (DIAG_NAIVE & 1) ? (nrows / 8) * 4 : ((DIAG_NAIVE & 4) && need_ctx ? (NCTX / 8) * 4 : 0), n_swa = (DIAG_NAIVE & 2) ? (nrows / 4) * 4 : 0;
        const int mla_r0 = (DIAG_NAIVE & 1) ? 0 : NLAT;
        for (int t = bid * NWV + wid; t < n_mla + n_swa; t += nb * NWV) {
            if (t < n_mla) mla_task(p, t & 3, mla_r0 + (t >> 2) * 8, lane);
            else { const int s2 = t - n_mla; swa_task(p, l, s2 & 3, (s2 >> 2) * 4, lane); }
        }
        __syncthreads();
    }
    if (!(DIAG_NAIVE & 1))
    for (int u = bid; u < 256; u += nb) {
        const int b = u >> 7, h = (u >> 5) & 3, qb = u & 31;
        const AttnSrc a{p.Q2b, 768, h * 192, p.Kn, 512, h * 128, p.Krb, 64, p.VtM, R, h * 128, p.mix, D, 1024 + h * 128};
        attn_unit<true>(a, b * T + qb * 128, NLAT + b * LCTX, b * T, 64, false, qb * 128, 0, true, -INFINITY, cM, lds);
    }
    if (!(DIAG_NAIVE & 2))
    for (int u = bid; u < 256; u += nb) {
        const int b = u >> 7, h = (u >> 5) & 3, qb = u & 31, q0 = qb * 128;
        const int ts = (q0 - 128) < 0 ? 0 : (q0 - 128), te = (q0 + 256) > T ? T : (q0 + 256);
        const AttnSrc a{p.sqb, 512, h * 128, p.skb, 256, (h >> 1) * 128, nullptr, 0, p.svT, R, (h >> 1) * 128, p.mix, D, h * 128};
        attn_unit<false>(a, b * T + q0, NLAT + b * LCTX, b * T + ts, (te - ts) / 64, true, q0, ts, false, p.swa_sink[l * 4 + h] * LOG2E, cS, lds);
    }
    if (need_ctx) {
        for (int u = nb - 1 - bid; u < 32; u += nb) {
            const int v = u & 15, b = v >> 3, h = (v >> 1) & 3, qb = v & 1;
            const int qrow0 = NLAT + b * LCTX + qb * 128;
            int nl0 = 0; asm volatile("" : "+s"(nl0));
            if (u < 16) { if (DIAG_NAIVE & 5) continue; const AttnSrc a{p.Q2b, 768, h * 192, p.Kn, 512, h * 128, p.Krb, 64, p.VtM, R, h * 128, p.mix, D, 1024 + h * 128};
                attn_unit<true>(a, qrow0, NLAT + b * LCTX, 0, nl0, false, 0, 0, false, -INFINITY, cM, lds); }
            else { if (DIAG_NAIVE & 2) continue; const AttnSrc a{p.sqb, 512, h * 128, p.skb, 256, (h >> 1) * 128, nullptr, 0, p.svT, R, (h >> 1) * 128, p.mix, D, h * 128};
                attn_unit<false>(a, qrow0, NLAT + b * LCTX, 0, nl0, false, 0, 0, false, p.swa_sink[l * 4 + h] * LOG2E, cS, lds); }
        }
    }
    __syncthreads();
    {
        constexpr int NBU1 = 16 * NCHK / 4;
        for (int bu = bid; bu < 2 * NBU1; bu += nb) { if (bu < NBU1) scan_s1<0>(p, l, bu, smem); else scan_s1<1>(p, l, bu - NBU1, smem); }
    }
}

__device__ __forceinline__ void ph_post1(const Params& p, int l, int bid, int nb) {
    const int tid = otid(), lane = tid & 63, wid = tid >> 6;
    const int nrows = (l < DEPTH - 1) ? R : NLAT;
    for (int r = bid * NWV + wid; r < nrows; r += nb * NWV) {
        const float* mv = p.modv + ((long)l * 3 + mod_row(r)) * 6 * D;
        Row x, o; row_load(x, p.xc + (long)r * D, lane); row_load(o, p.ob + (long)r * D, lane);
#pragma unroll
        for (int i = 0; i < 8; ++i) {
            const float4 g = ld4(mv + 2 * D + (i * 64 + lane) * 4);
            x.v[i].x = ALPHA * x.v[i].x + g.x * o.v[i].x; x.v[i].y = ALPHA * x.v[i].y + g.y * o.v[i].y;
            x.v[i].z = ALPHA * x.v[i].z + g.z * o.v[i].z; x.v[i].w = ALPHA * x.v[i].w + g.w * o.v[i].w;
        }
        float mean, rstd; row_stats(x, mean, rstd);
        row_affine(x, mean, rstd, p.ln1_g + l * D, p.ln1_b + l * D, lane);
        row_store(x, p.xc + (long)r * D, lane);
        row_stats(x, mean, rstd);
        row_modulate(x, mean, rstd, mv + 3 * D, mv + 4 * D, lane);
        row_store_bf16(x, p.hb + (long)r * D, lane);
        row_store(x, p.ob + (long)r * D, lane);
    }
}

__device__ __forceinline__ void ph_router(const Params& p, int l, int bid, int nb, float* smem) {
    const int tid = otid(), lane = tid & 63, wid = tid >> 6, half = wid >> 2, wq = wid & 3, i = lane & 31, hk = lane >> 5;
    const int nrows = (l < DEPTH - 1) ? R : NLAT;
    const float* wre = p.w_re + (long)l * D * 32;
    const float* wrg = p.w_rg + (long)l * D * 4;
    for (int bu = bid; bu < nrows / 64; bu += nb) {
        const int row0 = bu * 64 + half * 32;
        f32x16 acc0, acc1;
#pragma unroll
        for (int q = 0; q < 16; ++q) { acc0[q] = 0.f; acc1[q] = 0.f; }
        const float* ap = p.ob + (long)(row0 + i) * D + wq * 512 + 4 * hk;
#pragma unroll 2
        for (int g = 0; g < 64; ++g) {
            const float4 a4 = ld4(ap + g * 8);
            const int kb = wq * 512 + g * 8 + 4 * hk;
            float b0[4], b1[4];
#pragma unroll
            for (int j = 0; j < 4; ++j) { b0[j] = wre[(long)(kb + j) * 32 + i]; b1[j] = (i < 4) ? wrg[(long)(kb + j) * 4 + i] : 0.f; }
            acc0 = __builtin_amdgcn_mfma_f32_32x32x2f32(a4.x, b0[0], acc0, 0, 0, 0); acc1 = __builtin_amdgcn_mfma_f32_32x32x2f32(a4.x, b1[0], acc1, 0, 0, 0);
            acc0 = __builtin_amdgcn_mfma_f32_32x32x2f32(a4.y, b0[1], acc0, 0, 0, 0); acc1 = __builtin_amdgcn_mfma_f32_32x32x2f32(a4.y, b1[1], acc1, 0, 0, 0);
            acc0 = __builtin_amdgcn_mfma_f32_32x32x2f32(a4.z, b0[2], acc0, 0, 0, 0); acc1 = __builtin_amdgcn_mfma_f32_32x32x2f32(a4.z, b1[2], acc1, 0, 0, 0);
            acc0 = __builtin_amdgcn_mfma_f32_32x32x2f32(a4.w, b0[3], acc0, 0, 0, 0); acc1 = __builtin_amdgcn_mfma_f32_32x32x2f32(a4.w, b1[3], acc1, 0, 0, 0);
        }
        __syncthreads();
        float* tp = smem + (half * 4 + wq) * (32 * 65);
#pragma unroll
        for (int q = 0; q < 16; ++q) { const int row = (q & 3) + 8 * (q >> 2) + 4 * hk; tp[row * 65 + i] = acc0[q]; tp[row * 65 + 32 + i] = acc1[q]; }
        __syncthreads();
        if (tid < 64) {
            const int hh = tid >> 5, rr = tid & 31, r = bu * 64 + hh * 32 + rr;
            const float* t0 = smem + (hh * 4) * (32 * 65) + rr * 65;
            float lg[4], le[32];
#pragma unroll
            for (int e = 0; e < 32; ++e) le[e] = (t0[e] + t0[32 * 65 + e]) + (t0[2 * 32 * 65 + e] + t0[3 * 32 * 65 + e]);
#pragma unroll
            for (int g = 0; g < 4; ++g) lg[g] = (t0[32 + g] + t0[32 * 65 + 32 + g]) + (t0[2 * 32 * 65 + 32 + g] + t0[3 * 32 * 65 + 32 + g]);
            int grp = 0; float gm = lg[0];
#pragma unroll
            for (int g = 1; g < 4; ++g) if (lg[g] > gm) { gm = lg[g]; grp = g; }
            float zs = 0.f;
#pragma unroll
            for (int g = 0; g < 4; ++g) zs += expf(lg[g] - gm);
            const float pgrp = 1.0f / zs;
            float ev[8];
#pragma unroll
            for (int e = 0; e < 8; ++e) { ev[e] = (grp == 0) ? le[e] : (grp == 1) ? le[8 + e] : (grp == 2) ? le[16 + e] : le[24 + e]; }
            int i0 = 0; float v0 = ev[0];
#pragma unroll
            for (int e = 1; e < 8; ++e) if (ev[e] > v0) { v0 = ev[e]; i0 = e; }
            int i1 = -1; float v1 = -INFINITY;
#pragma unroll
            for (int e = 0; e < 8; ++e) if (e != i0 && ev[e] > v1) { v1 = ev[e]; i1 = e; }
            const float e1 = expf(v1 - v0);
            const float g0 = pgrp / (1.0f + e1), g1 = pgrp * e1 / (1.0f + e1);
            p.eid[r * 2 + 0] = grp * 8 + i0; p.eid[r * 2 + 1] = grp * 8 + i1;
            p.gate[r * 2 + 0] = g0; p.gate[r * 2 + 1] = g1;
        }
    }
}

__device__ __forceinline__ void ph_sort(const Params& p, int l, int bid, int* smem) {
    if (bid != 0) return;
    const int tid = otid(), lane = tid & 63, wid = tid >> 6;
    const int ntok = (l < DEPTH - 1) ? R : NLAT;
    const int nch = ntok / 64;
    int* cnt = smem;
    int* pst = smem + 136 * 32;
    int* tot = pst + 32;
    for (int i = tid; i < NSLOT; i += NTH) p.slot_tok[i] = -1;
    for (int c = wid; c < nch; c += NWV) {
        const int t = c * 64 + lane;
        const int e0 = p.eid[t * 2], e1 = p.eid[t * 2 + 1];
        for (int e = 0; e < 32; ++e) {
            const unsigned long long mk = __ballot(e0 == e || e1 == e);
            if (lane == 0) cnt[c * 32 + e] = __popcll(mk);
        }
    }
    __threadfence_block();
    __syncthreads();
    if (tid < 32) {
        int run = 0;
        for (int c = 0; c < nch; ++c) { const int v = cnt[c * 32 + tid]; cnt[c * 32 + tid] = run; run += v; }
        tot[tid] = run;
    }
    __syncthreads();
    if (tid == 0) {
        int ps = 0;
        for (int e = 0; e < 32; ++e) { pst[e] = ps; ps += (tot[e] + 255) / 256 * 256; }
        p.tile_e[NTILE] = ps / 256;
        int e = 0;
        for (int b = 0; b < NTILE; ++b) {
            const int s = b * 256;
            while (e < 32 && s >= pst[e] + (tot[e] + 255) / 256 * 256) ++e;
            p.tile_e[b] = (e < 32) ? e : -1;
        }
    }
    __syncthreads();
    for (int c = wid; c < nch; c += NWV) {
        const int t = c * 64 + lane;
        const int e0 = p.eid[t * 2], e1 = p.eid[t * 2 + 1];
        for (int e = 0; e < 32; ++e) {
            const unsigned long long mk = __ballot(e0 == e || e1 == e);
            const int rank = __popcll(mk & ((1ull << lane) - 1ull));
            if (e0 == e || e1 == e) {
                const int slot = pst[e] + cnt[c * 32 + e] + rank;
                p.slot_tok[slot] = t;
                p.slot_of[t * 2 + (e1 == e ? 1 : 0)] = slot;
            }
        }
    }
}

__device__ __forceinline__ void ph_gather(const Params& p, int bid, int nb) {
    const int tid = otid(), lane = tid & 63, wid = tid >> 6;
    const int nslots = p.tile_e[NTILE] * 256;
    for (int s0 = bid * NWV + wid; s0 < nslots; s0 += nb * NWV) {
        const int src = p.slot_tok[s0];
        u32x4* d = (u32x4*)(p.xs + (long)s0 * D);
        if (src >= 0) { const u32x4* sp = (const u32x4*)(p.hb + (long)src * D);
#pragma unroll
            for (int i = 0; i < 4; ++i) d[i * 64 + lane] = sp[i * 64 + lane]; }
        else { const u32x4 z = {0u, 0u, 0u, 0u};
#pragma unroll
            for (int i = 0; i < 4; ++i) d[i * 64 + lane] = z; }
    }
}

__device__ __forceinline__ void ph_post2(const Params& p, int l, int bid, int nb) {
    const int tid = otid(), lane = tid & 63, wid = tid >> 6;
    const int nrows = (l < DEPTH - 1) ? R : NLAT;
    for (int r = bid * NWV + wid; r < nrows; r += nb * NWV) {
        const float* mv = p.modv + ((long)l * 3 + mod_row(r)) * 6 * D;
        const int s0 = p.slot_of[r * 2], s1 = p.slot_of[r * 2 + 1];
        const float g0 = p.gate[r * 2], g1 = p.gate[r * 2 + 1];
        Row x, y0, y1; row_load(x, p.xc + (long)r * D, lane); row_load(y0, p.Ys + (long)s0 * D, lane); row_load(y1, p.Ys + (long)s1 * D, lane);
#pragma unroll
        for (int i = 0; i < 8; ++i) {
            const float4 g = ld4(mv + 5 * D + (i * 64 + lane) * 4);
            x.v[i].x = ALPHA * x.v[i].x + g.x * (g0 * y0.v[i].x + g1 * y1.v[i].x); x.v[i].y = ALPHA * x.v[i].y + g.y * (g0 * y0.v[i].y + g1 * y1.v[i].y);
            x.v[i].z = ALPHA * x.v[i].z + g.z * (g0 * y0.v[i].z + g1 * y1.v[i].z); x.v[i].w = ALPHA * x.v[i].w + g.w * (g0 * y0.v[i].w + g1 * y1.v[i].w);
        }
        float mean, rstd; row_stats(x, mean, rstd);
        row_affine(x, mean, rstd, p.ln2_g + l * D, p.ln2_b + l * D, lane);
        if (l == DEPTH - 1) row_store(x, p.out + (long)r * D, lane);
        else row_store(x, p.xc + (long)r * D, lane);
    }
}

constexpr int PH_PER_LAYER = 15, N_PHASES = 1 + DEPTH * PH_PER_LAYER;
constexpr int LDS_MAIN = 128 * 1024, LDS_BYTES = LDS_MAIN + 256;

__global__ void __launch_bounds__(NTH, 2) fwd(Params p) {
    extern __shared__ __attribute__((aligned(16))) unsigned char lds_raw[];
    float* smem = (float*)lds_raw;
    LAS unsigned char* ldsp = (LAS unsigned char*)lds_raw;
    const int bid = blockIdx.x, nb = gridDim.x;
    const int vcu = (nb % 8 == 0) ? (bid % 8) * (nb / 8) + bid / 8 : bid;
#if ONE_LAUNCH
    if (threadIdx.x == 0) *(uint4*)(lds_raw + LDS_MAIN) = make_uint4(0u, 0u, 0u, 0u);
    __syncthreads();
    XcdBarrier bar = xcd_barrier_post(p.bar, (volatile LAS unsigned*)(ldsp + LDS_MAIN));
#define SEAM(k) do { if ((k) + 1 < p.ph_hi) xcd_barrier(bar); } while (0)
#else
#define SEAM(k) do { } while (0)
#endif
#define IN(k) (p.ph_lo <= (k) && (k) < p.ph_hi)
    if (IN(0)) { ph_prologue(p, bid, nb, smem); if (DUPMASK & 1) { __syncthreads(); ph_prologue(p, bid, nb, smem); } SEAM(0); }
    for (int l = 0; l < DEPTH; ++l) {
        const int k0 = 1 + l * PH_PER_LAYER;
        const int mrows = (l < DEPTH - 1) ? R : NLAT;
        if (IN(k0 + 0)) { ph_lnmod(p, l, bid, nb); if (DUPMASK & 16) ph_lnmod(p, l, bid, nb); SEAM(k0 + 0); }
        if (IN(k0 + 1)) {
            pg8::Gemm g{p.hb, p.WinT + (long)l * INP * D, R, INP, D}; pg8::StaticOrder S; S.init(R, INP, nb, bid);
            pg8::EpiF32 E{p.P, INC, INC};
            pg8::gemm_phase(ldsp, g, S, E); if (DUPMASK & 2) pg8::gemm_phase(ldsp, g, S, E);
            if (l == 0) {
                const int rem = ((R / 256) * (INP / 256)) % nb;
                if (rem > 0 && bid >= rem) conv_rest(p, bid - rem, nb - rem, smem);
                else if (rem == 0) conv_rest(p, bid, nb, smem);
            }
            SEAM(k0 + 1);
        }
        if (IN(k0 + 2)) { ph_prep(p, l, bid, nb); if (DUPMASK & 16) ph_prep(p, l, bid, nb); SEAM(k0 + 2); }
        if (IN(k0 + 3)) {
            { pg8::Gemm g{p.cqn, p.WuqT + (long)l * 768 * 384, R, 768, 384}; pg8::StaticOrder S; S.init(R, 768, nb, bid); pg8::EpiBf16 E{p.Q2b, 768}; pg8::gemm_phase(ldsp, g, S, E); if (DUPMASK & 2) pg8::gemm_phase(ldsp, g, S, E); }
            { pg8::Gemm g{p.ckvn, p.WukvT + (long)l * 1024 * 256, R, 512, 256}; pg8::StaticOrder S; S.init(R, 512, nb, bid); pg8::EpiBf16 E{p.Kn, 512}; pg8::gemm_phase(ldsp, g, S, E); if (DUPMASK & 2) pg8::gemm_phase(ldsp, g, S, E); }
            { pg8::Gemm g{p.WukvT + (long)l * 1024 * 256 + 512 * 256, p.ckvn, 512, R, 256}; pg8::StaticOrder S; S.init(512, R, nb, bid); pg8::EpiBf16 E{p.VtM, R}; pg8::gemm_phase(ldsp, g, S, E); if (DUPMASK & 2) pg8::gemm_phase(ldsp, g, S, E); }
            SEAM(k0 + 3);
        }
        if (IN(k0 + 4)) { ph_mixers(p, l, bid, nb, smem, ldsp); if (DUPMASK & 4) { __syncthreads(); ph_mixers(p, l, bid, nb, smem, ldsp); } SEAM(k0 + 4); }
        if (IN(k0 + 5)) { ph_scan2(p, bid, nb); SEAM(k0 + 5); }
        if (IN(k0 + 6)) { ph_scan3(p, l, bid, nb, smem); if (DUPMASK & 8) { __syncthreads(); ph_scan3(p, l, bid, nb, smem); } SEAM(k0 + 6); }
        if (IN(k0 + 7)) {
            pg8::Gemm g{p.mix, p.WoutT + (long)l * D * D, mrows, D, D}; pg8::StaticOrder S; S.init(mrows, D, nb, bid);
            pg8::EpiF32 E{p.ob, D, D};
            pg8::gemm_phase(ldsp, g, S, E); if (DUPMASK & 2) pg8::gemm_phase(ldsp, g, S, E); SEAM(k0 + 7);
        }
        if (IN(k0 + 8)) { ph_post1(p, l, bid, nb); SEAM(k0 + 8); }
        if (IN(k0 + 9)) { ph_router(p, l, bid, nb, smem); SEAM(k0 + 9); }
        if (IN(k0 + 10)) { ph_sort(p, l, bid, (int*)smem); if (bid > 0) conv_moe(p, l, bid - 1, nb - 1, smem); SEAM(k0 + 10); }
        if (IN(k0 + 11)) { ph_gather(p, bid, nb); if (DUPMASK & 16) ph_gather(p, bid, nb); SEAM(k0 + 11); }
        if (IN(k0 + 12)) {
            pg8::Gemm g{p.xs, p.W13T + (long)l * NEXP * 1024 * D, NSLOT, 1024, D};
            pg8::MoeOrder S{4, p.tile_e[NTILE] * 4, nb, vcu, (size_t)1024 * D * 2, p.tile_e};
            pg8::EpiSwiglu E{p.act, FF};
            pg8::gemm_phase(ldsp, g, S, E); if (DUPMASK & 2) pg8::gemm_phase(ldsp, g, S, E); SEAM(k0 + 12);
        }
        if (IN(k0 + 13)) {
            pg8::Gemm g{p.act, p.W2T + (long)l * NEXP * D * FF, NSLOT, D, FF};
            pg8::MoeOrder S{8, p.tile_e[NTILE] * 8, nb, vcu, (size_t)D * FF * 2, p.tile_e};
            pg8::EpiF32 E{p.Ys, D, D};
            pg8::gemm_phase(ldsp, g, S, E); if (DUPMASK & 2) pg8::gemm_phase(ldsp, g, S, E); SEAM(k0 + 13);
        }
        if (IN(k0 + 14)) { ph_post2(p, l, bid, nb); SEAM(k0 + 14); }
    }
}

static inline size_t al256(size_t v) { return (v + 255) & ~(size_t)255; }

extern "C" void kernel_launch(void* const* d_in, const int* in_sizes, int n_in, void* d_out, int out_size, void* d_ws, size_t ws_size, hipStream_t stream) {
    static int grid = 0;
    if (grid == 0) {
        int dev = 0, cus = 0, per_cu = 0;
        hipGetDevice(&dev);
        hipDeviceGetAttribute(&cus, hipDeviceAttributeMultiprocessorCount, dev);
        hipFuncSetAttribute((const void*)fwd, hipFuncAttributeMaxDynamicSharedMemorySize, LDS_BYTES);
        hipOccupancyMaxActiveBlocksPerMultiprocessor(&per_cu, (const void*)fwd, NTH, LDS_BYTES);
        (void)hipGetLastError();
        if (cus <= 0) cus = 256;
        grid = cus;
        if (per_cu < 1) fprintf(stderr, "kernel_launch: occupancy query reports %d\n", per_cu);
    }
    Params p{};
    const float* const* in = (const float* const*)d_in;
    p.x = in[0]; p.c = in[1]; p.ctx = in[2]; p.c_ctx = in[3]; p.w_ada = in[4]; p.b_ada = in[5]; p.w_in = in[6]; p.swa_sink = in[7];
    p.ret_s = in[8]; p.ret_gn = in[9]; p.q_norm = in[10]; p.kv_norm = in[11]; p.w_uq = in[12]; p.w_ukv = in[13]; p.lb_logits = in[14];
    p.hgrn_gn = in[15]; p.w_out = in[16]; p.ln1_g = in[17]; p.ln1_b = in[18]; p.w_rg = in[19]; p.w_re = in[20]; p.w1 = in[21]; p.w3 = in[22];
    p.w2 = in[23]; p.ln2_g = in[24]; p.ln2_b = in[25];
    p.out = (float*)d_out;
    unsigned char* ws = (unsigned char*)d_ws; size_t off = 0;
    auto carve = [&](size_t bytes) { unsigned char* q = ws + off; off = al256(off + bytes); return q; };
    p.bar = (unsigned*)carve(XCD_BAR_WORDS * 4);
    p.modv = (float*)carve((size_t)DEPTH * 3 * 6 * D * 4);
    p.xc = (float*)carve((size_t)R * D * 4);
    p.hb = (bf16_t*)carve((size_t)R * D * 2);
    p.P = (float*)carve((size_t)R * INC * 4);
    p.Ys = p.P;
    p.cqn = (bf16_t*)carve((size_t)R * 384 * 2);
    p.ckvn = (bf16_t*)carve((size_t)R * 256 * 2);
    p.Q2b = (bf16_t*)carve((size_t)R * 768 * 2);
    p.Kn = (bf16_t*)carve((size_t)R * 512 * 2);
    p.VtM = (bf16_t*)carve((size_t)512 * R * 2);
    p.Krb = (bf16_t*)carve((size_t)R * 64 * 2);
    p.sqb = (bf16_t*)carve((size_t)R * 512 * 2);
    p.skb = (bf16_t*)carve((size_t)R * 256 * 2);
    p.svT = (bf16_t*)carve((size_t)256 * R * 2);
    p.sst = (float*)carve((size_t)32 * NCHK * 16384 * 4);
    p.sA = (float*)carve((size_t)32 * NCHK * 128 * 4);
    p.mix = (bf16_t*)carve((size_t)R * D * 2);
    p.ob = p.sst;
    p.xs = (bf16_t*)carve((size_t)NSLOT * D * 2);
    p.act = (bf16_t*)carve((size_t)NSLOT * FF * 2);
    p.gate = (float*)carve((size_t)R * 2 * 4);
    p.eid = (int*)carve((size_t)R * 2 * 4);
    p.slot_of = (int*)carve((size_t)R * 2 * 4);
    p.slot_tok = (int*)carve((size_t)NSLOT * 4);
    p.tile_e = (int*)carve((size_t)(NTILE + 1) * 4);
    p.WinT = (bf16_t*)carve((size_t)DEPTH * INP * D * 2);
    p.WoutT = (bf16_t*)carve((size_t)DEPTH * D * D * 2);
    p.WuqT = (bf16_t*)carve((size_t)DEPTH * 768 * 384 * 2);
    p.WukvT = (bf16_t*)carve((size_t)DEPTH * 1024 * 256 * 2);
    p.W13T = (bf16_t*)carve((size_t)DEPTH * NEXP * 1024 * D * 2);
    p.W2T = (bf16_t*)carve((size_t)DEPTH * NEXP * D * FF * 2);
    if (off > ws_size) { fprintf(stderr, "kernel_launch: workspace too small: need %zu have %zu\n", off, ws_size); return; }
    hipMemsetAsync(p.bar, 0, XCD_BAR_WORDS * 4, stream);
#if ONE_LAUNCH
    p.ph_lo = 0; p.ph_hi = N_PHASES;
    hipLaunchKernelGGL(fwd, dim3(grid), dim3(NTH), LDS_BYTES, stream, p);
#else
    for (int k = 0; k < N_PHASES; ++k) {
        p.ph_lo = k; p.ph_hi = k + 1;
        hipLaunchKernelGGL(fwd, dim3(grid), dim3(NTH), LDS_BYTES, stream, p);
    }
#endif
}
```

```cpp
#include <hip/hip_runtime.h>
#include <cstdio>
#include <cstdint>

#ifndef DIAG_NAIVE
#define DIAG_NAIVE 0
#endif
#ifndef DUPMASK
#define DUPMASK 0
#endif
#ifndef ONE_LAUNCH
#define ONE_LAUNCH 1
#endif

constexpr int D = 2048, NBATCH = 2, T = 4096, LCTX = 256, DEPTH = 2;
constexpr int NLAT = NBATCH * T, NCTX = NBATCH * LCTX, R = NLAT + NCTX;
constexpr int INC = 6208;
constexpr int SQ = 0, SK = 512, SV = 768, RQ = 1024, RK = 1536, RV = 2048, RG = 2560, CQ = 3072, CKV = 3456, KR = 3584,
              HQ = 3648, HFF = 4160, HFB = 4672, HI = 5184, HG = 5696;
constexpr int NEXP = 32, FF = 512;
constexpr int NSLOT = 25600, NTILE = NSLOT / 256;
constexpr int INP = 6400;
constexpr float EPS = 1e-6f;
constexpr float ALPHA = 1.41421356237309515f;
constexpr int NTH = 512, NWV = 8;

typedef float f32x16 __attribute__((ext_vector_type(16)));
typedef unsigned short bf16_t;
typedef short bf16x8 __attribute__((ext_vector_type(8)));
typedef float f32x4 __attribute__((ext_vector_type(4)));
typedef unsigned u32x4 __attribute__((ext_vector_type(4)));
typedef unsigned u32x2 __attribute__((ext_vector_type(2)));

#define XB_TMO      128
#define XB_XCNT(j)  (256  + 64 * (j))
#define XB_XSUB(j)  (1280 + 64 * (j))
#define XB_XGEN(j)  (2304 + 64 * (j))
#define XB_TOP      3328
#define XB_TOPGEN   3392
#define XCD_BAR_WORDS 3456
#define XB_SPIN_CAP (1u << 18)
#define LAS __attribute__((address_space(3)))

__device__ __forceinline__ unsigned xb_ld(unsigned* p)              { return __hip_atomic_load(p, __ATOMIC_RELAXED, __HIP_MEMORY_SCOPE_AGENT); }
__device__ __forceinline__ unsigned xb_add(unsigned* p, unsigned v) { return __hip_atomic_fetch_add(p, v, __ATOMIC_RELAXED, __HIP_MEMORY_SCOPE_AGENT); }
__device__ __forceinline__ unsigned xb_xcc_id() { return (unsigned)__builtin_amdgcn_s_getreg((3 << 11) | 20) & 0xFu; }
#define XB_SPIN(cond, bar) do { unsigned _sp = 0; while (cond) { __builtin_amdgcn_s_sleep(1); \
    if ((++_sp & 255u) == 0u) { if (xb_ld(&(bar)[XB_TMO])) break; if (_sp > XB_SPIN_CAP) { atomicAdd(&(bar)[XB_TMO], 1u); break; } } } } while (0)

struct XcdBarrier { unsigned* bar; unsigned x; volatile LAS unsigned* st; };

__device__ __forceinline__ XcdBarrier xcd_barrier_post(unsigned* bar, volatile LAS unsigned* st) {
    XcdBarrier b; b.bar = bar; b.x = xb_xcc_id(); b.st = st;
    if (threadIdx.x == 0) (void)xb_add(&bar[XB_XCNT(b.x)], 1u);
    return b;
}
__device__ __forceinline__ void xcd_barrier_complete(unsigned* bar, unsigned x, unsigned& nloc, unsigned& nx) {
    const unsigned G = gridDim.x * gridDim.y * gridDim.z;
    unsigned sum, cnt, mine, sp = 0u;
    for (;;) {
        sum = 0u; cnt = 0u; mine = 0u;
#pragma unroll
        for (unsigned j = 0; j < 16; ++j) { const unsigned c = xb_ld(&bar[XB_XCNT(j)]); sum += c; cnt += (c > 0u) ? 1u : 0u; mine = (j == x) ? c : mine; }
        if (sum == G) break;
        __builtin_amdgcn_s_sleep(1);
        if ((++sp & 255u) == 0u) { if (xb_ld(&bar[XB_TMO])) break; if (sp > XB_SPIN_CAP) { atomicAdd(&bar[XB_TMO], 1u); break; } }
    }
    nloc = mine > 0u ? mine : 1u; nx = cnt > 0u ? cnt : 1u;
}
__device__ __forceinline__ void xcd_barrier(const XcdBarrier& b) {
    asm volatile("s_waitcnt vmcnt(0)" ::: "memory");
    __syncthreads();
    if (threadIdx.x == 0) {
        unsigned* bar = b.bar;
        __builtin_amdgcn_s_waitcnt(0);
        unsigned nloc = b.st[0], nx = b.st[1];
        if (nloc == 0u) { xcd_barrier_complete(bar, b.x, nloc, nx); b.st[0] = nloc; b.st[1] = nx; }
        const unsigned old = xb_add(&bar[XB_XSUB(b.x)], 1u);
        const unsigned gen = old / nloc;
        if (old + 1u == (gen + 1u) * nloc) {
            __builtin_amdgcn_fence(__ATOMIC_RELEASE, "agent");
            asm volatile("s_waitcnt vmcnt(0)" ::: "memory");
            const unsigned og = xb_add(&bar[XB_TOP], 1u);
            const unsigned tg = og / nx;
            if (og + 1u == (tg + 1u) * nx) xb_add(&bar[XB_TOPGEN], 1u);
            else XB_SPIN(xb_ld(&bar[XB_TOPGEN]) == tg, bar);
            __builtin_amdgcn_fence(__ATOMIC_ACQUIRE, "agent");
            xb_add(&bar[XB_XGEN(b.x)], 1u);
            asm volatile("s_waitcnt vmcnt(0)" ::: "memory");
        } else {
            XB_SPIN(xb_ld(&bar[XB_XGEN(b.x)]) == gen, bar);
            __builtin_amdgcn_fence(__ATOMIC_ACQUIRE, "agent");
            asm volatile("s_waitcnt vmcnt(0)" ::: "memory");
        }
    }
    __syncthreads();
}

struct Params {
    const float *x, *c, *ctx, *c_ctx, *w_ada, *b_ada, *w_in, *swa_sink, *ret_s, *ret_gn, *q_norm, *kv_norm, *w_uq, *w_ukv,
                *lb_logits, *hgrn_gn, *w_out, *ln1_g, *ln1_b, *w_rg, *w_re, *w1, *w3, *w2, *ln2_g, *ln2_b;
    float* out;
    unsigned* bar;
    float *modv, *xc, *P, *sst, *sA, *ob, *Ys, *gate;
    bf16_t *hb, *cqn, *ckvn, *mix, *xs, *act, *Q2b, *Kn, *VtM, *Krb, *sqb, *skb, *svT;
    bf16_t *WinT, *WoutT, *WuqT, *WukvT, *W13T, *W2T;
    int *eid, *slot_of, *slot_tok, *tile_e;
    int ph_lo, ph_hi;
};

__device__ __forceinline__ int otid() { int t = threadIdx.x; asm volatile("" : "+v"(t)); return t; }
__device__ __forceinline__ float wsum(float v) {
#pragma unroll
    for (int o = 32; o > 0; o >>= 1) v += __shfl_xor(v, o);
    return v;
}
__device__ __forceinline__ float siluf(float v) { return v / (1.0f + expf(-v)); }
__device__ __forceinline__ float sigmf(float v) { return 1.0f / (1.0f + expf(-v)); }
__device__ __forceinline__ int mod_row(int r) { return r < NLAT ? (r >= T ? 1 : 0) : 2; }
__device__ __forceinline__ float4 ld4(const float* p) { return *(const float4*)p; }
__device__ __forceinline__ bf16_t f2bf(float f) { unsigned u = __float_as_uint(f); u += 0x7FFFu + ((u >> 16) & 1u); return (bf16_t)(u >> 16); }
__device__ __forceinline__ unsigned cvt_pk_bf16(float lo, float hi) { unsigned r; asm volatile("v_cvt_pk_bf16_f32 %0, %1, %2" : "=v"(r) : "v"(lo), "v"(hi)); return r; }
__device__ __forceinline__ void st4(float* p, float4 v) { *(float4*)p = v; }

namespace pg8 {
constexpr int BM = 256, BK = 64, HALF = 128, HTB = HALF * BK * 2, STAGE_BYTES = 8 * HTB, NXCD = 8, WGM = 8;
__host__ __device__ __forceinline__ int lds_byte(int r, int c) { const int st = (r >> 4) * 2 + (c >> 5), rr = r & 15, cc = c & 31, ob = rr * 64 + cc * 2; return st * 1024 + (ob ^ (((ob >> 9) & 1) << 5)); }
__host__ __device__ __forceinline__ void stage_rc(int b, int& R, int& C) { const int st = b / 1024, sb = b % 1024, swz = sb ^ (((sb >> 9) & 1) << 5); R = (st >> 1) * 16 + swz / 64; C = (st & 1) * 32 + (swz % 64) / 2; }
struct Unit { int pm, pn; };
struct Gemm { const bf16_t* A; const bf16_t* Bt; int M, N, K; };
struct StaticOrder {
    int nM, nN, nwg, G, c;
    __device__ void init(int M, int N, int G_, int c_) { nM = M / BM; nN = N / BM; nwg = nM * nN; G = G_; c = c_; }
    __device__ bool next(int i, Unit& u) const {
        const long L = (long)i * G + c; if (L >= nwg) return false;
        int wgid = (int)L; { const int q = nwg / NXCD, r = nwg % NXCD, xcd = wgid % NXCD, off = wgid / NXCD; wgid = (xcd < r ? xcd * (q + 1) : r * (q + 1) + (xcd - r) * q) + off; }
        const int nig = WGM * nN, gid = wgid / nig, fm = gid * WGM, gsz = (nM - fm) < WGM ? (nM - fm) : WGM;
        u.pm = fm + ((wgid % nig) % gsz); u.pn = (wgid % nig) / gsz; return true;
    }
    __device__ __forceinline__ size_t boff(const Unit& u, size_t tstep) const { return (size_t)u.pn * tstep; }
};
struct MoeOrder {
    int npn, nunits, G, c; size_t estride; const int* tile_e;
    __device__ bool next(int i, Unit& u) const { const long L = (long)i * G + c; if (L >= nunits) return false; u.pm = (int)(L / npn); u.pn = (int)(L % npn); return true; }
    __device__ __forceinline__ size_t boff(const Unit& u, size_t tstep) const { return (size_t)tile_e[u.pm] * estride + (size_t)u.pn * tstep; }
};
struct EpiF32 {
    float* C; int ldc; int ncols;
    __device__ __forceinline__ void operator()(const f32x4 (&acc)[2][2][4][2], const Unit& u, int wr, int wc, int fr, int fq) const {
        const int row0 = u.pm * BM + wr * 64 + fr, col0 = u.pn * BM + wc * 32 + 4 * fq;
#pragma unroll
        for (int ai = 0; ai < 2; ++ai)
#pragma unroll
            for (int m = 0; m < 4; ++m) { float* rowp = C + (size_t)(row0 + ai * HALF + m * 16) * ldc + col0;
#pragma unroll
                for (int bj = 0; bj < 2; ++bj)
#pragma unroll
                    for (int n = 0; n < 2; ++n) if (col0 + bj * HALF + n * 16 < ncols) *(f32x4*)(rowp + bj * HALF + n * 16) = acc[ai][bj][m][n]; }
    }
};
struct EpiBf16 {
    bf16_t* O; int ldc;
    __device__ __forceinline__ void operator()(const f32x4 (&acc)[2][2][4][2], const Unit& u, int wr, int wc, int fr, int fq) const {
        const int row0 = u.pm * BM + wr * 64 + fr, col0 = u.pn * BM + wc * 32 + 4 * fq;
#pragma unroll
        for (int ai = 0; ai < 2; ++ai)
#pragma unroll
            for (int m = 0; m < 4; ++m) { bf16_t* rowp = O + (size_t)(row0 + ai * HALF + m * 16) * ldc + col0;
#pragma unroll
                for (int bj = 0; bj < 2; ++bj)
#pragma unroll
                    for (int n = 0; n < 2; ++n) { const f32x4 v = acc[ai][bj][m][n]; u32x2 w; w.x = cvt_pk_bf16(v[0], v[1]); w.y = cvt_pk_bf16(v[2], v[3]); *(u32x2*)(rowp + bj * HALF + n * 16) = w; } }
    }
};
struct EpiSwiglu {
    bf16_t* O; int ldc;
    __device__ __forceinline__ void operator()(const f32x4 (&acc)[2][2][4][2], const Unit& u, int wr, int wc, int fr, int fq) const {
        const int row0 = u.pm * BM + wr * 64 + fr, col0 = u.pn * HALF + wc * 32 + 4 * fq;
#pragma unroll
        for (int ai = 0; ai < 2; ++ai)
#pragma unroll
            for (int m = 0; m < 4; ++m) { bf16_t* rowp = O + (size_t)(row0 + ai * HALF + m * 16) * ldc + col0;
#pragma unroll
                for (int n = 0; n < 2; ++n) { const f32x4 g = acc[ai][0][m][n], v = acc[ai][1][m][n]; float r[4];
#pragma unroll
                    for (int j = 0; j < 4; ++j) r[j] = g[j] / (1.0f + __expf(-g[j])) * v[j];
                    u32x2 w; w.x = cvt_pk_bf16(r[0], r[1]); w.y = cvt_pk_bf16(r[2], r[3]); *(u32x2*)(rowp + n * 16) = w; } }
    }
};
template <class Epi, class Sched>
__device__ __forceinline__ void gemm_phase(LAS unsigned char* lds, const Gemm g, const Sched& S, const Epi& E) {
    const int tid = otid(), wid = __builtin_amdgcn_readfirstlane(tid >> 6), lane = tid & 63, wr = wid >> 2, wc = wid & 3, fr = lane & 15, fq = lane >> 4;
    const int K = g.K, nt = K / BK;
    unsigned voffA[2], voffB[2];
#pragma unroll
    for (int i = 0; i < 2; ++i) { int R_, C_; stage_rc(tid * 16 + i * 8192, R_, C_); voffA[i] = (unsigned)(R_ * K + C_) * 2u; voffB[i] = voffA[i]; }
    const size_t kstep = (size_t)(BK * 2);
    const size_t hstep = (size_t)HALF * K * 2;
    const size_t tstep = 2 * hstep;
    const unsigned ldsw = (unsigned)wid * 1024u;
    const int aoff = lds_byte(wr * 64 + fr, fq * 8), boff = lds_byte(wc * 32 + fr, fq * 8);
#define PG8_SA(b, h) (((b) * 2 + (h)) * HTB)
#define PG8_SB(b, h) ((4 + (b) * 2 + (h)) * HTB)
#define PG8_STAGE(bufoff, gbase, voff) do { _Pragma("unroll") for (int _i = 0; _i < 2; ++_i) \
        __builtin_amdgcn_global_load_lds((const unsigned*)((const char*)(gbase) + (voff)[_i]), (LAS unsigned*)(lds + (bufoff) + ldsw + _i * 8192), 16, 0, 0); } while (0)
#define PG8_LDA(dst, b, h) do { _Pragma("unroll") for (int m = 0; m < 4; ++m) _Pragma("unroll") for (int k = 0; k < 2; ++k) dst[m][k] = *(const LAS bf16x8*)(lds + PG8_SA(b, h) + aoff + m * 2048 + k * 1024); } while (0)
#define PG8_LDB(dst, b, h) do { _Pragma("unroll") for (int n = 0; n < 2; ++n) _Pragma("unroll") for (int k = 0; k < 2; ++k) dst[n][k] = *(const LAS bf16x8*)(lds + PG8_SB(b, h) + boff + n * 2048 + k * 1024); } while (0)
#define PG8_MMA(ai, bj, At, Bt) do { __builtin_amdgcn_s_setprio(1); _Pragma("unroll") for (int m = 0; m < 4; ++m) _Pragma("unroll") for (int n = 0; n < 2; ++n) _Pragma("unroll") for (int k = 0; k < 2; ++k) \
        acc[ai][bj][m][n] = __builtin_amdgcn_mfma_f32_16x16x32_bf16(Bt[n][k], At[m][k], acc[ai][bj][m][n], 0, 0, 0); __builtin_amdgcn_s_setprio(0); } while (0)
#define PG8_WAIT_V(n) asm volatile("s_waitcnt vmcnt(" #n ")" ::: "memory")
#define PG8_WAIT_L(n) asm volatile("s_waitcnt lgkmcnt(" #n ")" ::: "memory")
#define PG8_BAR __builtin_amdgcn_s_barrier()
#define PG8_SCHED __builtin_amdgcn_sched_barrier(0)
    Unit cur, nxt; int ui = 0;
    if (!S.next(0, cur)) return;
    f32x4 acc[2][2][4][2];
#pragma unroll
    for (int a = 0; a < 2; ++a)
#pragma unroll
        for (int b = 0; b < 2; ++b)
#pragma unroll
            for (int m = 0; m < 4; ++m)
#pragma unroll
                for (int n = 0; n < 2; ++n) acc[a][b][m][n] = (f32x4){0.f, 0.f, 0.f, 0.f};
    bf16x8 At[4][2], B0[2][2], B1[2][2];
    const char* cA = (const char*)g.A + (size_t)cur.pm * tstep; const char* cB = (const char*)g.Bt + S.boff(cur, tstep);
    PG8_STAGE(PG8_SB(0, 0), cB, voffB); PG8_STAGE(PG8_SA(0, 0), cA, voffA); PG8_STAGE(PG8_SB(0, 1), cB + hstep, voffB); PG8_STAGE(PG8_SA(0, 1), cA + hstep, voffA);
    if (wr == 1) PG8_BAR;
    PG8_WAIT_V(4); PG8_BAR;
    PG8_STAGE(PG8_SB(1, 0), cB + kstep, voffB); PG8_STAGE(PG8_SA(1, 0), cA + kstep, voffA); PG8_STAGE(PG8_SB(1, 1), cB + hstep + kstep, voffB);
    PG8_WAIT_V(6); PG8_BAR;
    for (;;) {
        const bool has_next = S.next(ui + 1, nxt);
        const char* nA = has_next ? (const char*)g.A + (size_t)nxt.pm * tstep : cA; const char* nB = has_next ? (const char*)g.Bt + S.boff(nxt, tstep) : cB;
        for (int t = 0; t < nt; t += 2) {
            const bool last = (t == nt - 2);
            const char* a1 = cA + (size_t)(t + 1) * kstep;
            const char* a2 = last ? nA : cA + (size_t)(t + 2) * kstep; const char* b2 = last ? nB : cB + (size_t)(t + 2) * kstep;
            const char* a3 = a2 + kstep; const char* b3 = b2 + kstep;
            PG8_LDB(B0, 0, 0); PG8_SCHED; PG8_LDA(At, 0, 0); PG8_STAGE(PG8_SA(1, 1), a1 + hstep, voffA);
            PG8_WAIT_L(8); PG8_BAR; PG8_WAIT_L(0); PG8_MMA(0, 0, At, B0); PG8_BAR; PG8_SCHED;
            PG8_LDB(B1, 0, 1); PG8_STAGE(PG8_SB(0, 0), b2, voffB);
            PG8_BAR; PG8_WAIT_L(0); PG8_MMA(0, 1, At, B1); PG8_BAR;
            PG8_LDA(At, 0, 1); PG8_STAGE(PG8_SA(0, 0), a2, voffA);
            PG8_BAR; PG8_WAIT_L(0); PG8_MMA(1, 0, At, B0); PG8_BAR; PG8_SCHED;
            PG8_STAGE(PG8_SB(0, 1), b2 + hstep, voffB);
            PG8_WAIT_V(6); PG8_BAR; PG8_MMA(1, 1, At, B1); PG8_BAR;
            PG8_LDB(B0, 1, 0); PG8_SCHED; PG8_LDA(At, 1, 0); PG8_STAGE(PG8_SA(0, 1), a2 + hstep, voffA);
            PG8_WAIT_L(8); PG8_BAR; PG8_WAIT_L(0); PG8_MMA(0, 0, At, B0); PG8_BAR; PG8_SCHED;
            PG8_LDB(B1, 1, 1); PG8_STAGE(PG8_SB(1, 0), b3, voffB);
            PG8_BAR; PG8_WAIT_L(0); PG8_MMA(0, 1, At, B1); PG8_BAR;
            PG8_LDA(At, 1, 1); PG8_STAGE(PG8_SA(1, 0), a3, voffA);
            PG8_BAR; PG8_WAIT_L(0); PG8_MMA(1, 0, At, B0); PG8_BAR; PG8_SCHED;
            PG8_STAGE(PG8_SB(1, 1), b3 + hstep, voffB);
            PG8_WAIT_V(6); PG8_BAR; PG8_MMA(1, 1, At, B1); PG8_BAR;
        }
        E(acc, cur, wr, wc, fr, fq);
        if (!has_next) break;
#pragma unroll
        for (int a = 0; a < 2; ++a)
#pragma unroll
            for (int b = 0; b < 2; ++b)
#pragma unroll
                for (int m = 0; m < 4; ++m)
#pragma unroll
                    for (int n = 0; n < 2; ++n) acc[a][b][m][n] = (f32x4){0.f, 0.f, 0.f, 0.f};
        cur = nxt; cA = nA; cB = nB; ++ui;
    }
    PG8_WAIT_V(0);
    if (wr == 0) PG8_BAR;
    PG8_BAR;
#undef PG8_SA
#undef PG8_SB
#undef PG8_STAGE
#undef PG8_LDA
#undef PG8_LDB
#undef PG8_MMA
#undef PG8_WAIT_V
#undef PG8_WAIT_L
#undef PG8_BAR
#undef PG8_SCHED
}
}

struct ConvDesc { const float* src; bf16_t* dst; int K, N, ldk, nblk, nmul, noff, nmat; long sstride, dstride; };
__device__ __forceinline__ void conv_wT(const ConvDesc& d, int bid, int nb, float* smem) {
    const int tid = otid();
    const int tk = d.K / 64, tn = d.N / 64, per = tk * tn;
    for (int u = bid; u < d.nmat * per; u += nb) {
        const int mat = u / per, t = u % per, kt = t / tn, ntl = t % tn;
        const float* s = d.src + (long)mat * d.sstride + (long)(kt * 64) * d.N + ntl * 64;
        __syncthreads();
#pragma unroll
        for (int ps = 0; ps < 2; ++ps) {
            const int kk = (tid >> 4) + ps * 32, n4 = (tid & 15) * 4;
            const float4 v = ld4(s + (long)kk * d.N + n4);
            smem[kk * 65 + n4 + 0] = v.x; smem[kk * 65 + n4 + 1] = v.y; smem[kk * 65 + n4 + 2] = v.z; smem[kk * 65 + n4 + 3] = v.w;
        }
        __syncthreads();
        const int n = tid >> 3, k8 = (tid & 7) * 8;
        u32x4 w;
        w.x = cvt_pk_bf16(smem[(k8 + 0) * 65 + n], smem[(k8 + 1) * 65 + n]); w.y = cvt_pk_bf16(smem[(k8 + 2) * 65 + n], smem[(k8 + 3) * 65 + n]);
        w.z = cvt_pk_bf16(smem[(k8 + 4) * 65 + n], smem[(k8 + 5) * 65 + n]); w.w = cvt_pk_bf16(smem[(k8 + 6) * 65 + n], smem[(k8 + 7) * 65 + n]);
        const int gn = ntl * 64 + n;
        const int drow = (d.nblk < 0) ? (((gn >> 7) & 1) * 512 + (gn >> 8) * 128 + (gn & 127)) : ((gn / d.nblk) * d.nmul + d.noff + gn % d.nblk);
        *(u32x4*)(d.dst + (long)mat * d.dstride + (long)drow * d.ldk + kt * 64 + k8) = w;
    }
}

__device__ __forceinline__ void conv_first(const Params& p, int bid, int nb, float* smem) {
    const ConvDesc c_in{p.w_in, p.WinT, D, INC, D, 1 << 30, 0, 0, 1, (long)D * INC, (long)INP * D};
    conv_wT(c_in, bid, nb, smem);
    const ConvDesc c_uq{p.w_uq, p.WuqT, 384, 768, 384, 1 << 30, 0, 0, 1, 384L * 768, 768L * 384};
    conv_wT(c_uq, bid, nb, smem);
    const ConvDesc c_ukv{p.w_ukv, p.WukvT, 128, 1024, 256, -1, 0, 0, 1, 128L * 1024, 1024L * 256};
    conv_wT(c_ukv, bid, nb, smem);
}
__device__ __forceinline__ void conv_rest(const Params& p, int bid, int nb, float* smem) {
    const ConvDesc c_out{p.w_out, p.WoutT, D, D, D, 1 << 30, 0, 0, DEPTH, (long)D * D, (long)D * D};
    conv_wT(c_out, bid, nb, smem);
    const ConvDesc c_in{p.w_in + (long)D * INC, p.WinT + (long)INP * D, D, INC, D, 1 << 30, 0, 0, DEPTH - 1, (long)D * INC, (long)INP * D};
    conv_wT(c_in, bid, nb, smem);
    const ConvDesc c_uq{p.w_uq + 384L * 768, p.WuqT + 768L * 384, 384, 768, 384, 1 << 30, 0, 0, DEPTH - 1, 384L * 768, 768L * 384};
    conv_wT(c_uq, bid, nb, smem);
    const ConvDesc c_ukv{p.w_ukv + 128L * 1024, p.WukvT + 1024L * 256, 128, 1024, 256, -1, 0, 0, DEPTH - 1, 128L * 1024, 1024L * 256};
    conv_wT(c_ukv, bid, nb, smem);
}
__device__ __forceinline__ void conv_moe(const Params& p, int l, int bid, int nb, float* smem) {
    const ConvDesc c_w1{p.w1 + (long)l * NEXP * D * FF, p.W13T + (long)l * NEXP * 1024 * D, D, FF, D, 128, 256, 0, NEXP, (long)D * FF, 1024L * D};
    conv_wT(c_w1, bid, nb, smem);
    const ConvDesc c_w3{p.w3 + (long)l * NEXP * D * FF, p.W13T + (long)l * NEXP * 1024 * D, D, FF, D, 128, 256, 128, NEXP, (long)D * FF, 1024L * D};
    conv_wT(c_w3, bid, nb, smem);
    const ConvDesc c_w2{p.w2 + (long)l * NEXP * FF * D, p.W2T + (long)l * NEXP * D * FF, FF, D, FF, 1 << 30, 0, 0, NEXP, (long)FF * D, (long)D * FF};
    conv_wT(c_w2, bid, nb, smem);
}
__device__ __forceinline__ void ph_prologue(const Params& p, int bid, int nb, float* smem) {
    const int tid = otid();
    {
        const long n4 = (long)R * D / 4, nl4 = (long)NLAT * D / 4;
        for (long i = (long)bid * NTH + tid; i < n4; i += (long)nb * NTH) {
            float4 v = (i < nl4) ? ld4(p.x + i * 4) : ld4(p.ctx + (i - nl4) * 4);
            st4(p.xc + i * 4, v);
        }
    }
    for (int u = bid; u < DEPTH * 96; u += nb) {
        const int l = u / 96, jb = u % 96;
        __syncthreads();
        for (int i = tid; i < 3 * D; i += NTH) {
            const int r = i / D, k = i % D;
            const float cv = (r < 2) ? p.c[r * D + k] : p.c_ctx[k];
            smem[i] = siluf(cv);
        }
        __syncthreads();
        const int cc = tid & 127, ks = tid >> 7;
        const float* w = p.w_ada + (long)l * D * (6 * D) + (long)(ks * 512) * (6 * D) + jb * 128 + cc;
        const float* sc = smem + ks * 512;
        float a0 = 0.f, a1 = 0.f, a2 = 0.f;
#pragma unroll 8
        for (int k = 0; k < 512; ++k) {
            const float wv = w[(long)k * (6 * D)];
            a0 = fmaf(sc[k], wv, a0); a1 = fmaf(sc[D + k], wv, a1); a2 = fmaf(sc[2 * D + k], wv, a2);
        }
        float* red = smem + 3 * D;
        red[(ks * 3 + 0) * 128 + cc] = a0; red[(ks * 3 + 1) * 128 + cc] = a1; red[(ks * 3 + 2) * 128 + cc] = a2;
        __syncthreads();
        if (tid < 384) {
            const int r = tid >> 7;
            const float v = (red[(0 * 3 + r) * 128 + cc] + red[(1 * 3 + r) * 128 + cc]) + (red[(2 * 3 + r) * 128 + cc] + red[(3 * 3 + r) * 128 + cc]);
            p.modv[((long)l * 3 + r) * 6 * D + jb * 128 + cc] = v + p.b_ada[l * 6 * D + jb * 128 + cc];
        }
    }
    __syncthreads();
    conv_first(p, bid, nb, smem);
    {
        const u32x4 z = {0u, 0u, 0u, 0u};
        for (long i = (long)bid * NTH + tid; i < (long)DEPTH * (INP - INC) * D / 8; i += (long)nb * NTH) {
            const long per = (long)(INP - INC) * D / 8; const int l = (int)(i / per); const long o = i % per;
            *(u32x4*)(p.WinT + (long)l * INP * D + (long)INC * D + o * 8) = z;
        }
        for (long i = (long)bid * NTH + tid; i < (long)DEPTH * 1024 * 16; i += (long)nb * NTH) {
            const long row = i / 16; const int c8 = (int)(i % 16) * 8;
            *(u32x4*)(p.WukvT + row * 256 + 128 + c8) = z;
        }
    }
}

struct Row { float4 v[8]; };
__device__ __forceinline__ void row_load(Row& r, const float* p, int lane) {
#pragma unroll
    for (int i = 0; i < 8; ++i) r.v[i] = ld4(p + (i * 64 + lane) * 4);
}
__device__ __forceinline__ void row_store(const Row& r, float* p, int lane) {
#pragma unroll
    for (int i = 0; i < 8; ++i) st4(p + (i * 64 + lane) * 4, r.v[i]);
}
__device__ __forceinline__ void row_store_bf16(const Row& r, bf16_t* p, int lane) {
#pragma unroll
    for (int i = 0; i < 8; ++i) { u32x2 w; w.x = cvt_pk_bf16(r.v[i].x, r.v[i].y); w.y = cvt_pk_bf16(r.v[i].z, r.v[i].w); *(u32x2*)(p + (i * 64 + lane) * 4) = w; }
}
__device__ __forceinline__ void row_stats(const Row& r, float& mean, float& rstd) {
    float s = 0.f;
#pragma unroll
    for (int i = 0; i < 8; ++i) s += (r.v[i].x + r.v[i].y) + (r.v[i].z + r.v[i].w);
    mean = wsum(s) * (1.0f / D);
    float q = 0.f;
#pragma unroll
    for (int i = 0; i < 8; ++i) { const float a = r.v[i].x - mean, b = r.v[i].y - mean, c = r.v[i].z - mean, d = r.v[i].w - mean; q += (a * a + b * b) + (c * c + d * d); }
    rstd = rsqrtf(wsum(q) * (1.0f / D) + EPS);
}
__device__ __forceinline__ void row_modulate(Row& r, float mean, float rstd, const float* sh, const float* sc, int lane) {
#pragma unroll
    for (int i = 0; i < 8; ++i) {
        const int c = (i * 64 + lane) * 4;
        const float4 s = ld4(sc + c), h = ld4(sh + c);
        r.v[i].x = (r.v[i].x - mean) * rstd * (1.f + s.x) + h.x; r.v[i].y = (r.v[i].y - mean) * rstd * (1.f + s.y) + h.y;
        r.v[i].z = (r.v[i].z - mean) * rstd * (1.f + s.z) + h.z; r.v[i].w = (r.v[i].w - mean) * rstd * (1.f + s.w) + h.w;
    }
}
__device__ __forceinline__ void row_affine(Row& r, float mean, float rstd, const float* g, const float* b, int lane) {
#pragma unroll
    for (int i = 0; i < 8; ++i) {
        const int c = (i * 64 + lane) * 4;
        const float4 s = ld4(g + c), h = ld4(b + c);
        r.v[i].x = (r.v[i].x - mean) * rstd * s.x + h.x; r.v[i].y = (r.v[i].y - mean) * rstd * s.y + h.y;
        r.v[i].z = (r.v[i].z - mean) * rstd * s.z + h.z; r.v[i].w = (r.v[i].w - mean) * rstd * s.w + h.w;
    }
}

__device__ __forceinline__ void ph_lnmod(const Params& p, int l, int bid, int nb) {
    const int tid = otid(), lane = tid & 63, wid = tid >> 6;
    for (int r = bid * NWV + wid; r < R; r += nb * NWV) {
        Row x; row_load(x, p.xc + (long)r * D, lane);
        float mean, rstd; row_stats(x, mean, rstd);
        const float* mv = p.modv + ((long)l * 3 + mod_row(r)) * 6 * D;
        row_modulate(x, mean, rstd, mv + 0 * D, mv + 1 * D, lane);
        row_store_bf16(x, p.hb + (long)r * D, lane);
    }
}

__device__ __forceinline__ void ph_prep(const Params& p, int l, int bid, int nb) {
    const int tid = otid(), lane = tid & 63, wid = tid >> 6;
    for (int rr = 0; rr < 8 * (R / 64); ++rr) {
        const int grp = rr >> 3;
        const int g64 = bid + (grp) * nb; if (g64 >= R / 64) break;
        const int r = g64 * 64 + wid * 8 + (rr & 7);
        const float* pr = p.P + (long)r * INC;
        const bool lat = r < NLAT;
        const int t = r % T; const float rowi = (float)(t / 64), coli = (float)(t % 64);
        {
            float sn = 0.f, cs = 1.f;
            if (lat) { const int f = lane & 31; const float inv = powf(10000.0f, -(float)f / 32.0f); sincosf((lane < 32 ? rowi : coli) * inv, &sn, &cs); }
#pragma unroll
            for (int h = 0; h < 6; ++h) {
                const float x1 = pr[SQ + h * 128 + lane], x2 = pr[SQ + h * 128 + lane + 64];
                const bf16_t y1 = f2bf(x1 * cs - x2 * sn), y2 = f2bf(x2 * cs + x1 * sn);
                bf16_t* d = (h < 4) ? (p.sqb + (long)r * 512 + h * 128) : (p.skb + (long)r * 256 + (h - 4) * 128);
                d[lane] = y1; d[lane + 64] = y2;
            }
#pragma unroll
            for (int i = 0; i < 4; ++i) p.svT[(long)(i * 64 + lane) * R + r] = f2bf(pr[SV + i * 64 + lane]);
        }
        if (lane < 32) {
            float sn = 0.f, cs = 1.f;
            if (lat) { const int f = lane & 15; const float inv = powf(10000.0f, -(float)f / 16.0f); sincosf((lane < 16 ? rowi : coli) * inv, &sn, &cs); }
            const float x1 = pr[KR + lane], x2 = pr[KR + lane + 32];
            p.Krb[(long)r * 64 + lane] = f2bf(x1 * cs - x2 * sn); p.Krb[(long)r * 64 + lane + 32] = f2bf(x2 * cs + x1 * sn);
        }
        {
            float v[6]; float s = 0.f;
#pragma unroll
            for (int i = 0; i < 6; ++i) { v[i] = pr[CQ + i * 64 + lane]; s += v[i] * v[i]; }
            const float rs = rsqrtf(wsum(s) * (1.0f / 384.0f) + EPS);
#pragma unroll
            for (int i = 0; i < 6; ++i) p.cqn[(long)r * 384 + i * 64 + lane] = f2bf(v[i] * rs * p.q_norm[l * 384 + i * 64 + lane]);
            const float a = pr[CKV + lane], b = pr[CKV + 64 + lane];
            const float rs2 = rsqrtf(wsum(a * a + b * b) * (1.0f / 128.0f) + EPS);
            p.ckvn[(long)r * 256 + lane] = f2bf(a * rs2 * p.kv_norm[l * 128 + lane]);
            p.ckvn[(long)r * 256 + 64 + lane] = f2bf(b * rs2 * p.kv_norm[l * 128 + 64 + lane]);
            p.ckvn[(long)r * 256 + 128 + lane] = 0; p.ckvn[(long)r * 256 + 192 + lane] = 0;
        }
    }
}

struct AttnSrc {
    const bf16_t* Q; int ldq, qoff;
    const bf16_t* K1; int ldk1, k1off;
    const bf16_t* K2; int ldk2;
    const bf16_t* Vt; int ldv, voff;
    bf16_t* O; int ldo, ooff;
};
template <bool MLA>
__device__ __forceinline__ void attn_unit(const AttnSrc& a, int qrow0, int ctxrow0, int locrow0, int nloc, bool win, int tq0, int tk0, bool rope_q,
                                          float sink_l2, float c, LAS unsigned char* lds) {
    constexpr int KSTR = MLA ? 400 : 272, NKS = MLA ? 6 : 4, VSTR = 144, KBYTES = 64 * KSTR, BUFB = KBYTES + 128 * VSTR, NCH = MLA ? 5 : 4;
    const int tid = otid(), lane = tid & 63, wid = tid >> 6, fr = lane & 15, fq = lane >> 4;
    const int ntiles = 4 + nloc;
    bf16x8 qf[NKS];
    {
        const bf16_t* qp = a.Q + (long)(qrow0 + wid * 16 + fr) * a.ldq + a.qoff + fq * 8;
#pragma unroll
        for (int ks = 0; ks < NKS; ++ks) qf[ks] = *(const bf16x8*)(qp + ks * 32);
        if (MLA && rope_q) {
            const int t = tq0 + wid * 16 + fr; const float rowi = (float)(t / 64), coli = (float)(t % 64);
#pragma unroll
            for (int e = 0; e < 8; ++e) {
                const int i = fq * 8 + e, f = i & 15;
                const float inv = powf(10000.0f, -(float)f / 16.0f);
                const float ang = (i < 16 ? rowi : coli) * inv;
                float sn, cs; sincosf(ang, &sn, &cs);
                const float x1 = __uint_as_float(((unsigned)(unsigned short)qf[4][e]) << 16), x2 = __uint_as_float(((unsigned)(unsigned short)qf[5][e]) << 16);
                qf[4][e] = (short)f2bf(x1 * cs - x2 * sn); qf[5][e] = (short)f2bf(x2 * cs + x1 * sn);
            }
        }
    }
    f32x4 o[8];
#pragma unroll
    for (int dt = 0; dt < 8; ++dt) o[dt] = (f32x4){0.f, 0.f, 0.f, 0.f};
    float m = -INFINITY, l = 0.f;
    u32x4 rg[NCH];
#define ATT_LOAD(keyrow0) do { \
        const int kr_ = (keyrow0); \
        rg[0] = *(const u32x4*)(a.K1 + (long)(kr_ + (tid >> 4)) * a.ldk1 + a.k1off + (tid & 15) * 8); \
        rg[1] = *(const u32x4*)(a.K1 + (long)(kr_ + 32 + (tid >> 4)) * a.ldk1 + a.k1off + (tid & 15) * 8); \
        if (MLA) { rg[2] = *(const u32x4*)(a.K2 + (long)(kr_ + (tid >> 3)) * a.ldk2 + (tid & 7) * 8); \
                   rg[3] = *(const u32x4*)(a.Vt + (long)(a.voff + (tid >> 3)) * a.ldv + kr_ + (tid & 7) * 8); \
                   rg[NCH - 1] = *(const u32x4*)(a.Vt + (long)(a.voff + 64 + (tid >> 3)) * a.ldv + kr_ + (tid & 7) * 8); } \
        else { rg[2] = *(const u32x4*)(a.Vt + (long)(a.voff + (tid >> 3)) * a.ldv + kr_ + (tid & 7) * 8); \
               rg[NCH - 1] = *(const u32x4*)(a.Vt + (long)(a.voff + 64 + (tid >> 3)) * a.ldv + kr_ + (tid & 7) * 8); } } while (0)
#define ATT_STORE(buf) do { LAS unsigned char* b_ = (buf); \
        *(LAS u32x4*)(b_ + (tid >> 4) * KSTR + (tid & 15) * 16) = rg[0]; \
        *(LAS u32x4*)(b_ + (32 + (tid >> 4)) * KSTR + (tid & 15) * 16) = rg[1]; \
        if (MLA) { *(LAS u32x4*)(b_ + (tid >> 3) * KSTR + 256 + (tid & 7) * 16) = rg[2]; \
                   *(LAS u32x4*)(b_ + KBYTES + (tid >> 3) * VSTR + (tid & 7) * 16) = rg[3]; \
                   *(LAS u32x4*)(b_ + KBYTES + (64 + (tid >> 3)) * VSTR + (tid & 7) * 16) = rg[NCH - 1]; } \
        else { *(LAS u32x4*)(b_ + KBYTES + (tid >> 3) * VSTR + (tid & 7) * 16) = rg[2]; \
               *(LAS u32x4*)(b_ + KBYTES + (64 + (tid >> 3)) * VSTR + (tid & 7) * 16) = rg[NCH - 1]; } } while (0)
#define ATT_KEYROW(i) ((i) < 4 ? ctxrow0 + 64 * (i) : locrow0 + 64 * ((i) - 4))
    __syncthreads();
    ATT_LOAD(ATT_KEYROW(0));
    ATT_STORE(lds);
    __syncthreads();
    for (int t = 0; t < ntiles; ++t) {
        LAS unsigned char* buf = lds + (t & 1) * BUFB;
        if (t + 1 < ntiles) ATT_LOAD(ATT_KEYROW(t + 1));
        f32x4 s[4];
#pragma unroll
        for (int kt = 0; kt < 4; ++kt) {
            s[kt] = (f32x4){0.f, 0.f, 0.f, 0.f};
#pragma unroll
            for (int ks = 0; ks < NKS; ++ks) {
                const bf16x8 kf = *(const LAS bf16x8*)(buf + (kt * 16 + fr) * KSTR + ks * 64 + fq * 16);
                s[kt] = __builtin_amdgcn_mfma_f32_16x16x32_bf16(kf, qf[ks], s[kt], 0, 0, 0);
            }
        }
        if (win && t >= 4) {
            const int tq = tq0 + wid * 16 + fr, tkb = tk0 + 64 * (t - 4) + 4 * fq;
#pragma unroll
            for (int kt = 0; kt < 4; ++kt)
#pragma unroll
                for (int j = 0; j < 4; ++j) { const int d = tkb + kt * 16 + j - tq; if (d < -128 || d > 128) s[kt][j] = -INFINITY; }
        }
        float mx = fmaxf(fmaxf(fmaxf(s[0][0], s[0][1]), fmaxf(s[0][2], s[0][3])), fmaxf(fmaxf(s[1][0], s[1][1]), fmaxf(s[1][2], s[1][3])));
        mx = fmaxf(mx, fmaxf(fmaxf(fmaxf(s[2][0], s[2][1]), fmaxf(s[2][2], s[2][3])), fmaxf(fmaxf(s[3][0], s[3][1]), fmaxf(s[3][2], s[3][3]))));
        mx = fmaxf(mx, __shfl_xor(mx, 16)); mx = fmaxf(mx, __shfl_xor(mx, 32));
        const float mn = fmaxf(m, mx * c);
        const float alpha = __builtin_amdgcn_exp2f(m - mn);
        m = mn;
        float ps = 0.f;
#pragma unroll
        for (int kt = 0; kt < 4; ++kt)
#pragma unroll
            for (int j = 0; j < 4; ++j) { const float pv = __builtin_amdgcn_exp2f(fmaf(s[kt][j], c, -mn)); s[kt][j] = pv; ps += pv; }
        l = l * alpha + ps;
#pragma unroll
        for (int dt = 0; dt < 8; ++dt) o[dt] = o[dt] * alpha;
#pragma unroll
        for (int s2 = 0; s2 < 2; ++s2) {
            u32x4 pk; pk.x = cvt_pk_bf16(s[2 * s2][0], s[2 * s2][1]); pk.y = cvt_pk_bf16(s[2 * s2][2], s[2 * s2][3]);
            pk.z = cvt_pk_bf16(s[2 * s2 + 1][0], s[2 * s2 + 1][1]); pk.w = cvt_pk_bf16(s[2 * s2 + 1][2], s[2 * s2 + 1][3]);
            const bf16x8 pf = __builtin_bit_cast(bf16x8, pk);
#pragma unroll
            for (int dt = 0; dt < 8; ++dt) {
                const LAS unsigned char* vp = buf + KBYTES + (dt * 16 + fr) * VSTR + (32 * s2 + 4 * fq) * 2;
                const u32x2 lo = *(const LAS u32x2*)vp, hi = *(const LAS u32x2*)(vp + 32);
                u32x4 vv; vv.x = lo.x; vv.y = lo.y; vv.z = hi.x; vv.w = hi.y;
                o[dt] = __builtin_amdgcn_mfma_f32_16x16x32_bf16(__builtin_bit_cast(bf16x8, vv), pf, o[dt], 0, 0, 0);
            }
        }
        __syncthreads();
        if (t + 1 < ntiles) ATT_STORE(lds + ((t + 1) & 1) * BUFB);
        __syncthreads();
    }
#undef ATT_LOAD
#undef ATT_STORE
#undef ATT_KEYROW
    l += __shfl_xor(l, 16); l += __shfl_xor(l, 32);
    if (sink_l2 > -INFINITY) { const float mn = fmaxf(m, sink_l2); const float alpha = __builtin_amdgcn_exp2f(m - mn); l = l * alpha + __builtin_amdgcn_exp2f(sink_l2 - mn);
#pragma unroll
        for (int dt = 0; dt < 8; ++dt) o[dt] = o[dt] * alpha; }
    const float il = 1.0f / l;
    bf16_t* op = a.O + (long)(qrow0 + wid * 16 + fr) * a.ldo + a.ooff + 4 * fq;
#pragma unroll
    for (int dt = 0; dt < 8; ++dt) { u32x2 w; w.x = cvt_pk_bf16(o[dt][0] * il, o[dt][1] * il); w.y = cvt_pk_bf16(o[dt][2] * il, o[dt][3] * il); *(u32x2*)(op + dt * 16) = w; }
}


__device__ __forceinline__ float bf2f(bf16_t v) { return __uint_as_float(((unsigned)v) << 16); }
#define OSM_UPDATE(S, M_, L_, A0, A1, V0, V1) do { const float mn_ = fmaxf(M_, S); const float cr_ = expf(M_ - mn_); const float pp_ = expf((S) - mn_); \
    L_ = L_ * cr_ + pp_; A0 = A0 * cr_ + pp_ * (V0); A1 = A1 * cr_ + pp_ * (V1); M_ = mn_; } while (0)
__device__ __forceinline__ void swa_task(const Params& p, int l, int h, int r0, int lane) {
    constexpr int QW = 4;
    const float scale = 0.08838834764831845f;
    const bool lat = r0 < NLAT;
    const int b = lat ? r0 / T : (r0 - NLAT) / LCTX;
    const int kvh = h >> 1;
    float q0[QW], q1[QW], m[QW], ls[QW], a0[QW], a1[QW];
#pragma unroll
    for (int i = 0; i < QW; ++i) {
        const bf16_t* q = p.sqb + (long)(r0 + i) * 512 + h * 128;
        q0[i] = bf2f(q[lane]) * scale; q1[i] = bf2f(q[lane + 64]) * scale; m[i] = -INFINITY; ls[i] = 0.f; a0[i] = 0.f; a1[i] = 0.f;
    }
    for (int j = 0; j < LCTX; ++j) {
        const long rk = NLAT + b * LCTX + j;
        const float k0 = bf2f(p.skb[rk * 256 + kvh * 128 + lane]), k1 = bf2f(p.skb[rk * 256 + kvh * 128 + 64 + lane]);
        const float v0 = bf2f(p.svT[(long)(kvh * 128 + lane) * R + rk]), v1 = bf2f(p.svT[(long)(kvh * 128 + 64 + lane) * R + rk]);
#pragma unroll
        for (int i = 0; i < QW; ++i) { const float s = wsum(q0[i] * k0 + q1[i] * k1); OSM_UPDATE(s, m[i], ls[i], a0[i], a1[i], v0, v1); }
    }
    if (lat) {
        const int t0 = r0 % T;
        const int lo = (t0 - 128) < 0 ? 0 : (t0 - 128), hi = (t0 + QW - 1 + 128) > (T - 1) ? (T - 1) : (t0 + QW - 1 + 128);
        for (int tk = lo; tk <= hi; ++tk) {
            const long rk = b * T + tk;
            const float k0 = bf2f(p.skb[rk * 256 + kvh * 128 + lane]), k1 = bf2f(p.skb[rk * 256 + kvh * 128 + 64 + lane]);
            const float v0 = bf2f(p.svT[(long)(kvh * 128 + lane) * R + rk]), v1 = bf2f(p.svT[(long)(kvh * 128 + 64 + lane) * R + rk]);
#pragma unroll
            for (int i = 0; i < QW; ++i) {
                const int d = tk - (t0 + i);
                if (d >= -128 && d <= 128) { const float s = wsum(q0[i] * k0 + q1[i] * k1); OSM_UPDATE(s, m[i], ls[i], a0[i], a1[i], v0, v1); }
            }
        }
    }
    const float sk = p.swa_sink[l * 4 + h];
#pragma unroll
    for (int i = 0; i < QW; ++i) {
        OSM_UPDATE(sk, m[i], ls[i], a0[i], a1[i], 0.f, 0.f);
        bf16_t* o = p.mix + (long)(r0 + i) * D + h * 128;
        const float il = 1.0f / ls[i];
        o[lane] = f2bf(a0[i] * il); o[lane + 64] = f2bf(a1[i] * il);
    }
}
__device__ __forceinline__ void mla_task(const Params& p, int h, int r0, int lane) {
    constexpr int QW = 8;
    const float scale = 0.07216878364870323f;
    const bool lat = r0 < NLAT;
    const int b = lat ? r0 / T : (r0 - NLAT) / LCTX;
    float q0[QW], q1[QW], q2[QW], m[QW], ls[QW], a0[QW], a1[QW];
#pragma unroll
    for (int i = 0; i < QW; ++i) {
        const bf16_t* q = p.Q2b + (long)(r0 + i) * 768 + h * 192;
        q0[i] = bf2f(q[lane]) * scale; q1[i] = bf2f(q[lane + 64]) * scale;
        float qr = bf2f(q[128 + lane]);
        if (lat) {
            const int t = (r0 + i) % T; const float rowi = (float)(t / 64), coli = (float)(t % 64);
            const int ii = lane & 31, f = ii & 15;
            const float inv = powf(10000.0f, -(float)f / 16.0f);
            const float ang = (ii < 16 ? rowi : coli) * inv;
            float sn, cs; sincosf(ang, &sn, &cs);
            const float other = __shfl_xor(qr, 32);
            qr = (lane < 32) ? (qr * cs - other * sn) : (qr * cs + other * sn);
        }
        q2[i] = qr * scale; m[i] = -INFINITY; ls[i] = 0.f; a0[i] = 0.f; a1[i] = 0.f;
    }
    const int nkeys = lat ? (LCTX + T) : LCTX;
    for (int j = 0; j < nkeys; ++j) {
        const long rk = (j < LCTX) ? (NLAT + b * LCTX + j) : (b * T + (j - LCTX));
        const float k0 = bf2f(p.Kn[rk * 512 + h * 128 + lane]), k1 = bf2f(p.Kn[rk * 512 + h * 128 + 64 + lane]);
        const float v0 = bf2f(p.VtM[(long)(h * 128 + lane) * R + rk]), v1 = bf2f(p.VtM[(long)(h * 128 + 64 + lane) * R + rk]);
        const float k2 = bf2f(p.Krb[rk * 64 + lane]);
#pragma unroll
        for (int i = 0; i < QW; ++i) { const float s = wsum(q0[i] * k0 + q1[i] * k1 + q2[i] * k2); OSM_UPDATE(s, m[i], ls[i], a0[i], a1[i], v0, v1); }
    }
#pragma unroll
    for (int i = 0; i < QW; ++i) {
        bf16_t* o = p.mix + (long)(r0 + i) * D + 1024 + h * 128;
        const float il = 1.0f / ls[i];
        o[lane] = f2bf(a0[i] * il); o[lane + 64] = f2bf(a1[i] * il);
    }
}

constexpr int NCHK = (LCTX + T) / 64;
constexpr int SC_QB = 0, SC_KB = 17408, SC_BF = 34816, SC_VT = 68608, SC_ST = 87040, SC_QT = 121856;
__device__ __forceinline__ float hgrn_lb(const Params& p, int l, int dir, int hi) {
    if (l == 0) return 0.f;
    const float l0 = p.lb_logits[(0 * 2 + dir) * 512 + hi], l1 = p.lb_logits[(1 * 2 + dir) * 512 + hi];
    const float mx = fmaxf(l0, l1), e0 = expf(l0 - mx), e1 = expf(l1 - mx);
    return e1 / (e0 + e1);
}
__device__ __forceinline__ int scan_row0(int b, int rb) { return rb < 4 ? NLAT + b * LCTX + rb * 64 : b * T + (rb - 4) * 64; }
__device__ __forceinline__ int scan_chunk(int dir, int rb) { return dir ? (rb < 4 ? 3 - rb : 71 - rb) : rb; }
template <int MIXER>
__device__ __forceinline__ void scan_load_k(const Params& p, int l, int h, int dir, int row0, int d, int rq, float lng, float lb, float (&kv)[16], float (&pb)[16], float& tot) {
    const int koff = (MIXER == 0 ? RK : (dir ? HFB : HFF)) + h * 128 + d;
    float g[16];
#pragma unroll
    for (int j = 0; j < 16; ++j) {
        const float z = p.P[(long)(row0 + rq * 16 + j) * INC + koff];
        if (MIXER == 0) { kv[j] = z * 0.08838834764831845f; g[j] = lng; }
        else { const float f = lb + (1.0f - lb) * sigmf(z); kv[j] = 1.0f - f; g[j] = logf(f); }
    }
    float run = 0.f;
    if (dir == 0) {
#pragma unroll
        for (int j = 0; j < 16; ++j) { run += g[j]; pb[j] = run; }
    } else {
#pragma unroll
        for (int j = 15; j >= 0; --j) { run += g[j]; pb[j] = run; }
    }
    tot = run;
}
template <int MIXER>
__device__ __forceinline__ void scan_s1(const Params& p, int l, int u, LAS unsigned char* lds) {
    const int tid = otid(), lane = tid & 63, wid = tid >> 6, fr = lane & 15, fq = lane >> 4, d = tid & 127, rq = tid >> 7;
    const int sl = u / NCHK, rb = u % NCHK, b = sl >> 3, h = (sl >> 1) & 3, dir = sl & 1, sq = MIXER * 16 + sl;
    const int row0 = scan_row0(b, rb), c = scan_chunk(dir, rb);
    const float lng = (MIXER == 0) ? log1pf(-exp2f(-p.ret_s[(l * 2 + dir) * 4 + h])) : 0.f;
    const float lb = (MIXER == 1) ? hgrn_lb(p, l, dir, h * 128 + d) : 0.f;
    LAS float* qt = (LAS float*)(lds + 36864);
    float kv[16], pb[16], tot;
    scan_load_k<MIXER>(p, l, h, dir, row0, d, rq, lng, lb, kv, pb, tot);
    float vv[16];
    {
        const int voff = (MIXER == 0 ? RV : HI) + h * 128 + d;
#pragma unroll
        for (int j = 0; j < 16; ++j) vv[j] = p.P[(long)(row0 + rq * 16 + j) * INC + voff];
    }
    __syncthreads();
    qt[rq * 128 + d] = tot;
#pragma unroll
    for (int j = 0; j < 16; ++j) *(LAS bf16_t*)(lds + 18432 + d * 144 + (rq * 16 + j) * 2) = f2bf(vv[j]);
    __syncthreads();
    float off = 0.f, all = 0.f;
#pragma unroll
    for (int q = 0; q < 4; ++q) { const float tq_ = qt[q * 128 + d]; all += tq_; if (dir == 0 ? (q < rq) : (q > rq)) off += tq_; }
#pragma unroll
    for (int j = 0; j < 16; ++j) *(LAS bf16_t*)(lds + d * 144 + (rq * 16 + j) * 2) = f2bf(kv[j] * __expf(all - (pb[j] + off)));
    if (rq == 0) p.sA[(long)(sq * NCHK + c) * 128 + d] = __expf(all);
    __syncthreads();
    f32x4 acc[8];
#pragma unroll
    for (int nt = 0; nt < 8; ++nt) acc[nt] = (f32x4){0.f, 0.f, 0.f, 0.f};
#pragma unroll
    for (int ks = 0; ks < 2; ++ks) {
        const bf16x8 a = *(const LAS bf16x8*)(lds + 18432 + (wid * 16 + fr) * 144 + (32 * ks + 8 * fq) * 2);
#pragma unroll
        for (int nt = 0; nt < 8; ++nt) {
            const bf16x8 bb = *(const LAS bf16x8*)(lds + (nt * 16 + fr) * 144 + (32 * ks + 8 * fq) * 2);
            acc[nt] = __builtin_amdgcn_mfma_f32_16x16x32_bf16(a, bb, acc[nt], 0, 0, 0);
        }
    }
    float* up = p.sst + (long)(sq * NCHK + c) * 16384 + (long)(wid * 16 + 4 * fq) * 128 + fr;
#pragma unroll
    for (int nt = 0; nt < 8; ++nt)
#pragma unroll
        for (int j = 0; j < 4; ++j) up[j * 128 + nt * 16] = acc[nt][j];
}
__device__ __forceinline__ void ph_scan2(const Params& p, int bid, int nb) {
    const int tid = otid();
    for (int e = bid * NTH + tid; e < 32 * 16384; e += nb * NTH) {
        const int sq = e >> 14, ij = e & 16383, dk = ij & 127;
        float* base = p.sst + (long)sq * NCHK * 16384 + ij;
        const float* A = p.sA + (long)sq * NCHK * 128 + dk;
        float S = 0.f;
#pragma unroll 4
        for (int c = 0; c < NCHK; ++c) { const float uv = base[(long)c * 16384]; base[(long)c * 16384] = S; S = fmaf(A[c * 128], S, uv); }
    }
}
__device__ __forceinline__ void bf8_to_f32(const bf16x8 v, float (&f)[8]) {
    const u32x4 w = __builtin_bit_cast(u32x4, v);
    f[0] = __uint_as_float(w.x << 16); f[1] = __uint_as_float(w.x & 0xffff0000u); f[2] = __uint_as_float(w.y << 16); f[3] = __uint_as_float(w.y & 0xffff0000u);
    f[4] = __uint_as_float(w.z << 16); f[5] = __uint_as_float(w.z & 0xffff0000u); f[6] = __uint_as_float(w.w << 16); f[7] = __uint_as_float(w.w & 0xffff0000u);
}
__device__ __forceinline__ bf16x8 f32_to_bf8(const float (&f)[8]) {
    u32x4 w; w.x = cvt_pk_bf16(f[0], f[1]); w.y = cvt_pk_bf16(f[2], f[3]); w.z = cvt_pk_bf16(f[4], f[5]); w.w = cvt_pk_bf16(f[6], f[7]);
    return __builtin_bit_cast(bf16x8, w);
}
template <int MIXER>
__device__ __forceinline__ void scan_s3(const Params& p, int l, int u, LAS unsigned char* lds) {
    const int tid = otid(), lane = tid & 63, wid = tid >> 6, fr = lane & 15, fq = lane >> 4, d = tid & 127, rq = tid >> 7, jr = wid & 3, dvh = wid >> 2;
    const int b = u / (4 * NCHK), rem = u % (4 * NCHK), h = rem / NCHK, rb = rem % NCHK;
    const int row0 = scan_row0(b, rb);
    LAS float* qt = (LAS float*)(lds + SC_QT);
    LAS float* bfp = (LAS float*)(lds + SC_BF);
    __syncthreads();
    {
        const int qoff = (MIXER == 0 ? RQ : HQ) + h * 128 + d, voff = (MIXER == 0 ? RV : HI) + h * 128 + d;
#pragma unroll
        for (int j = 0; j < 16; ++j) {
            const int r = rq * 16 + j; const float* pr = p.P + (long)(row0 + r) * INC;
            const float qv = pr[qoff], vv = pr[voff];
            *(LAS bf16_t*)(lds + SC_QB + r * 272 + d * 2) = f2bf(MIXER == 0 ? qv : siluf(qv));
            *(LAS bf16_t*)(lds + SC_VT + d * 144 + r * 2) = f2bf(vv);
        }
    }
    f32x4 o[4];
#pragma unroll
    for (int dt = 0; dt < 4; ++dt) o[dt] = (f32x4){0.f, 0.f, 0.f, 0.f};
#pragma unroll 1
    for (int dir = 0; dir < 2; ++dir) {
        const int sq = MIXER * 16 + (b * 4 + h) * 2 + dir, cidx = scan_chunk(dir, rb);
        const float lng = (MIXER == 0) ? log1pf(-exp2f(-p.ret_s[(l * 2 + dir) * 4 + h])) : 0.f;
        const float lb = (MIXER == 1) ? hgrn_lb(p, l, dir, h * 128 + d) : 0.f;
        float kv[16], pb[16], tot;
        scan_load_k<MIXER>(p, l, h, dir, row0, d, rq, lng, lb, kv, pb, tot);
        if (dir == 1) __syncthreads();
        qt[rq * 128 + d] = tot;
#pragma unroll
        for (int j = 0; j < 16; ++j) *(LAS bf16_t*)(lds + SC_KB + (rq * 16 + j) * 272 + d * 2) = f2bf(kv[j]);
        {
            const float* sp = p.sst + (long)(sq * NCHK + cidx) * 16384;
#pragma unroll
            for (int e = 0; e < 8; ++e) {
                const int idx = tid + e * NTH, dv = idx >> 5, c4 = idx & 31;
                const float4 v4 = ld4(sp + dv * 128 + c4 * 4);
                u32x2 w; w.x = cvt_pk_bf16(v4.x, v4.y); w.y = cvt_pk_bf16(v4.z, v4.w);
                *(LAS u32x2*)(lds + SC_ST + dv * 272 + c4 * 8) = w;
            }
        }
        __syncthreads();
        {
            float off = 0.f;
#pragma unroll
            for (int q = 0; q < 4; ++q) { const float tq_ = qt[q * 128 + d]; if (dir == 0 ? (q < rq) : (q > rq)) off += tq_; }
#pragma unroll
            for (int j = 0; j < 16; ++j) bfp[(rq * 16 + j) * 132 + d] = pb[j] + off;
        }
        __syncthreads();
        const int n = 16 * jr + fr;
        const int rowB = dir == 0 ? 16 * jr - 1 : 16 * jr + 16;
        const bool hasB = dir == 0 ? (jr > 0) : (jr < 3);
        bf16x8 Qh[4], Qt[4];
        float B8[4][8];
#pragma unroll
        for (int ks = 0; ks < 4; ++ks) {
            const int d0 = 32 * ks + 8 * fq;
            float q8[8], bn[8];
            bf8_to_f32(*(const LAS bf16x8*)(lds + SC_QB + n * 272 + d0 * 2), q8);
            const f32x4 b0 = *(const LAS f32x4*)(bfp + n * 132 + d0), b1 = *(const LAS f32x4*)(bfp + n * 132 + d0 + 4);
            bn[0] = b0[0]; bn[1] = b0[1]; bn[2] = b0[2]; bn[3] = b0[3]; bn[4] = b1[0]; bn[5] = b1[1]; bn[6] = b1[2]; bn[7] = b1[3];
            if (hasB) { const f32x4 c0 = *(const LAS f32x4*)(bfp + rowB * 132 + d0), c1 = *(const LAS f32x4*)(bfp + rowB * 132 + d0 + 4);
                B8[ks][0] = c0[0]; B8[ks][1] = c0[1]; B8[ks][2] = c0[2]; B8[ks][3] = c0[3]; B8[ks][4] = c1[0]; B8[ks][5] = c1[1]; B8[ks][6] = c1[2]; B8[ks][7] = c1[3]; }
            else {
#pragma unroll
                for (int e = 0; e < 8; ++e) B8[ks][e] = 0.f; }
            float qh[8], qtl[8];
#pragma unroll
            for (int e = 0; e < 8; ++e) { qh[e] = q8[e] * __expf(bn[e] - B8[ks][e]); qtl[e] = q8[e] * __expf(bn[e]); }
            Qh[ks] = f32_to_bf8(qh); Qt[ks] = f32_to_bf8(qtl);
        }
#pragma unroll
        for (int dt = 0; dt < 4; ++dt)
#pragma unroll
            for (int ks = 0; ks < 4; ++ks) {
                const bf16x8 a = *(const LAS bf16x8*)(lds + SC_ST + (dvh * 64 + dt * 16 + fr) * 272 + (32 * ks + 8 * fq) * 2);
                o[dt] = __builtin_amdgcn_mfma_f32_16x16x32_bf16(a, Qt[ks], o[dt], 0, 0, 0);
            }
        f32x4 sc[4];
#pragma unroll
        for (int kr = 0; kr < 4; ++kr) {
            sc[kr] = (f32x4){0.f, 0.f, 0.f, 0.f};
            const bool need = dir == 0 ? (kr <= jr) : (kr >= jr);
            if (need) {
                const int m = 16 * kr + fr;
#pragma unroll
                for (int ks = 0; ks < 4; ++ks) {
                    const int d0 = 32 * ks + 8 * fq;
                    float k8[8], kh[8];
                    bf8_to_f32(*(const LAS bf16x8*)(lds + SC_KB + m * 272 + d0 * 2), k8);
                    const f32x4 b0 = *(const LAS f32x4*)(bfp + m * 132 + d0), b1 = *(const LAS f32x4*)(bfp + m * 132 + d0 + 4);
                    const float bm[8] = {b0[0], b0[1], b0[2], b0[3], b1[0], b1[1], b1[2], b1[3]};
#pragma unroll
                    for (int e = 0; e < 8; ++e) kh[e] = k8[e] * __expf(fminf(B8[ks][e] - bm[e], 60.0f));
                    sc[kr] = __builtin_amdgcn_mfma_f32_16x16x32_bf16(f32_to_bf8(kh), Qh[ks], sc[kr], 0, 0, 0);
                }
                if (kr == jr) {
#pragma unroll
                    for (int j = 0; j < 4; ++j) { const int mm = 4 * fq + j; const bool keep = dir == 0 ? (mm <= fr) : (mm >= fr); if (!keep) sc[kr][j] = 0.f; }
                }
            }
        }
#pragma unroll
        for (int s2 = 0; s2 < 2; ++s2) {
            const bool need = dir == 0 ? (2 * s2 <= jr) : (2 * s2 + 1 >= jr);
            if (need) {
                u32x4 pk; pk.x = cvt_pk_bf16(sc[2 * s2][0], sc[2 * s2][1]); pk.y = cvt_pk_bf16(sc[2 * s2][2], sc[2 * s2][3]);
                pk.z = cvt_pk_bf16(sc[2 * s2 + 1][0], sc[2 * s2 + 1][1]); pk.w = cvt_pk_bf16(sc[2 * s2 + 1][2], sc[2 * s2 + 1][3]);
                const bf16x8 pf = __builtin_bit_cast(bf16x8, pk);
#pragma unroll
                for (int dt = 0; dt < 4; ++dt) {
                    const LAS unsigned char* vp = lds + SC_VT + (dvh * 64 + dt * 16 + fr) * 144 + (32 * s2 + 4 * fq) * 2;
                    const u32x2 lo = *(const LAS u32x2*)vp, hi = *(const LAS u32x2*)(vp + 32);
                    u32x4 vv; vv.x = lo.x; vv.y = lo.y; vv.z = hi.x; vv.w = hi.y;
                    o[dt] = __builtin_amdgcn_mfma_f32_16x16x32_bf16(__builtin_bit_cast(bf16x8, vv), pf, o[dt], 0, 0, 0);
                }
            }
        }
    }
    __syncthreads();
#pragma unroll
    for (int dt = 0; dt < 4; ++dt) *(LAS f32x4*)(bfp + (16 * jr + fr) * 128 + dvh * 64 + dt * 16 + 4 * fq) = o[dt];
    __syncthreads();
    {
        for (int rr = 0; rr < 8; ++rr) {
            const int lr = wid * 8 + rr, r = row0 + lr;
            const float a = bfp[lr * 128 + lane], bq = bfp[lr * 128 + 64 + lane];
            const float* pr = p.P + (long)r * INC;
            const int cc = h * 128 + lane;
            if (MIXER == 0) {
                const float mean = wsum(a + bq) * (1.0f / 128.0f);
                const float da = a - mean, db = bq - mean;
                const float rstd = rsqrtf(wsum(da * da + db * db) * (1.0f / 128.0f) + EPS);
                p.mix[(long)r * D + 512 + cc] = f2bf(siluf(pr[RG + cc]) * (da * rstd * p.ret_gn[l * 512 + cc]));
                p.mix[(long)r * D + 512 + cc + 64] = f2bf(siluf(pr[RG + cc + 64]) * (db * rstd * p.ret_gn[l * 512 + cc + 64]));
            } else {
                const float rs = rsqrtf(wsum(a * a + bq * bq) * (1.0f / 128.0f) + EPS);
                p.mix[(long)r * D + 1536 + cc] = f2bf(siluf(pr[HG + cc]) * (a * rs * p.hgrn_gn[l * 512 + cc]));
                p.mix[(long)r * D + 1536 + cc + 64] = f2bf(siluf(pr[HG + cc + 64]) * (bq * rs * p.hgrn_gn[l * 512 + cc + 64]));
            }
        }
    }
}
__device__ __forceinline__ void ph_scan3(const Params& p, int l, int bid, int nb, LAS unsigned char* lds) {
    constexpr int NU = 2 * 4 * NCHK;
    for (int u = bid; u < 2 * NU; u += nb) {
        if (u < NU) scan_s3<0>(p, l, u, lds); else scan_s3<1>(p, l, u - NU, lds);
    }
}

__device__ __forceinline__ void ph_mixers(const Params& p, int l, int bid, int nb, float* smem, LAS unsigned char* lds) {
    const bool need_ctx = l < DEPTH - 1;
    const float LOG2E = 1.4426950408889634f;
    const float cM = 0.07216878364870323f * LOG2E, cS = 0.08838834764831845f * LOG2E;
#ifndef DIAG_NAIVE
#define DIAG_NAIVE 0
#endif
    if (DIAG_NAIVE) {
        const int tid = otid(), lane = tid & 63, wid = tid >> 6;
        const int nrows = need_ctx ? R : NLAT;
        const int n_mla = (DIAG_NAIVE & 1) ? (nrows / 8) * 4 : ((DIAG_NAIVE & 4) && need_ctx ? (NCTX / 8) * 4 : 0), n_swa = (DIAG_NAIVE & 2) ? (nrows / 4) * 4 : 0;
        const int mla_r0 = (DIAG_NAIVE & 1) ? 0 : NLAT;
        for (int t = bid * NWV + wid; t < n_mla + n_swa; t += nb * NWV) {
            if (t < n_mla) mla_task(p, t & 3, mla_r0 + (t >> 2) * 8, lane);
            else { const int s2 = t - n_mla; swa_task(p, l, s2 & 3, (s2 >> 2) * 4, lane); }
        }
        __syncthreads();
    }
    if (!(DIAG_NAIVE & 1))
    for (int u = bid; u < 256; u += nb) {
        const int b = u >> 7, h = (u >> 5) & 3, qb = u & 31;
        const AttnSrc a{p.Q2b, 768, h * 192, p.Kn, 512, h * 128, p.Krb, 64, p.VtM, R, h * 128, p.mix, D, 1024 + h * 128};
        attn_unit<true>(a, b * T + qb * 128, NLAT + b * LCTX, b * T, 64, false, qb * 128, 0, true, -INFINITY, cM, lds);
    }
    if (!(DIAG_NAIVE & 2))
    for (int u = bid; u < 256; u += nb) {
        const int b = u >> 7, h = (u >> 5) & 3, qb = u & 31, q0 = qb * 128;
        const int ts = (q0 - 128) < 0 ? 0 : (q0 - 128), te = (q0 + 256) > T ? T : (q0 + 256);
        const AttnSrc a{p.sqb, 512, h * 128, p.skb, 256, (h >> 1) * 128, nullptr, 0, p.svT, R, (h >> 1) * 128, p.mix, D, h * 128};
        attn_unit<false>(a, b * T + q0, NLAT + b * LCTX, b * T + ts, (te - ts) / 64, true, q0, ts, false, p.swa_sink[l * 4 + h] * LOG2E, cS, lds);
    }
    if (need_ctx) {
        for (int u = nb - 1 - bid; u < 32; u += nb) {
            const int v = u & 15, b = v >> 3, h = (v >> 1) & 3, qb = v & 1;
            const int qrow0 = NLAT + b * LCTX + qb * 128;
            int nl0 = 0; asm volatile("" : "+s"(nl0));
            if (u < 16) { if (DIAG_NAIVE & 5) continue; const AttnSrc a{p.Q2b, 768, h * 192, p.Kn, 512, h * 128, p.Krb, 64, p.VtM, R, h * 128, p.mix, D, 1024 + h * 128};
                attn_unit<true>(a, qrow0, NLAT + b * LCTX, 0, nl0, false, 0, 0, false, -INFINITY, cM, lds); }
            else { if (DIAG_NAIVE & 2) continue; const AttnSrc a{p.sqb, 512, h * 128, p.skb, 256, (h >> 1) * 128, nullptr, 0, p.svT, R, (h >> 1) * 128, p.mix, D, h * 128};
                attn_unit<false>(a, qrow0, NLAT + b * LCTX, 0, nl0, false, 0, 0, false, p.swa_sink[l * 4 + h] * LOG2E, cS, lds); }
        }
    }
    __syncthreads();
    {
        constexpr int NU1 = 16 * NCHK;
        for (int u = bid; u < 2 * NU1; u += nb) { if (u < NU1) scan_s1<0>(p, l, u, lds); else scan_s1<1>(p, l, u - NU1, lds); }
    }
}

__device__ __forceinline__ void ph_post1(const Params& p, int l, int bid, int nb) {
    const int tid = otid(), lane = tid & 63, wid = tid >> 6;
    const int nrows = (l < DEPTH - 1) ? R : NLAT;
    for (int r = bid * NWV + wid; r < nrows; r += nb * NWV) {
        const float* mv = p.modv + ((long)l * 3 + mod_row(r)) * 6 * D;
        Row x, o; row_load(x, p.xc + (long)r * D, lane); row_load(o, p.ob + (long)r * D, lane);
#pragma unroll
        for (int i = 0; i < 8; ++i) {
            const float4 g = ld4(mv + 2 * D + (i * 64 + lane) * 4);
            x.v[i].x = ALPHA * x.v[i].x + g.x * o.v[i].x; x.v[i].y = ALPHA * x.v[i].y + g.y * o.v[i].y;
            x.v[i].z = ALPHA * x.v[i].z + g.z * o.v[i].z; x.v[i].w = ALPHA * x.v[i].w + g.w * o.v[i].w;
        }
        float mean, rstd; row_stats(x, mean, rstd);
        row_affine(x, mean, rstd, p.ln1_g + l * D, p.ln1_b + l * D, lane);
        row_store(x, p.xc + (long)r * D, lane);
        row_stats(x, mean, rstd);
        row_modulate(x, mean, rstd, mv + 3 * D, mv + 4 * D, lane);
        row_store_bf16(x, p.hb + (long)r * D, lane);
        row_store(x, p.ob + (long)r * D, lane);
    }
}

__device__ __forceinline__ void ph_router(const Params& p, int l, int bid, int nb, float* smem) {
    const int tid = otid(), lane = tid & 63, wid = tid >> 6, half = wid >> 2, wq = wid & 3, i = lane & 31, hk = lane >> 5;
    const int nrows = (l < DEPTH - 1) ? R : NLAT;
    const float* wre = p.w_re + (long)l * D * 32;
    const float* wrg = p.w_rg + (long)l * D * 4;
    for (int bu = bid; bu < nrows / 64; bu += nb) {
        const int row0 = bu * 64 + half * 32;
        f32x16 acc0, acc1;
#pragma unroll
        for (int q = 0; q < 16; ++q) { acc0[q] = 0.f; acc1[q] = 0.f; }
        const float* ap = p.ob + (long)(row0 + i) * D + wq * 512 + 4 * hk;
#pragma unroll 2
        for (int g = 0; g < 64; ++g) {
            const float4 a4 = ld4(ap + g * 8);
            const int kb = wq * 512 + g * 8 + 4 * hk;
            float b0[4], b1[4];
#pragma unroll
            for (int j = 0; j < 4; ++j) { b0[j] = wre[(long)(kb + j) * 32 + i]; b1[j] = (i < 4) ? wrg[(long)(kb + j) * 4 + i] : 0.f; }
            acc0 = __builtin_amdgcn_mfma_f32_32x32x2f32(a4.x, b0[0], acc0, 0, 0, 0); acc1 = __builtin_amdgcn_mfma_f32_32x32x2f32(a4.x, b1[0], acc1, 0, 0, 0);
            acc0 = __builtin_amdgcn_mfma_f32_32x32x2f32(a4.y, b0[1], acc0, 0, 0, 0); acc1 = __builtin_amdgcn_mfma_f32_32x32x2f32(a4.y, b1[1], acc1, 0, 0, 0);
            acc0 = __builtin_amdgcn_mfma_f32_32x32x2f32(a4.z, b0[2], acc0, 0, 0, 0); acc1 = __builtin_amdgcn_mfma_f32_32x32x2f32(a4.z, b1[2], acc1, 0, 0, 0);
            acc0 = __builtin_amdgcn_mfma_f32_32x32x2f32(a4.w, b0[3], acc0, 0, 0, 0); acc1 = __builtin_amdgcn_mfma_f32_32x32x2f32(a4.w, b1[3], acc1, 0, 0, 0);
        }
        __syncthreads();
        float* tp = smem + (half * 4 + wq) * (32 * 65);
#pragma unroll
        for (int q = 0; q < 16; ++q) { const int row = (q & 3) + 8 * (q >> 2) + 4 * hk; tp[row * 65 + i] = acc0[q]; tp[row * 65 + 32 + i] = acc1[q]; }
        __syncthreads();
        if (tid < 64) {
            const int hh = tid >> 5, rr = tid & 31, r = bu * 64 + hh * 32 + rr;
            const float* t0 = smem + (hh * 4) * (32 * 65) + rr * 65;
            float lg[4], le[32];
#pragma unroll
            for (int e = 0; e < 32; ++e) le[e] = (t0[e] + t0[32 * 65 + e]) + (t0[2 * 32 * 65 + e] + t0[3 * 32 * 65 + e]);
#pragma unroll
            for (int g = 0; g < 4; ++g) lg[g] = (t0[32 + g] + t0[32 * 65 + 32 + g]) + (t0[2 * 32 * 65 + 32 + g] + t0[3 * 32 * 65 + 32 + g]);
            int grp = 0; float gm = lg[0];
#pragma unroll
            for (int g = 1; g < 4; ++g) if (lg[g] > gm) { gm = lg[g]; grp = g; }
            float zs = 0.f;
#pragma unroll
            for (int g = 0; g < 4; ++g) zs += expf(lg[g] - gm);
            const float pgrp = 1.0f / zs;
            float ev[8];
#pragma unroll
            for (int e = 0; e < 8; ++e) { ev[e] = (grp == 0) ? le[e] : (grp == 1) ? le[8 + e] : (grp == 2) ? le[16 + e] : le[24 + e]; }
            int i0 = 0; float v0 = ev[0];
#pragma unroll
            for (int e = 1; e < 8; ++e) if (ev[e] > v0) { v0 = ev[e]; i0 = e; }
            int i1 = -1; float v1 = -INFINITY;
#pragma unroll
            for (int e = 0; e < 8; ++e) if (e != i0 && ev[e] > v1) { v1 = ev[e]; i1 = e; }
            const float e1 = expf(v1 - v0);
            const float g0 = pgrp / (1.0f + e1), g1 = pgrp * e1 / (1.0f + e1);
            p.eid[r * 2 + 0] = grp * 8 + i0; p.eid[r * 2 + 1] = grp * 8 + i1;
            p.gate[r * 2 + 0] = g0; p.gate[r * 2 + 1] = g1;
        }
    }
}

__device__ __forceinline__ void ph_sort(const Params& p, int l, int bid, int* smem) {
    if (bid != 0) return;
    const int tid = otid(), lane = tid & 63, wid = tid >> 6;
    const int ntok = (l < DEPTH - 1) ? R : NLAT;
    const int nch = ntok / 64;
    int* cnt = smem;
    int* pst = smem + 136 * 32;
    int* tot = pst + 32;
    for (int i = tid; i < NSLOT; i += NTH) p.slot_tok[i] = -1;
    for (int c = wid; c < nch; c += NWV) {
        const int t = c * 64 + lane;
        const int e0 = p.eid[t * 2], e1 = p.eid[t * 2 + 1];
        for (int e = 0; e < 32; ++e) {
            const unsigned long long mk = __ballot(e0 == e || e1 == e);
            if (lane == 0) cnt[c * 32 + e] = __popcll(mk);
        }
    }
    __threadfence_block();
    __syncthreads();
    if (tid < 32) {
        int run = 0;
        for (int c = 0; c < nch; ++c) { const int v = cnt[c * 32 + tid]; cnt[c * 32 + tid] = run; run += v; }
        tot[tid] = run;
    }
    __syncthreads();
    if (tid == 0) {
        int ps = 0;
        for (int e = 0; e < 32; ++e) { pst[e] = ps; ps += (tot[e] + 255) / 256 * 256; }
        p.tile_e[NTILE] = ps / 256;
        int e = 0;
        for (int b = 0; b < NTILE; ++b) {
            const int s = b * 256;
            while (e < 32 && s >= pst[e] + (tot[e] + 255) / 256 * 256) ++e;
            p.tile_e[b] = (e < 32) ? e : -1;
        }
    }
    __syncthreads();
    for (int c = wid; c < nch; c += NWV) {
        const int t = c * 64 + lane;
        const int e0 = p.eid[t * 2], e1 = p.eid[t * 2 + 1];
        for (int e = 0; e < 32; ++e) {
            const unsigned long long mk = __ballot(e0 == e || e1 == e);
            const int rank = __popcll(mk & ((1ull << lane) - 1ull));
            if (e0 == e || e1 == e) {
                const int slot = pst[e] + cnt[c * 32 + e] + rank;
                p.slot_tok[slot] = t;
                p.slot_of[t * 2 + (e1 == e ? 1 : 0)] = slot;
            }
        }
    }
}

__device__ __forceinline__ void ph_gather(const Params& p, int bid, int nb) {
    const int tid = otid(), lane = tid & 63, wid = tid >> 6;
    const int nslots = p.tile_e[NTILE] * 256;
    for (int s0 = bid * NWV + wid; s0 < nslots; s0 += nb * NWV) {
        const int src = p.slot_tok[s0];
        u32x4* d = (u32x4*)(p.xs + (long)s0 * D);
        if (src >= 0) { const u32x4* sp = (const u32x4*)(p.hb + (long)src * D);
#pragma unroll
            for (int i = 0; i < 4; ++i) d[i * 64 + lane] = sp[i * 64 + lane]; }
        else { const u32x4 z = {0u, 0u, 0u, 0u};
#pragma unroll
            for (int i = 0; i < 4; ++i) d[i * 64 + lane] = z; }
    }
}

__device__ __forceinline__ void ph_post2(const Params& p, int l, int bid, int nb) {
    const int tid = otid(), lane = tid & 63, wid = tid >> 6;
    const int nrows = (l < DEPTH - 1) ? R : NLAT;
    for (int r = bid * NWV + wid; r < nrows; r += nb * NWV) {
        const float* mv = p.modv + ((long)l * 3 + mod_row(r)) * 6 * D;
        const int s0 = p.slot_of[r * 2], s1 = p.slot_of[r * 2 + 1];
        const float g0 = p.gate[r * 2], g1 = p.gate[r * 2 + 1];
        Row x, y0, y1; row_load(x, p.xc + (long)r * D, lane); row_load(y0, p.Ys + (long)s0 * D, lane); row_load(y1, p.Ys + (long)s1 * D, lane);
#pragma unroll
        for (int i = 0; i < 8; ++i) {
            const float4 g = ld4(mv + 5 * D + (i * 64 + lane) * 4);
            x.v[i].x = ALPHA * x.v[i].x + g.x * (g0 * y0.v[i].x + g1 * y1.v[i].x); x.v[i].y = ALPHA * x.v[i].y + g.y * (g0 * y0.v[i].y + g1 * y1.v[i].y);
            x.v[i].z = ALPHA * x.v[i].z + g.z * (g0 * y0.v[i].z + g1 * y1.v[i].z); x.v[i].w = ALPHA * x.v[i].w + g.w * (g0 * y0.v[i].w + g1 * y1.v[i].w);
        }
        float mean, rstd; row_stats(x, mean, rstd);
        row_affine(x, mean, rstd, p.ln2_g + l * D, p.ln2_b + l * D, lane);
        if (l == DEPTH - 1) row_store(x, p.out + (long)r * D, lane);
        else row_store(x, p.xc + (long)r * D, lane);
    }
}

constexpr int PH_PER_LAYER = 15, N_PHASES = 1 + DEPTH * PH_PER_LAYER;
constexpr int LDS_MAIN = 128 * 1024, LDS_BYTES = LDS_MAIN + 256;

__global__ void __launch_bounds__(NTH, 2) fwd(Params p) {
    extern __shared__ __attribute__((aligned(16))) unsigned char lds_raw[];
    float* smem = (float*)lds_raw;
    LAS unsigned char* ldsp = (LAS unsigned char*)lds_raw;
    const int bid = blockIdx.x, nb = gridDim.x;
    const int vcu = (nb % 8 == 0) ? (bid % 8) * (nb / 8) + bid / 8 : bid;
#if ONE_LAUNCH
    if (threadIdx.x == 0) *(uint4*)(lds_raw + LDS_MAIN) = make_uint4(0u, 0u, 0u, 0u);
    __syncthreads();
    XcdBarrier bar = xcd_barrier_post(p.bar, (volatile LAS unsigned*)(ldsp + LDS_MAIN));
#define SEAM(k) do { if ((k) + 1 < p.ph_hi) xcd_barrier(bar); } while (0)
#else
#define SEAM(k) do { } while (0)
#endif
#define IN(k) (p.ph_lo <= (k) && (k) < p.ph_hi)
    if (IN(0)) { ph_prologue(p, bid, nb, smem); if (DUPMASK & 1) { __syncthreads(); ph_prologue(p, bid, nb, smem); } SEAM(0); }
    for (int l = 0; l < DEPTH; ++l) {
        const int k0 = 1 + l * PH_PER_LAYER;
        const int mrows = (l < DEPTH - 1) ? R : NLAT;
        if (IN(k0 + 0)) { ph_lnmod(p, l, bid, nb); if (DUPMASK & 16) ph_lnmod(p, l, bid, nb); SEAM(k0 + 0); }
        if (IN(k0 + 1)) {
            pg8::Gemm g{p.hb, p.WinT + (long)l * INP * D, R, INP, D}; pg8::StaticOrder S; S.init(R, INP, nb, bid);
            pg8::EpiF32 E{p.P, INC, INC};
            pg8::gemm_phase(ldsp, g, S, E); if (DUPMASK & 2) pg8::gemm_phase(ldsp, g, S, E);
            if (l == 0) {
                const int rem = ((R / 256) * (INP / 256)) % nb;
                if (rem > 0 && bid >= rem) conv_rest(p, bid - rem, nb - rem, smem);
                else if (rem == 0) conv_rest(p, bid, nb, smem);
            }
            SEAM(k0 + 1);
        }
        if (IN(k0 + 2)) { ph_prep(p, l, bid, nb); if (DUPMASK & 16) ph_prep(p, l, bid, nb); SEAM(k0 + 2); }
        if (IN(k0 + 3)) {
            { pg8::Gemm g{p.cqn, p.WuqT + (long)l * 768 * 384, R, 768, 384}; pg8::StaticOrder S; S.init(R, 768, nb, bid); pg8::EpiBf16 E{p.Q2b, 768}; pg8::gemm_phase(ldsp, g, S, E); if (DUPMASK & 2) pg8::gemm_phase(ldsp, g, S, E); }
            { pg8::Gemm g{p.ckvn, p.WukvT + (long)l * 1024 * 256, R, 512, 256}; pg8::StaticOrder S; S.init(R, 512, nb, bid); pg8::EpiBf16 E{p.Kn, 512}; pg8::gemm_phase(ldsp, g, S, E); if (DUPMASK & 2) pg8::gemm_phase(ldsp, g, S, E); }
            { pg8::Gemm g{p.WukvT + (long)l * 1024 * 256 + 512 * 256, p.ckvn, 512, R, 256}; pg8::StaticOrder S; S.init(512, R, nb, bid); pg8::EpiBf16 E{p.VtM, R}; pg8::gemm_phase(ldsp, g, S, E); if (DUPMASK & 2) pg8::gemm_phase(ldsp, g, S, E); }
            SEAM(k0 + 3);
        }
        if (IN(k0 + 4)) { ph_mixers(p, l, bid, nb, smem, ldsp); if (DUPMASK & 4) { __syncthreads(); ph_mixers(p, l, bid, nb, smem, ldsp); } SEAM(k0 + 4); }
        if (IN(k0 + 5)) { ph_scan2(p, bid, nb); SEAM(k0 + 5); }
        if (IN(k0 + 6)) { ph_scan3(p, l, bid, nb, ldsp); if (DUPMASK & 8) { __syncthreads(); ph_scan3(p, l, bid, nb, ldsp); } SEAM(k0 + 6); }
        if (IN(k0 + 7)) {
            pg8::Gemm g{p.mix, p.WoutT + (long)l * D * D, mrows, D, D}; pg8::StaticOrder S; S.init(mrows, D, nb, bid);
            pg8::EpiF32 E{p.ob, D, D};
            pg8::gemm_phase(ldsp, g, S, E); if (DUPMASK & 2) pg8::gemm_phase(ldsp, g, S, E); SEAM(k0 + 7);
        }
        if (IN(k0 + 8)) { ph_post1(p, l, bid, nb); SEAM(k0 + 8); }
        if (IN(k0 + 9)) { ph_router(p, l, bid, nb, smem); SEAM(k0 + 9); }
        if (IN(k0 + 10)) { ph_sort(p, l, bid, (int*)smem); if (bid > 0) conv_moe(p, l, bid - 1, nb - 1, smem); SEAM(k0 + 10); }
        if (IN(k0 + 11)) { ph_gather(p, bid, nb); if (DUPMASK & 16) ph_gather(p, bid, nb); SEAM(k0 + 11); }
        if (IN(k0 + 12)) {
            pg8::Gemm g{p.xs, p.W13T + (long)l * NEXP * 1024 * D, NSLOT, 1024, D};
            pg8::MoeOrder S{4, p.tile_e[NTILE] * 4, nb, vcu, (size_t)1024 * D * 2, p.tile_e};
            pg8::EpiSwiglu E{p.act, FF};
            pg8::gemm_phase(ldsp, g, S, E); if (DUPMASK & 2) pg8::gemm_phase(ldsp, g, S, E); SEAM(k0 + 12);
        }
        if (IN(k0 + 13)) {
            pg8::Gemm g{p.act, p.W2T + (long)l * NEXP * D * FF, NSLOT, D, FF};
            pg8::MoeOrder S{8, p.tile_e[NTILE] * 8, nb, vcu, (size_t)D * FF * 2, p.tile_e};
            pg8::EpiF32 E{p.Ys, D, D};
            pg8::gemm_phase(ldsp, g, S, E); if (DUPMASK & 2) pg8::gemm_phase(ldsp, g, S, E); SEAM(k0 + 13);
        }
        if (IN(k0 + 14)) { ph_post2(p, l, bid, nb); SEAM(k0 + 14); }
    }
}

static inline size_t al256(size_t v) { return (v + 255) & ~(size_t)255; }

extern "C" void kernel_launch(void* const* d_in, const int* in_sizes, int n_in, void* d_out, int out_size, void* d_ws, size_t ws_size, hipStream_t stream) {
    static int grid = 0;
    if (grid == 0) {
        int dev = 0, cus = 0, per_cu = 0;
        hipGetDevice(&dev);
        hipDeviceGetAttribute(&cus, hipDeviceAttributeMultiprocessorCount, dev);
        hipFuncSetAttribute((const void*)fwd, hipFuncAttributeMaxDynamicSharedMemorySize, LDS_BYTES);
        hipOccupancyMaxActiveBlocksPerMultiprocessor(&per_cu, (const void*)fwd, NTH, LDS_BYTES);
        (void)hipGetLastError();
        if (cus <= 0) cus = 256;
        grid = cus;
        if (per_cu < 1) fprintf(stderr, "kernel_launch: occupancy query reports %d\n", per_cu);
    }
    Params p{};
    const float* const* in = (const float* const*)d_in;
    p.x = in[0]; p.c = in[1]; p.ctx = in[2]; p.c_ctx = in[3]; p.w_ada = in[4]; p.b_ada = in[5]; p.w_in = in[6]; p.swa_sink = in[7];
    p.ret_s = in[8]; p.ret_gn = in[9]; p.q_norm = in[10]; p.kv_norm = in[11]; p.w_uq = in[12]; p.w_ukv = in[13]; p.lb_logits = in[14];
    p.hgrn_gn = in[15]; p.w_out = in[16]; p.ln1_g = in[17]; p.ln1_b = in[18]; p.w_rg = in[19]; p.w_re = in[20]; p.w1 = in[21]; p.w3 = in[22];
    p.w2 = in[23]; p.ln2_g = in[24]; p.ln2_b = in[25];
    p.out = (float*)d_out;
    unsigned char* ws = (unsigned char*)d_ws; size_t off = 0;
    auto carve = [&](size_t bytes) { unsigned char* q = ws + off; off = al256(off + bytes); return q; };
    p.bar = (unsigned*)carve(XCD_BAR_WORDS * 4);
    p.modv = (float*)carve((size_t)DEPTH * 3 * 6 * D * 4);
    p.xc = (float*)carve((size_t)R * D * 4);
    p.hb = (bf16_t*)carve((size_t)R * D * 2);
    p.P = (float*)carve((size_t)R * INC * 4);
    p.Ys = p.P;
    p.cqn = (bf16_t*)carve((size_t)R * 384 * 2);
    p.ckvn = (bf16_t*)carve((size_t)R * 256 * 2);
    p.Q2b = (bf16_t*)carve((size_t)R * 768 * 2);
    p.Kn = (bf16_t*)carve((size_t)R * 512 * 2);
    p.VtM = (bf16_t*)carve((size_t)512 * R * 2);
    p.Krb = (bf16_t*)carve((size_t)R * 64 * 2);
    p.sqb = (bf16_t*)carve((size_t)R * 512 * 2);
    p.skb = (bf16_t*)carve((size_t)R * 256 * 2);
    p.svT = (bf16_t*)carve((size_t)256 * R * 2);
    p.sst = (float*)carve((size_t)32 * NCHK * 16384 * 4);
    p.sA = (float*)carve((size_t)32 * NCHK * 128 * 4);
    p.mix = (bf16_t*)carve((size_t)R * D * 2);
    p.ob = p.sst;
    p.xs = (bf16_t*)carve((size_t)NSLOT * D * 2);
    p.act = (bf16_t*)carve((size_t)NSLOT * FF * 2);
    p.gate = (float*)carve((size_t)R * 2 * 4);
    p.eid = (int*)carve((size_t)R * 2 * 4);
    p.slot_of = (int*)carve((size_t)R * 2 * 4);
    p.slot_tok = (int*)carve((size_t)NSLOT * 4);
    p.tile_e = (int*)carve((size_t)(NTILE + 1) * 4);
    p.WinT = (bf16_t*)carve((size_t)DEPTH * INP * D * 2);
    p.WoutT = (bf16_t*)carve((size_t)DEPTH * D * D * 2);
    p.WuqT = (bf16_t*)carve((size_t)DEPTH * 768 * 384 * 2);
    p.WukvT = (bf16_t*)carve((size_t)DEPTH * 1024 * 256 * 2);
    p.W13T = (bf16_t*)carve((size_t)DEPTH * NEXP * 1024 * D * 2);
    p.W2T = (bf16_t*)carve((size_t)DEPTH * NEXP * D * FF * 2);
    if (off > ws_size) { fprintf(stderr, "kernel_launch: workspace too small: need %zu have %zu\n", off, ws_size); return; }
    hipMemsetAsync(p.bar, 0, XCD_BAR_WORDS * 4, stream);
#if ONE_LAUNCH
    p.ph_lo = 0; p.ph_hi = N_PHASES;
    hipLaunchKernelGGL(fwd, dim3(grid), dim3(NTH), LDS_BYTES, stream, p);
#else
    for (int k = 0; k < N_PHASES; ++k) {
        p.ph_lo = k; p.ph_hi = k + 1;
        hipLaunchKernelGGL(fwd, dim3(grid), dim3(NTH), LDS_BYTES, stream, p);
    }
#endif
}
```

```cpp
#include <hip/hip_runtime.h>
#include <cstdio>
#include <cstdint>

#ifndef DIAG_NAIVE
#define DIAG_NAIVE 0
#endif
#ifndef DUPMASK
#define DUPMASK 0
#endif
#ifndef ONE_LAUNCH
#define ONE_LAUNCH 1
#endif

constexpr int D = 2048, NBATCH = 2, T = 4096, LCTX = 256, DEPTH = 2;
constexpr int NLAT = NBATCH * T, NCTX = NBATCH * LCTX, R = NLAT + NCTX;
constexpr int INC = 6208;
constexpr int SQ = 0, SK = 512, SV = 768, RQ = 1024, RK = 1536, RV = 2048, RG = 2560, CQ = 3072, CKV = 3456, KR = 3584,
              HQ = 3648, HFF = 4160, HFB = 4672, HI = 5184, HG = 5696;
constexpr int NEXP = 32, FF = 512;
constexpr int NSLOT = 25600, NTILE = NSLOT / 256;
constexpr int INP = 6400;
constexpr float EPS = 1e-6f;
constexpr float ALPHA = 1.41421356237309515f;
constexpr int NTH = 512, NWV = 8;

typedef float f32x16 __attribute__((ext_vector_type(16)));
typedef unsigned short bf16_t;
typedef short bf16x8 __attribute__((ext_vector_type(8)));
typedef float f32x4 __attribute__((ext_vector_type(4)));
typedef unsigned u32x4 __attribute__((ext_vector_type(4)));
typedef unsigned u32x2 __attribute__((ext_vector_type(2)));

#define XB_TMO      128
#define XB_XCNT(j)  (256  + 64 * (j))
#define XB_XSUB(j)  (1280 + 64 * (j))
#define XB_XGEN(j)  (2304 + 64 * (j))
#define XB_TOP      3328
#define XB_TOPGEN   3392
#define XCD_BAR_WORDS 3456
#define XB_SPIN_CAP (1u << 18)
#define LAS __attribute__((address_space(3)))

__device__ __forceinline__ unsigned xb_ld(unsigned* p)              { return __hip_atomic_load(p, __ATOMIC_RELAXED, __HIP_MEMORY_SCOPE_AGENT); }
__device__ __forceinline__ unsigned xb_add(unsigned* p, unsigned v) { return __hip_atomic_fetch_add(p, v, __ATOMIC_RELAXED, __HIP_MEMORY_SCOPE_AGENT); }
__device__ __forceinline__ unsigned xb_xcc_id() { return (unsigned)__builtin_amdgcn_s_getreg((3 << 11) | 20) & 0xFu; }
#define XB_SPIN(cond, bar) do { unsigned _sp = 0; while (cond) { __builtin_amdgcn_s_sleep(1); \
    if ((++_sp & 255u) == 0u) { if (xb_ld(&(bar)[XB_TMO])) break; if (_sp > XB_SPIN_CAP) { atomicAdd(&(bar)[XB_TMO], 1u); break; } } } } while (0)

struct XcdBarrier { unsigned* bar; unsigned x; volatile LAS unsigned* st; };

__device__ __forceinline__ XcdBarrier xcd_barrier_post(unsigned* bar, volatile LAS unsigned* st) {
    XcdBarrier b; b.bar = bar; b.x = xb_xcc_id(); b.st = st;
    if (threadIdx.x == 0) (void)xb_add(&bar[XB_XCNT(b.x)], 1u);
    return b;
}
__device__ __forceinline__ void xcd_barrier_complete(unsigned* bar, unsigned x, unsigned& nloc, unsigned& nx) {
    const unsigned G = gridDim.x * gridDim.y * gridDim.z;
    unsigned sum, cnt, mine, sp = 0u;
    for (;;) {
        sum = 0u; cnt = 0u; mine = 0u;
#pragma unroll
        for (unsigned j = 0; j < 16; ++j) { const unsigned c = xb_ld(&bar[XB_XCNT(j)]); sum += c; cnt += (c > 0u) ? 1u : 0u; mine = (j == x) ? c : mine; }
        if (sum == G) break;
        __builtin_amdgcn_s_sleep(1);
        if ((++sp & 255u) == 0u) { if (xb_ld(&bar[XB_TMO])) break; if (sp > XB_SPIN_CAP) { atomicAdd(&bar[XB_TMO], 1u); break; } }
    }
    nloc = mine > 0u ? mine : 1u; nx = cnt > 0u ? cnt : 1u;
}
__device__ __forceinline__ void xcd_barrier(const XcdBarrier& b) {
    asm volatile("s_waitcnt vmcnt(0)" ::: "memory");
    __syncthreads();
    if (threadIdx.x == 0) {
        unsigned* bar = b.bar;
        __builtin_amdgcn_s_waitcnt(0);
        unsigned nloc = b.st[0], nx = b.st[1];
        if (nloc == 0u) { xcd_barrier_complete(bar, b.x, nloc, nx); b.st[0] = nloc; b.st[1] = nx; }
        const unsigned old = xb_add(&bar[XB_XSUB(b.x)], 1u);
        const unsigned gen = old / nloc;
        if (old + 1u == (gen + 1u) * nloc) {
            __builtin_amdgcn_fence(__ATOMIC_RELEASE, "agent");
            asm volatile("s_waitcnt vmcnt(0)" ::: "memory");
            const unsigned og = xb_add(&bar[XB_TOP], 1u);
            const unsigned tg = og / nx;
            if (og + 1u == (tg + 1u) * nx) xb_add(&bar[XB_TOPGEN], 1u);
            else XB_SPIN(xb_ld(&bar[XB_TOPGEN]) == tg, bar);
            __builtin_amdgcn_fence(__ATOMIC_ACQUIRE, "agent");
            xb_add(&bar[XB_XGEN(b.x)], 1u);
            asm volatile("s_waitcnt vmcnt(0)" ::: "memory");
        } else {
            XB_SPIN(xb_ld(&bar[XB_XGEN(b.x)]) == gen, bar);
            __builtin_amdgcn_fence(__ATOMIC_ACQUIRE, "agent");
            asm volatile("s_waitcnt vmcnt(0)" ::: "memory");
        }
    }
    __syncthreads();
}

struct Params {
    const float *x, *c, *ctx, *c_ctx, *w_ada, *b_ada, *w_in, *swa_sink, *ret_s, *ret_gn, *q_norm, *kv_norm, *w_uq, *w_ukv,
                *lb_logits, *hgrn_gn, *w_out, *ln1_g, *ln1_b, *w_rg, *w_re, *w1, *w3, *w2, *ln2_g, *ln2_b;
    float* out;
    unsigned* bar;
    float *modv, *xc, *P, *sst, *sA, *ob, *Ys, *gate;
    bf16_t *hb, *cqn, *ckvn, *mix, *xs, *act, *Q2b, *Kn, *VtM, *Krb, *sqb, *skb, *svT;
    bf16_t *WinT, *WoutT, *WuqT, *WukvT, *W13T, *W2T;
    int *eid, *slot_of, *slot_tok, *tile_e, *cnt;
    int ph_lo, ph_hi;
};

__device__ __forceinline__ int otid() { int t = threadIdx.x; asm volatile("" : "+v"(t)); return t; }
__device__ __forceinline__ float wsum(float v) {
#pragma unroll
    for (int o = 32; o > 0; o >>= 1) v += __shfl_xor(v, o);
    return v;
}
__device__ __forceinline__ float siluf(float v) { return v / (1.0f + expf(-v)); }
__device__ __forceinline__ float sigmf(float v) { return 1.0f / (1.0f + expf(-v)); }
__device__ __forceinline__ int mod_row(int r) { return r < NLAT ? (r >= T ? 1 : 0) : 2; }
#define XSRC(p, l, r) ((l) == 0 ? ((r) < NLAT ? (p).x + (long)(r) * D : (p).ctx + (long)((r) - NLAT) * D) : (p).xc + (long)(r) * D)
__device__ __forceinline__ float4 ld4(const float* p) { return *(const float4*)p; }
__device__ __forceinline__ bf16_t f2bf(float f) { unsigned u = __float_as_uint(f); u += 0x7FFFu + ((u >> 16) & 1u); return (bf16_t)(u >> 16); }
__device__ __forceinline__ unsigned cvt_pk_bf16(float lo, float hi) { unsigned r; asm volatile("v_cvt_pk_bf16_f32 %0, %1, %2" : "=v"(r) : "v"(lo), "v"(hi)); return r; }
__device__ __forceinline__ void st4(float* p, float4 v) { *(float4*)p = v; }

namespace pg8 {
constexpr int BM = 256, BK = 64, HALF = 128, HTB = HALF * BK * 2, STAGE_BYTES = 8 * HTB, NXCD = 8, WGM = 8;
__host__ __device__ __forceinline__ int lds_byte(int r, int c) { const int st = (r >> 4) * 2 + (c >> 5), rr = r & 15, cc = c & 31, ob = rr * 64 + cc * 2; return st * 1024 + (ob ^ (((ob >> 9) & 1) << 5)); }
__host__ __device__ __forceinline__ void stage_rc(int b, int& R, int& C) { const int st = b / 1024, sb = b % 1024, swz = sb ^ (((sb >> 9) & 1) << 5); R = (st >> 1) * 16 + swz / 64; C = (st & 1) * 32 + (swz % 64) / 2; }
struct Unit { int pm, pn; };
struct Gemm { const bf16_t* A; const bf16_t* Bt; int M, N, K; };
struct StaticOrder {
    int nM, nN, nwg, G, c;
    __device__ void init(int M, int N, int G_, int c_) { nM = M / BM; nN = N / BM; nwg = nM * nN; G = G_; c = c_; }
    __device__ bool next(int i, Unit& u) const {
        const long L = (long)i * G + c; if (L >= nwg) return false;
        int wgid = (int)L; { const int q = nwg / NXCD, r = nwg % NXCD, xcd = wgid % NXCD, off = wgid / NXCD; wgid = (xcd < r ? xcd * (q + 1) : r * (q + 1) + (xcd - r) * q) + off; }
        const int nig = WGM * nN, gid = wgid / nig, fm = gid * WGM, gsz = (nM - fm) < WGM ? (nM - fm) : WGM;
        u.pm = fm + ((wgid % nig) % gsz); u.pn = (wgid % nig) / gsz; return true;
    }
    __device__ __forceinline__ size_t boff(const Unit& u, size_t tstep) const { return (size_t)u.pn * tstep; }
};
struct MoeOrder {
    int npn, nunits, G, c; size_t estride; const int* tile_e;
    __device__ bool next(int i, Unit& u) const { const long L = (long)i * G + c; if (L >= nunits) return false; u.pm = (int)(L / npn); u.pn = (int)(L % npn); return true; }
    __device__ __forceinline__ size_t boff(const Unit& u, size_t tstep) const { return (size_t)tile_e[u.pm] * estride + (size_t)u.pn * tstep; }
};
struct EpiF32 {
    float* C; int ldc; int ncols;
    __device__ __forceinline__ void operator()(const f32x4 (&acc)[2][2][4][2], const Unit& u, int wr, int wc, int fr, int fq) const {
        const int row0 = u.pm * BM + wr * 64 + fr, col0 = u.pn * BM + wc * 32 + 4 * fq;
#pragma unroll
        for (int ai = 0; ai < 2; ++ai)
#pragma unroll
            for (int m = 0; m < 4; ++m) { float* rowp = C + (size_t)(row0 + ai * HALF + m * 16) * ldc + col0;
#pragma unroll
                for (int bj = 0; bj < 2; ++bj)
#pragma unroll
                    for (int n = 0; n < 2; ++n) if (col0 + bj * HALF + n * 16 < ncols) *(f32x4*)(rowp + bj * HALF + n * 16) = acc[ai][bj][m][n]; }
    }
};
struct EpiBf16 {
    bf16_t* O; int ldc;
    __device__ __forceinline__ void operator()(const f32x4 (&acc)[2][2][4][2], const Unit& u, int wr, int wc, int fr, int fq) const {
        const int row0 = u.pm * BM + wr * 64 + fr, col0 = u.pn * BM + wc * 32 + 4 * fq;
#pragma unroll
        for (int ai = 0; ai < 2; ++ai)
#pragma unroll
            for (int m = 0; m < 4; ++m) { bf16_t* rowp = O + (size_t)(row0 + ai * HALF + m * 16) * ldc + col0;
#pragma unroll
                for (int bj = 0; bj < 2; ++bj)
#pragma unroll
                    for (int n = 0; n < 2; ++n) { const f32x4 v = acc[ai][bj][m][n]; u32x2 w; w.x = cvt_pk_bf16(v[0], v[1]); w.y = cvt_pk_bf16(v[2], v[3]); *(u32x2*)(rowp + bj * HALF + n * 16) = w; } }
    }
};
struct EpiSwiglu {
    bf16_t* O; int ldc;
    __device__ __forceinline__ void operator()(const f32x4 (&acc)[2][2][4][2], const Unit& u, int wr, int wc, int fr, int fq) const {
        const int row0 = u.pm * BM + wr * 64 + fr, col0 = u.pn * HALF + wc * 32 + 4 * fq;
#pragma unroll
        for (int ai = 0; ai < 2; ++ai)
#pragma unroll
            for (int m = 0; m < 4; ++m) { bf16_t* rowp = O + (size_t)(row0 + ai * HALF + m * 16) * ldc + col0;
#pragma unroll
                for (int n = 0; n < 2; ++n) { const f32x4 g = acc[ai][0][m][n], v = acc[ai][1][m][n]; float r[4];
#pragma unroll
                    for (int j = 0; j < 4; ++j) r[j] = g[j] / (1.0f + __expf(-g[j])) * v[j];
                    u32x2 w; w.x = cvt_pk_bf16(r[0], r[1]); w.y = cvt_pk_bf16(r[2], r[3]); *(u32x2*)(rowp + n * 16) = w; } }
    }
};
template <class Epi, class Sched>
__device__ __forceinline__ void gemm_phase(LAS unsigned char* lds, const Gemm g, const Sched& S, const Epi& E) {
    const int tid = otid(), wid = __builtin_amdgcn_readfirstlane(tid >> 6), lane = tid & 63, wr = wid >> 2, wc = wid & 3, fr = lane & 15, fq = lane >> 4;
    const int K = g.K, nt = K / BK;
    unsigned voffA[2], voffB[2];
#pragma unroll
    for (int i = 0; i < 2; ++i) { int R_, C_; stage_rc(tid * 16 + i * 8192, R_, C_); voffA[i] = (unsigned)(R_ * K + C_) * 2u; voffB[i] = voffA[i]; }
    const size_t kstep = (size_t)(BK * 2);
    const size_t hstep = (size_t)HALF * K * 2;
    const size_t tstep = 2 * hstep;
    const unsigned ldsw = (unsigned)wid * 1024u;
    const int aoff = lds_byte(wr * 64 + fr, fq * 8), boff = lds_byte(wc * 32 + fr, fq * 8);
#define PG8_SA(b, h) (((b) * 2 + (h)) * HTB)
#define PG8_SB(b, h) ((4 + (b) * 2 + (h)) * HTB)
#define PG8_STAGE(bufoff, gbase, voff) do { _Pragma("unroll") for (int _i = 0; _i < 2; ++_i) \
        __builtin_amdgcn_global_load_lds((const unsigned*)((const char*)(gbase) + (voff)[_i]), (LAS unsigned*)(lds + (bufoff) + ldsw + _i * 8192), 16, 0, 0); } while (0)
#define PG8_LDA(dst, b, h) do { _Pragma("unroll") for (int m = 0; m < 4; ++m) _Pragma("unroll") for (int k = 0; k < 2; ++k) dst[m][k] = *(const LAS bf16x8*)(lds + PG8_SA(b, h) + aoff + m * 2048 + k * 1024); } while (0)
#define PG8_LDB(dst, b, h) do { _Pragma("unroll") for (int n = 0; n < 2; ++n) _Pragma("unroll") for (int k = 0; k < 2; ++k) dst[n][k] = *(const LAS bf16x8*)(lds + PG8_SB(b, h) + boff + n * 2048 + k * 1024); } while (0)
#define PG8_MMA(ai, bj, At, Bt) do { __builtin_amdgcn_s_setprio(1); _Pragma("unroll") for (int m = 0; m < 4; ++m) _Pragma("unroll") for (int n = 0; n < 2; ++n) _Pragma("unroll") for (int k = 0; k < 2; ++k) \
        acc[ai][bj][m][n] = __builtin_amdgcn_mfma_f32_16x16x32_bf16(Bt[n][k], At[m][k], acc[ai][bj][m][n], 0, 0, 0); __builtin_amdgcn_s_setprio(0); } while (0)
#define PG8_WAIT_V(n) asm volatile("s_waitcnt vmcnt(" #n ")" ::: "memory")
#define PG8_WAIT_L(n) asm volatile("s_waitcnt lgkmcnt(" #n ")" ::: "memory")
#define PG8_BAR __builtin_amdgcn_s_barrier()
#define PG8_SCHED __builtin_amdgcn_sched_barrier(0)
    Unit cur, nxt; int ui = 0;
    if (!S.next(0, cur)) return;
    f32x4 acc[2][2][4][2];
#pragma unroll
    for (int a = 0; a < 2; ++a)
#pragma unroll
        for (int b = 0; b < 2; ++b)
#pragma unroll
            for (int m = 0; m < 4; ++m)
#pragma unroll
                for (int n = 0; n < 2; ++n) acc[a][b][m][n] = (f32x4){0.f, 0.f, 0.f, 0.f};
    bf16x8 At[4][2], B0[2][2], B1[2][2];
    const char* cA = (const char*)g.A + (size_t)cur.pm * tstep; const char* cB = (const char*)g.Bt + S.boff(cur, tstep);
    PG8_STAGE(PG8_SB(0, 0), cB, voffB); PG8_STAGE(PG8_SA(0, 0), cA, voffA); PG8_STAGE(PG8_SB(0, 1), cB + hstep, voffB); PG8_STAGE(PG8_SA(0, 1), cA + hstep, voffA);
    if (wr == 1) PG8_BAR;
    PG8_WAIT_V(4); PG8_BAR;
    PG8_STAGE(PG8_SB(1, 0), cB + kstep, voffB); PG8_STAGE(PG8_SA(1, 0), cA + kstep, voffA); PG8_STAGE(PG8_SB(1, 1), cB + hstep + kstep, voffB);
    PG8_WAIT_V(6); PG8_BAR;
    for (;;) {
        const bool has_next = S.next(ui + 1, nxt);
        const char* nA = has_next ? (const char*)g.A + (size_t)nxt.pm * tstep : cA; const char* nB = has_next ? (const char*)g.Bt + S.boff(nxt, tstep) : cB;
        for (int t = 0; t < nt; t += 2) {
            const bool last = (t == nt - 2);
            const char* a1 = cA + (size_t)(t + 1) * kstep;
            const char* a2 = last ? nA : cA + (size_t)(t + 2) * kstep; const char* b2 = last ? nB : cB + (size_t)(t + 2) * kstep;
            const char* a3 = a2 + kstep; const char* b3 = b2 + kstep;
            PG8_LDB(B0, 0, 0); PG8_SCHED; PG8_LDA(At, 0, 0); PG8_STAGE(PG8_SA(1, 1), a1 + hstep, voffA);
            PG8_WAIT_L(8); PG8_BAR; PG8_WAIT_L(0); PG8_MMA(0, 0, At, B0); PG8_BAR; PG8_SCHED;
            PG8_LDB(B1, 0, 1); PG8_STAGE(PG8_SB(0, 0), b2, voffB);
            PG8_BAR; PG8_WAIT_L(0); PG8_MMA(0, 1, At, B1); PG8_BAR;
            PG8_LDA(At, 0, 1); PG8_STAGE(PG8_SA(0, 0), a2, voffA);
            PG8_BAR; PG8_WAIT_L(0); PG8_MMA(1, 0, At, B0); PG8_BAR; PG8_SCHED;
            PG8_STAGE(PG8_SB(0, 1), b2 + hstep, voffB);
            PG8_WAIT_V(6); PG8_BAR; PG8_MMA(1, 1, At, B1); PG8_BAR;
            PG8_LDB(B0, 1, 0); PG8_SCHED; PG8_LDA(At, 1, 0); PG8_STAGE(PG8_SA(0, 1), a2 + hstep, voffA);
            PG8_WAIT_L(8); PG8_BAR; PG8_WAIT_L(0); PG8_MMA(0, 0, At, B0); PG8_BAR; PG8_SCHED;
            PG8_LDB(B1, 1, 1); PG8_STAGE(PG8_SB(1, 0), b3, voffB);
            PG8_BAR; PG8_WAIT_L(0); PG8_MMA(0, 1, At, B1); PG8_BAR;
            PG8_LDA(At, 1, 1); PG8_STAGE(PG8_SA(1, 0), a3, voffA);
            PG8_BAR; PG8_WAIT_L(0); PG8_MMA(1, 0, At, B0); PG8_BAR; PG8_SCHED;
            PG8_STAGE(PG8_SB(1, 1), b3 + hstep, voffB);
            PG8_WAIT_V(6); PG8_BAR; PG8_MMA(1, 1, At, B1); PG8_BAR;
        }
        E(acc, cur, wr, wc, fr, fq);
        if (!has_next) break;
#pragma unroll
        for (int a = 0; a < 2; ++a)
#pragma unroll
            for (int b = 0; b < 2; ++b)
#pragma unroll
                for (int m = 0; m < 4; ++m)
#pragma unroll
                    for (int n = 0; n < 2; ++n) acc[a][b][m][n] = (f32x4){0.f, 0.f, 0.f, 0.f};
        cur = nxt; cA = nA; cB = nB; ++ui;
    }
    PG8_WAIT_V(0);
    if (wr == 0) PG8_BAR;
    PG8_BAR;
#undef PG8_SA
#undef PG8_SB
#undef PG8_STAGE
#undef PG8_LDA
#undef PG8_LDB
#undef PG8_MMA
#undef PG8_WAIT_V
#undef PG8_WAIT_L
#undef PG8_BAR
#undef PG8_SCHED
}
}

struct ConvDesc { const float* src; bf16_t* dst; int K, N, ldk, nblk, nmul, noff, nmat; long sstride, dstride; };
__device__ __forceinline__ void conv_wT(const ConvDesc& d, int bid, int nb, float* smem) {
    const int tid = otid();
    const int tk = d.K / 128, tn = d.N / 64, per = tk * tn;
    for (int u = bid; u < d.nmat * per; u += nb) {
        const int mat = u / per, t = u % per, kt = t / tn, ntl = t % tn;
        const float* s = d.src + (long)mat * d.sstride + (long)(kt * 128) * d.N + ntl * 64;
        __syncthreads();
#pragma unroll
        for (int ps = 0; ps < 4; ++ps) {
            const int kk = (tid >> 4) + ps * 32, n4 = (tid & 15) * 4;
            const float4 v = ld4(s + (long)kk * d.N + n4);
            smem[kk * 65 + n4 + 0] = v.x; smem[kk * 65 + n4 + 1] = v.y; smem[kk * 65 + n4 + 2] = v.z; smem[kk * 65 + n4 + 3] = v.w;
        }
        __syncthreads();
        const int n = tid >> 3, k16 = (tid & 7) * 16;
        u32x4 w0, w1;
        w0.x = cvt_pk_bf16(smem[(k16 + 0) * 65 + n], smem[(k16 + 1) * 65 + n]); w0.y = cvt_pk_bf16(smem[(k16 + 2) * 65 + n], smem[(k16 + 3) * 65 + n]);
        w0.z = cvt_pk_bf16(smem[(k16 + 4) * 65 + n], smem[(k16 + 5) * 65 + n]); w0.w = cvt_pk_bf16(smem[(k16 + 6) * 65 + n], smem[(k16 + 7) * 65 + n]);
        w1.x = cvt_pk_bf16(smem[(k16 + 8) * 65 + n], smem[(k16 + 9) * 65 + n]); w1.y = cvt_pk_bf16(smem[(k16 + 10) * 65 + n], smem[(k16 + 11) * 65 + n]);
        w1.z = cvt_pk_bf16(smem[(k16 + 12) * 65 + n], smem[(k16 + 13) * 65 + n]); w1.w = cvt_pk_bf16(smem[(k16 + 14) * 65 + n], smem[(k16 + 15) * 65 + n]);
        const int gn = ntl * 64 + n;
        const int drow = (d.nblk < 0) ? (((gn >> 7) & 1) * 512 + (gn >> 8) * 128 + (gn & 127)) : ((gn / d.nblk) * d.nmul + d.noff + gn % d.nblk);
        bf16_t* dp = d.dst + (long)mat * d.dstride + (long)drow * d.ldk + kt * 128 + k16;
        *(u32x4*)dp = w0; *(u32x4*)(dp + 8) = w1;
    }
}

__device__ __forceinline__ void conv_first(const Params& p, int bid, int nb, float* smem) {
    const ConvDesc c_in{p.w_in, p.WinT, D, INC, D, 1 << 30, 0, 0, 1, (long)D * INC, (long)INP * D};
    conv_wT(c_in, bid, nb, smem);
    const ConvDesc c_uq{p.w_uq, p.WuqT, 384, 768, 384, 1 << 30, 0, 0, 1, 384L * 768, 768L * 384};
    conv_wT(c_uq, bid, nb, smem);
    const ConvDesc c_ukv{p.w_ukv, p.WukvT, 128, 1024, 256, -1, 0, 0, 1, 128L * 1024, 1024L * 256};
    conv_wT(c_ukv, bid, nb, smem);
}
__device__ __forceinline__ void conv_rest(const Params& p, int bid, int nb, float* smem) {
    const ConvDesc c_out{p.w_out, p.WoutT, D, D, D, 1 << 30, 0, 0, DEPTH, (long)D * D, (long)D * D};
    conv_wT(c_out, bid, nb, smem);
    const ConvDesc c_in{p.w_in + (long)D * INC, p.WinT + (long)INP * D, D, INC, D, 1 << 30, 0, 0, DEPTH - 1, (long)D * INC, (long)INP * D};
    conv_wT(c_in, bid, nb, smem);
    const ConvDesc c_uq{p.w_uq + 384L * 768, p.WuqT + 768L * 384, 384, 768, 384, 1 << 30, 0, 0, DEPTH - 1, 384L * 768, 768L * 384};
    conv_wT(c_uq, bid, nb, smem);
    const ConvDesc c_ukv{p.w_ukv + 128L * 1024, p.WukvT + 1024L * 256, 128, 1024, 256, -1, 0, 0, DEPTH - 1, 128L * 1024, 1024L * 256};
    conv_wT(c_ukv, bid, nb, smem);
}
__device__ __forceinline__ void conv_w1(const Params& p, int l, int bid, int nb, float* smem) {
    const ConvDesc c_w1{p.w1 + (long)l * NEXP * D * FF, p.W13T + (long)l * NEXP * 1024 * D, D, FF, D, 128, 256, 0, NEXP, (long)D * FF, 1024L * D};
    conv_wT(c_w1, bid, nb, smem);
}
__device__ __forceinline__ void conv_w3(const Params& p, int l, int bid, int nb, float* smem) {
    const ConvDesc c_w3{p.w3 + (long)l * NEXP * D * FF, p.W13T + (long)l * NEXP * 1024 * D, D, FF, D, 128, 256, 128, NEXP, (long)D * FF, 1024L * D};
    conv_wT(c_w3, bid, nb, smem);
}
__device__ __forceinline__ void conv_w2(const Params& p, int l, int bid, int nb, float* smem) {
    const ConvDesc c_w2{p.w2 + (long)l * NEXP * FF * D, p.W2T + (long)l * NEXP * D * FF, FF, D, FF, 1 << 30, 0, 0, NEXP, (long)FF * D, (long)D * FF};
    conv_wT(c_w2, bid, nb, smem);
}
__device__ __forceinline__ bool light_deal(int nunits, int nb, int bid, int& sb, int& snb) {
    const int rem = nunits % nb;
    if (rem == 0) { sb = bid; snb = nb; return true; }
    if (bid >= rem) { sb = bid - rem; snb = nb - rem; return true; }
    return false;
}
__device__ __forceinline__ void ph_prologue(const Params& p, int bid, int nb, float* smem) {
    const int tid = otid();
    for (int u = bid; u < DEPTH * 96; u += nb) {
        const int l = u / 96, jb = u % 96;
        __syncthreads();
        for (int i = tid; i < 3 * D; i += NTH) {
            const int r = i / D, k = i % D;
            const float cv = (r < 2) ? p.c[r * D + k] : p.c_ctx[k];
            smem[i] = siluf(cv);
        }
        __syncthreads();
        const int cc = tid & 127, ks = tid >> 7;
        const float* w = p.w_ada + (long)l * D * (6 * D) + (long)(ks * 512) * (6 * D) + jb * 128 + cc;
        const float* sc = smem + ks * 512;
        float a0 = 0.f, a1 = 0.f, a2 = 0.f;
#pragma unroll 8
        for (int k = 0; k < 512; ++k) {
            const float wv = w[(long)k * (6 * D)];
            a0 = fmaf(sc[k], wv, a0); a1 = fmaf(sc[D + k], wv, a1); a2 = fmaf(sc[2 * D + k], wv, a2);
        }
        float* red = smem + 3 * D;
        red[(ks * 3 + 0) * 128 + cc] = a0; red[(ks * 3 + 1) * 128 + cc] = a1; red[(ks * 3 + 2) * 128 + cc] = a2;
        __syncthreads();
        if (tid < 384) {
            const int r = tid >> 7;
            const float v = (red[(0 * 3 + r) * 128 + cc] + red[(1 * 3 + r) * 128 + cc]) + (red[(2 * 3 + r) * 128 + cc] + red[(3 * 3 + r) * 128 + cc]);
            p.modv[((long)l * 3 + r) * 6 * D + jb * 128 + cc] = v + p.b_ada[l * 6 * D + jb * 128 + cc];
        }
    }
    __syncthreads();
    conv_first(p, bid, nb, smem);
    {
        const u32x4 z = {0u, 0u, 0u, 0u};
        for (long i = (long)bid * NTH + tid; i < (long)DEPTH * (INP - INC) * D / 8; i += (long)nb * NTH) {
            const long per = (long)(INP - INC) * D / 8; const int l = (int)(i / per); const long o = i % per;
            *(u32x4*)(p.WinT + (long)l * INP * D + (long)INC * D + o * 8) = z;
        }
        for (long i = (long)bid * NTH + tid; i < (long)DEPTH * 1024 * 16; i += (long)nb * NTH) {
            const long row = i / 16; const int c8 = (int)(i % 16) * 8;
            *(u32x4*)(p.WukvT + row * 256 + 128 + c8) = z;
        }
    }
}

struct Row { float4 v[8]; };
__device__ __forceinline__ void row_load(Row& r, const float* p, int lane) {
#pragma unroll
    for (int i = 0; i < 8; ++i) r.v[i] = ld4(p + (i * 64 + lane) * 4);
}
__device__ __forceinline__ void row_store(const Row& r, float* p, int lane) {
#pragma unroll
    for (int i = 0; i < 8; ++i) st4(p + (i * 64 + lane) * 4, r.v[i]);
}
__device__ __forceinline__ void row_store_bf16(const Row& r, bf16_t* p, int lane) {
#pragma unroll
    for (int i = 0; i < 8; ++i) { u32x2 w; w.x = cvt_pk_bf16(r.v[i].x, r.v[i].y); w.y = cvt_pk_bf16(r.v[i].z, r.v[i].w); *(u32x2*)(p + (i * 64 + lane) * 4) = w; }
}
__device__ __forceinline__ void row_stats(const Row& r, float& mean, float& rstd) {
    float s = 0.f;
#pragma unroll
    for (int i = 0; i < 8; ++i) s += (r.v[i].x + r.v[i].y) + (r.v[i].z + r.v[i].w);
    mean = wsum(s) * (1.0f / D);
    float q = 0.f;
#pragma unroll
    for (int i = 0; i < 8; ++i) { const float a = r.v[i].x - mean, b = r.v[i].y - mean, c = r.v[i].z - mean, d = r.v[i].w - mean; q += (a * a + b * b) + (c * c + d * d); }
    rstd = rsqrtf(wsum(q) * (1.0f / D) + EPS);
}
__device__ __forceinline__ void row_modulate(Row& r, float mean, float rstd, const float* sh, const float* sc, int lane) {
#pragma unroll
    for (int i = 0; i < 8; ++i) {
        const int c = (i * 64 + lane) * 4;
        const float4 s = ld4(sc + c), h = ld4(sh + c);
        r.v[i].x = (r.v[i].x - mean) * rstd * (1.f + s.x) + h.x; r.v[i].y = (r.v[i].y - mean) * rstd * (1.f + s.y) + h.y;
        r.v[i].z = (r.v[i].z - mean) * rstd * (1.f + s.z) + h.z; r.v[i].w = (r.v[i].w - mean) * rstd * (1.f + s.w) + h.w;
    }
}
__device__ __forceinline__ void row_affine(Row& r, float mean, float rstd, const float* g, const float* b, int lane) {
#pragma unroll
    for (int i = 0; i < 8; ++i) {
        const int c = (i * 64 + lane) * 4;
        const float4 s = ld4(g + c), h = ld4(b + c);
        r.v[i].x = (r.v[i].x - mean) * rstd * s.x + h.x; r.v[i].y = (r.v[i].y - mean) * rstd * s.y + h.y;
        r.v[i].z = (r.v[i].z - mean) * rstd * s.z + h.z; r.v[i].w = (r.v[i].w - mean) * rstd * s.w + h.w;
    }
}

__device__ __forceinline__ void ph_lnmod(const Params& p, int l, int bid, int nb) {
    const int tid = otid(), lane = tid & 63, wid = tid >> 6;
    for (int r = bid * NWV + wid; r < R; r += nb * NWV) {
        Row x; row_load(x, XSRC(p, l, r), lane);
        float mean, rstd; row_stats(x, mean, rstd);
        const float* mv = p.modv + ((long)l * 3 + mod_row(r)) * 6 * D;
        row_modulate(x, mean, rstd, mv + 0 * D, mv + 1 * D, lane);
        row_store_bf16(x, p.hb + (long)r * D, lane);
    }
}

__device__ __forceinline__ void ph_prep(const Params& p, int l, int bid, int nb) {
    const int tid = otid(), lane = tid & 63, wid = tid >> 6;
    for (int rr = 0; rr < 8 * (R / 64); ++rr) {
        const int grp = rr >> 3;
        const int g64 = bid + (grp) * nb; if (g64 >= R / 64) break;
        const int r = g64 * 64 + wid * 8 + (rr & 7);
        const float* pr = p.P + (long)r * INC;
        const bool lat = r < NLAT;
        const int t = r % T; const float rowi = (float)(t / 64), coli = (float)(t % 64);
        {
            float sn = 0.f, cs = 1.f;
            if (lat) { const int f = lane & 31; const float inv = powf(10000.0f, -(float)f / 32.0f); sincosf((lane < 32 ? rowi : coli) * inv, &sn, &cs); }
#pragma unroll
            for (int h = 0; h < 6; ++h) {
                const float x1 = pr[SQ + h * 128 + lane], x2 = pr[SQ + h * 128 + lane + 64];
                const bf16_t y1 = f2bf(x1 * cs - x2 * sn), y2 = f2bf(x2 * cs + x1 * sn);
                bf16_t* d = (h < 4) ? (p.sqb + (long)r * 512 + h * 128) : (p.skb + (long)r * 256 + (h - 4) * 128);
                d[lane] = y1; d[lane + 64] = y2;
            }
#pragma unroll
            for (int i = 0; i < 4; ++i) p.svT[(long)(i * 64 + lane) * R + r] = f2bf(pr[SV + i * 64 + lane]);
        }
        if (lane < 32) {
            float sn = 0.f, cs = 1.f;
            if (lat) { const int f = lane & 15; const float inv = powf(10000.0f, -(float)f / 16.0f); sincosf((lane < 16 ? rowi : coli) * inv, &sn, &cs); }
            const float x1 = pr[KR + lane], x2 = pr[KR + lane + 32];
            p.Krb[(long)r * 64 + lane] = f2bf(x1 * cs - x2 * sn); p.Krb[(long)r * 64 + lane + 32] = f2bf(x2 * cs + x1 * sn);
        }
        {
            float v[6]; float s = 0.f;
#pragma unroll
            for (int i = 0; i < 6; ++i) { v[i] = pr[CQ + i * 64 + lane]; s += v[i] * v[i]; }
            const float rs = rsqrtf(wsum(s) * (1.0f / 384.0f) + EPS);
#pragma unroll
            for (int i = 0; i < 6; ++i) p.cqn[(long)r * 384 + i * 64 + lane] = f2bf(v[i] * rs * p.q_norm[l * 384 + i * 64 + lane]);
            const float a = pr[CKV + lane], b = pr[CKV + 64 + lane];
            const float rs2 = rsqrtf(wsum(a * a + b * b) * (1.0f / 128.0f) + EPS);
            p.ckvn[(long)r * 256 + lane] = f2bf(a * rs2 * p.kv_norm[l * 128 + lane]);
            p.ckvn[(long)r * 256 + 64 + lane] = f2bf(b * rs2 * p.kv_norm[l * 128 + 64 + lane]);
            p.ckvn[(long)r * 256 + 128 + lane] = 0; p.ckvn[(long)r * 256 + 192 + lane] = 0;
        }
    }
}

struct AttnSrc {
    const bf16_t* Q; int ldq, qoff;
    const bf16_t* K1; int ldk1, k1off;
    const bf16_t* K2; int ldk2;
    const bf16_t* Vt; int ldv, voff;
    bf16_t* O; int ldo, ooff;
};
template <bool MLA>
__device__ __forceinline__ void attn_unit(const AttnSrc& a, int qrow0, int ctxrow0, int locrow0, int nloc, bool win, int tq0, int tk0, bool rope_q,
                                          float sink_l2, float c, LAS unsigned char* lds) {
    constexpr int KSTR = MLA ? 400 : 272, NKS = MLA ? 6 : 4, VSTR = 144, KBYTES = 64 * KSTR, BUFB = KBYTES + 128 * VSTR, NCH = MLA ? 5 : 4;
    const int tid = otid(), lane = tid & 63, wid = tid >> 6, fr = lane & 15, fq = lane >> 4;
    const int ntiles = 4 + nloc;
    bf16x8 qf[2][NKS];
#pragma unroll
    for (int qt = 0; qt < 2; ++qt) {
        const bf16_t* qp = a.Q + (long)(qrow0 + wid * 32 + qt * 16 + fr) * a.ldq + a.qoff + fq * 8;
#pragma unroll
        for (int ks = 0; ks < NKS; ++ks) qf[qt][ks] = *(const bf16x8*)(qp + ks * 32);
        if (MLA && rope_q) {
            const int t = tq0 + wid * 32 + qt * 16 + fr; const float rowi = (float)(t / 64), coli = (float)(t % 64);
#pragma unroll
            for (int e = 0; e < 8; ++e) {
                const int i = fq * 8 + e, f = i & 15;
                const float inv = powf(10000.0f, -(float)f / 16.0f);
                const float ang = (i < 16 ? rowi : coli) * inv;
                float sn, cs; sincosf(ang, &sn, &cs);
                const float x1 = __uint_as_float(((unsigned)(unsigned short)qf[qt][NKS - 2][e]) << 16), x2 = __uint_as_float(((unsigned)(unsigned short)qf[qt][NKS - 1][e]) << 16);
                qf[qt][NKS - 2][e] = (short)f2bf(x1 * cs - x2 * sn); qf[qt][NKS - 1][e] = (short)f2bf(x2 * cs + x1 * sn);
            }
        }
    }
    f32x4 o[2][8];
#pragma unroll
    for (int qt = 0; qt < 2; ++qt)
#pragma unroll
        for (int dt = 0; dt < 8; ++dt) o[qt][dt] = (f32x4){0.f, 0.f, 0.f, 0.f};
    float m[2] = {-INFINITY, -INFINITY}, l[2] = {0.f, 0.f};
    u32x4 rg[NCH];
#define ATT_LOAD(keyrow0) do { \
        const int kr_ = (keyrow0); \
        rg[0] = *(const u32x4*)(a.K1 + (long)(kr_ + (tid >> 4)) * a.ldk1 + a.k1off + (tid & 15) * 8); \
        rg[1] = *(const u32x4*)(a.K1 + (long)(kr_ + 32 + (tid >> 4)) * a.ldk1 + a.k1off + (tid & 15) * 8); \
        if (MLA) { rg[2] = *(const u32x4*)(a.K2 + (long)(kr_ + (tid >> 3)) * a.ldk2 + (tid & 7) * 8); \
                   rg[3] = *(const u32x4*)(a.Vt + (long)(a.voff + (tid >> 3)) * a.ldv + kr_ + (tid & 7) * 8); \
                   rg[NCH - 1] = *(const u32x4*)(a.Vt + (long)(a.voff + 64 + (tid >> 3)) * a.ldv + kr_ + (tid & 7) * 8); } \
        else { rg[2] = *(const u32x4*)(a.Vt + (long)(a.voff + (tid >> 3)) * a.ldv + kr_ + (tid & 7) * 8); \
               rg[NCH - 1] = *(const u32x4*)(a.Vt + (long)(a.voff + 64 + (tid >> 3)) * a.ldv + kr_ + (tid & 7) * 8); } } while (0)
#define ATT_STORE(buf) do { LAS unsigned char* b_ = (buf); \
        *(LAS u32x4*)(b_ + (tid >> 4) * KSTR + (tid & 15) * 16) = rg[0]; \
        *(LAS u32x4*)(b_ + (32 + (tid >> 4)) * KSTR + (tid & 15) * 16) = rg[1]; \
        if (MLA) { *(LAS u32x4*)(b_ + (tid >> 3) * KSTR + 256 + (tid & 7) * 16) = rg[2]; \
                   *(LAS u32x4*)(b_ + KBYTES + (tid >> 3) * VSTR + (tid & 7) * 16) = rg[3]; \
                   *(LAS u32x4*)(b_ + KBYTES + (64 + (tid >> 3)) * VSTR + (tid & 7) * 16) = rg[NCH - 1]; } \
        else { *(LAS u32x4*)(b_ + KBYTES + (tid >> 3) * VSTR + (tid & 7) * 16) = rg[2]; \
               *(LAS u32x4*)(b_ + KBYTES + (64 + (tid >> 3)) * VSTR + (tid & 7) * 16) = rg[NCH - 1]; } } while (0)
#define ATT_KEYROW(i) ((i) < 4 ? ctxrow0 + 64 * (i) : locrow0 + 64 * ((i) - 4))
    __syncthreads();
    ATT_LOAD(ATT_KEYROW(0));
    ATT_STORE(lds);
    __syncthreads();
    for (int t = 0; t < ntiles; ++t) {
        LAS unsigned char* buf = lds + (t & 1) * BUFB;
        if (t + 1 < ntiles) ATT_LOAD(ATT_KEYROW(t + 1));
        f32x4 s[2][4];
#pragma unroll
        for (int kt = 0; kt < 4; ++kt) {
            s[0][kt] = (f32x4){0.f, 0.f, 0.f, 0.f}; s[1][kt] = (f32x4){0.f, 0.f, 0.f, 0.f};
#pragma unroll
            for (int ks = 0; ks < NKS; ++ks) {
                const bf16x8 kf = *(const LAS bf16x8*)(buf + (kt * 16 + fr) * KSTR + ks * 64 + fq * 16);
                s[0][kt] = __builtin_amdgcn_mfma_f32_16x16x32_bf16(kf, qf[0][ks], s[0][kt], 0, 0, 0);
                s[1][kt] = __builtin_amdgcn_mfma_f32_16x16x32_bf16(kf, qf[1][ks], s[1][kt], 0, 0, 0);
            }
        }
        u32x4 pk[2][2];
#pragma unroll
        for (int qt = 0; qt < 2; ++qt) {
            if (win && t >= 4) {
                const int tq = tq0 + wid * 32 + qt * 16 + fr, tkb = tk0 + 64 * (t - 4) + 4 * fq;
#pragma unroll
                for (int kt = 0; kt < 4; ++kt)
#pragma unroll
                    for (int j = 0; j < 4; ++j) { const int dd = tkb + kt * 16 + j - tq; if (dd < -128 || dd > 128) s[qt][kt][j] = -INFINITY; }
            }
            float mx = fmaxf(fmaxf(fmaxf(s[qt][0][0], s[qt][0][1]), fmaxf(s[qt][0][2], s[qt][0][3])), fmaxf(fmaxf(s[qt][1][0], s[qt][1][1]), fmaxf(s[qt][1][2], s[qt][1][3])));
            mx = fmaxf(mx, fmaxf(fmaxf(fmaxf(s[qt][2][0], s[qt][2][1]), fmaxf(s[qt][2][2], s[qt][2][3])), fmaxf(fmaxf(s[qt][3][0], s[qt][3][1]), fmaxf(s[qt][3][2], s[qt][3][3]))));
            mx = fmaxf(mx, __shfl_xor(mx, 16)); mx = fmaxf(mx, __shfl_xor(mx, 32));
            const float mn = fmaxf(m[qt], mx * c);
            const float alpha = __builtin_amdgcn_exp2f(m[qt] - mn);
            m[qt] = mn;
            float ps = 0.f;
#pragma unroll
            for (int kt = 0; kt < 4; ++kt)
#pragma unroll
                for (int j = 0; j < 4; ++j) { const float pv = __builtin_amdgcn_exp2f(fmaf(s[qt][kt][j], c, -mn)); s[qt][kt][j] = pv; ps += pv; }
            l[qt] = l[qt] * alpha + ps;
#pragma unroll
            for (int dt = 0; dt < 8; ++dt) o[qt][dt] = o[qt][dt] * alpha;
#pragma unroll
            for (int s2 = 0; s2 < 2; ++s2) {
                pk[qt][s2].x = cvt_pk_bf16(s[qt][2 * s2][0], s[qt][2 * s2][1]); pk[qt][s2].y = cvt_pk_bf16(s[qt][2 * s2][2], s[qt][2 * s2][3]);
                pk[qt][s2].z = cvt_pk_bf16(s[qt][2 * s2 + 1][0], s[qt][2 * s2 + 1][1]); pk[qt][s2].w = cvt_pk_bf16(s[qt][2 * s2 + 1][2], s[qt][2 * s2 + 1][3]);
            }
        }
#pragma unroll
        for (int s2 = 0; s2 < 2; ++s2) {
            const bf16x8 pf0 = __builtin_bit_cast(bf16x8, pk[0][s2]), pf1 = __builtin_bit_cast(bf16x8, pk[1][s2]);
#pragma unroll
            for (int dt = 0; dt < 8; ++dt) {
                const LAS unsigned char* vp = buf + KBYTES + (dt * 16 + fr) * VSTR + (32 * s2 + 4 * fq) * 2;
                const u32x2 lo = *(const LAS u32x2*)vp, hi = *(const LAS u32x2*)(vp + 32);
                u32x4 vv; vv.x = lo.x; vv.y = lo.y; vv.z = hi.x; vv.w = hi.y;
                const bf16x8 vf = __builtin_bit_cast(bf16x8, vv);
                o[0][dt] = __builtin_amdgcn_mfma_f32_16x16x32_bf16(vf, pf0, o[0][dt], 0, 0, 0);
                o[1][dt] = __builtin_amdgcn_mfma_f32_16x16x32_bf16(vf, pf1, o[1][dt], 0, 0, 0);
            }
        }
        if (t + 1 < ntiles) ATT_STORE(lds + ((t + 1) & 1) * BUFB);
        __syncthreads();
    }
#undef ATT_LOAD
#undef ATT_STORE
#undef ATT_KEYROW
#pragma unroll
    for (int qt = 0; qt < 2; ++qt) {
        float lt = l[qt]; lt += __shfl_xor(lt, 16); lt += __shfl_xor(lt, 32);
        if (sink_l2 > -INFINITY) { const float mn = fmaxf(m[qt], sink_l2); const float alpha = __builtin_amdgcn_exp2f(m[qt] - mn); lt = lt * alpha + __builtin_amdgcn_exp2f(sink_l2 - mn);
#pragma unroll
            for (int dt = 0; dt < 8; ++dt) o[qt][dt] = o[qt][dt] * alpha; }
        const float il = 1.0f / lt;
        bf16_t* op = a.O + (long)(qrow0 + wid * 32 + qt * 16 + fr) * a.ldo + a.ooff + 4 * fq;
#pragma unroll
        for (int dt = 0; dt < 8; ++dt) { u32x2 w; w.x = cvt_pk_bf16(o[qt][dt][0] * il, o[qt][dt][1] * il); w.y = cvt_pk_bf16(o[qt][dt][2] * il, o[qt][dt][3] * il); *(u32x2*)(op + dt * 16) = w; }
    }
}

constexpr int NCHK = (LCTX + T) / 64;
constexpr int SC_QB = 0, SC_KB = 17408, SC_BF = 34816, SC_VT = 68608, SC_ST = 87040, SC_QT = 121856;
__device__ __forceinline__ float hgrn_lb(const Params& p, int l, int dir, int hi) {
    if (l == 0) return 0.f;
    const float l0 = p.lb_logits[(0 * 2 + dir) * 512 + hi], l1 = p.lb_logits[(1 * 2 + dir) * 512 + hi];
    const float mx = fmaxf(l0, l1), e0 = expf(l0 - mx), e1 = expf(l1 - mx);
    return e1 / (e0 + e1);
}
__device__ __forceinline__ int scan_row0(int b, int rb) { return rb < 4 ? NLAT + b * LCTX + rb * 64 : b * T + (rb - 4) * 64; }
__device__ __forceinline__ int scan_chunk(int dir, int rb) { return dir ? (rb < 4 ? 3 - rb : 71 - rb) : rb; }
template <int MIXER>
__device__ __forceinline__ void scan_load_k(const Params& p, int l, int h, int dir, int row0, int d, int rq, float lng, float lb, float (&kv)[16], float (&pb)[16], float& tot) {
    const int koff = (MIXER == 0 ? RK : (dir ? HFB : HFF)) + h * 128 + d;
    float g[16];
#pragma unroll
    for (int j = 0; j < 16; ++j) {
        const float z = p.P[(long)(row0 + rq * 16 + j) * INC + koff];
        if (MIXER == 0) { kv[j] = z * 0.08838834764831845f; g[j] = lng; }
        else { const float f = lb + (1.0f - lb) * __builtin_amdgcn_rcpf(1.0f + __expf(-z)); kv[j] = 1.0f - f; g[j] = __logf(f); }
    }
    float run = 0.f;
    if (dir == 0) {
#pragma unroll
        for (int j = 0; j < 16; ++j) { run += g[j]; pb[j] = run; }
    } else {
#pragma unroll
        for (int j = 15; j >= 0; --j) { run += g[j]; pb[j] = run; }
    }
    tot = run;
}
template <int MIXER>
__device__ __forceinline__ void scan_s1(const Params& p, int l, int u, LAS unsigned char* lds) {
    const int tid = otid(), lane = tid & 63, wid = tid >> 6, fr = lane & 15, fq = lane >> 4, d = tid & 127, rq = tid >> 7;
    const int sl = u / NCHK, rb = u % NCHK, b = sl >> 3, h = (sl >> 1) & 3, dir = sl & 1, sq = MIXER * 16 + sl;
    const int row0 = scan_row0(b, rb), c = scan_chunk(dir, rb);
    const float lng = (MIXER == 0) ? log1pf(-exp2f(-p.ret_s[(l * 2 + dir) * 4 + h])) : 0.f;
    const float lb = (MIXER == 1) ? hgrn_lb(p, l, dir, h * 128 + d) : 0.f;
    LAS float* qt = (LAS float*)(lds + 36864);
    float kv[16], pb[16], tot;
    scan_load_k<MIXER>(p, l, h, dir, row0, d, rq, lng, lb, kv, pb, tot);
    float vv[16];
    {
        const int voff = (MIXER == 0 ? RV : HI) + h * 128 + d;
#pragma unroll
        for (int j = 0; j < 16; ++j) vv[j] = p.P[(long)(row0 + rq * 16 + j) * INC + voff];
    }
    __syncthreads();
    qt[rq * 128 + d] = tot;
#pragma unroll
    for (int j = 0; j < 16; ++j) *(LAS bf16_t*)(lds + 18432 + d * 144 + (rq * 16 + j) * 2) = f2bf(vv[j]);
    __syncthreads();
    float off = 0.f, all = 0.f;
#pragma unroll
    for (int q = 0; q < 4; ++q) { const float tq_ = qt[q * 128 + d]; all += tq_; if (dir == 0 ? (q < rq) : (q > rq)) off += tq_; }
#pragma unroll
    for (int j = 0; j < 16; ++j) *(LAS bf16_t*)(lds + d * 144 + (rq * 16 + j) * 2) = f2bf(kv[j] * __expf(all - (pb[j] + off)));
    if (rq == 0) p.sA[(long)(sq * NCHK + c) * 128 + d] = __expf(all);
    __syncthreads();
    f32x4 acc[8];
#pragma unroll
    for (int nt = 0; nt < 8; ++nt) acc[nt] = (f32x4){0.f, 0.f, 0.f, 0.f};
#pragma unroll
    for (int ks = 0; ks < 2; ++ks) {
        const bf16x8 a = *(const LAS bf16x8*)(lds + 18432 + (wid * 16 + fr) * 144 + (32 * ks + 8 * fq) * 2);
#pragma unroll
        for (int nt = 0; nt < 8; ++nt) {
            const bf16x8 bb = *(const LAS bf16x8*)(lds + (nt * 16 + fr) * 144 + (32 * ks + 8 * fq) * 2);
            acc[nt] = __builtin_amdgcn_mfma_f32_16x16x32_bf16(a, bb, acc[nt], 0, 0, 0);
        }
    }
    float* up = p.sst + (long)(sq * NCHK + c) * 16384 + (long)(wid * 16 + 4 * fq) * 128 + fr;
#pragma unroll
    for (int nt = 0; nt < 8; ++nt)
#pragma unroll
        for (int j = 0; j < 4; ++j) up[j * 128 + nt * 16] = acc[nt][j];
}
__device__ __forceinline__ void ph_scan2(const Params& p, int bid, int nb) {
    const int tid = otid();
    for (int e = bid * NTH + tid; e < 32 * 16384; e += nb * NTH) {
        const int sq = e >> 14, ij = e & 16383, dk = ij & 127;
        float* base = p.sst + (long)sq * NCHK * 16384 + ij;
        const float* A = p.sA + (long)sq * NCHK * 128 + dk;
        float S = 0.f;
#pragma unroll 4
        for (int c = 0; c < NCHK; ++c) { const float uv = base[(long)c * 16384]; base[(long)c * 16384] = S; S = fmaf(A[c * 128], S, uv); }
    }
}
__device__ __forceinline__ void bf8_to_f32(const bf16x8 v, float (&f)[8]) {
    const u32x4 w = __builtin_bit_cast(u32x4, v);
    f[0] = __uint_as_float(w.x << 16); f[1] = __uint_as_float(w.x & 0xffff0000u); f[2] = __uint_as_float(w.y << 16); f[3] = __uint_as_float(w.y & 0xffff0000u);
    f[4] = __uint_as_float(w.z << 16); f[5] = __uint_as_float(w.z & 0xffff0000u); f[6] = __uint_as_float(w.w << 16); f[7] = __uint_as_float(w.w & 0xffff0000u);
}
__device__ __forceinline__ bf16x8 f32_to_bf8(const float (&f)[8]) {
    u32x4 w; w.x = cvt_pk_bf16(f[0], f[1]); w.y = cvt_pk_bf16(f[2], f[3]); w.z = cvt_pk_bf16(f[4], f[5]); w.w = cvt_pk_bf16(f[6], f[7]);
    return __builtin_bit_cast(bf16x8, w);
}
template <int MIXER>
__device__ __forceinline__ void scan_s3(const Params& p, int l, int u, LAS unsigned char* lds) {
    const int tid = otid(), lane = tid & 63, wid = tid >> 6, fr = lane & 15, fq = lane >> 4, d = tid & 127, rq = tid >> 7, jr = wid & 3, dvh = wid >> 2;
    const int b = u / (4 * NCHK), rem = u % (4 * NCHK), h = rem / NCHK, rb = rem % NCHK;
    const int row0 = scan_row0(b, rb);
    LAS float* qt = (LAS float*)(lds + SC_QT);
    LAS float* bfp = (LAS float*)(lds + SC_BF);
    __syncthreads();
    {
        const int qoff = (MIXER == 0 ? RQ : HQ) + h * 128 + d, voff = (MIXER == 0 ? RV : HI) + h * 128 + d;
#pragma unroll
        for (int j = 0; j < 16; ++j) {
            const int r = rq * 16 + j; const float* pr = p.P + (long)(row0 + r) * INC;
            const float qv = pr[qoff], vv = pr[voff];
            *(LAS bf16_t*)(lds + SC_QB + r * 272 + d * 2) = f2bf(MIXER == 0 ? qv : qv * __builtin_amdgcn_rcpf(1.0f + __expf(-qv)));
            *(LAS bf16_t*)(lds + SC_VT + d * 144 + r * 2) = f2bf(vv);
        }
    }
    f32x4 o[4];
#pragma unroll
    for (int dt = 0; dt < 4; ++dt) o[dt] = (f32x4){0.f, 0.f, 0.f, 0.f};
#pragma unroll 1
    for (int dir = 0; dir < 2; ++dir) {
        const int sq = MIXER * 16 + (b * 4 + h) * 2 + dir, cidx = scan_chunk(dir, rb);
        const float lng = (MIXER == 0) ? log1pf(-exp2f(-p.ret_s[(l * 2 + dir) * 4 + h])) : 0.f;
        const float lb = (MIXER == 1) ? hgrn_lb(p, l, dir, h * 128 + d) : 0.f;
        float kv[16], pb[16], tot;
        scan_load_k<MIXER>(p, l, h, dir, row0, d, rq, lng, lb, kv, pb, tot);
        if (dir == 1) __syncthreads();
        qt[rq * 128 + d] = tot;
#pragma unroll
        for (int j = 0; j < 16; ++j) *(LAS bf16_t*)(lds + SC_KB + (rq * 16 + j) * 272 + d * 2) = f2bf(kv[j]);
        {
            const float* sp = p.sst + (long)(sq * NCHK + cidx) * 16384;
#pragma unroll
            for (int e = 0; e < 8; ++e) {
                const int idx = tid + e * NTH, dv = idx >> 5, c4 = idx & 31;
                const float4 v4 = ld4(sp + dv * 128 + c4 * 4);
                u32x2 w; w.x = cvt_pk_bf16(v4.x, v4.y); w.y = cvt_pk_bf16(v4.z, v4.w);
                *(LAS u32x2*)(lds + SC_ST + dv * 272 + c4 * 8) = w;
            }
        }
        __syncthreads();
        {
            float off = 0.f;
#pragma unroll
            for (int q = 0; q < 4; ++q) { const float tq_ = qt[q * 128 + d]; if (dir == 0 ? (q < rq) : (q > rq)) off += tq_; }
#pragma unroll
            for (int j = 0; j < 16; ++j) bfp[(rq * 16 + j) * 132 + d] = pb[j] + off;
        }
        __syncthreads();
        const int n = 16 * jr + fr;
        const int rowB = dir == 0 ? 16 * jr - 1 : 16 * jr + 16;
        const bool hasB = dir == 0 ? (jr > 0) : (jr < 3);
        bf16x8 Qh[4], Qt[4];
        float B8[4][8];
#pragma unroll
        for (int ks = 0; ks < 4; ++ks) {
            const int d0 = 32 * ks + 8 * fq;
            float q8[8], bn[8];
            bf8_to_f32(*(const LAS bf16x8*)(lds + SC_QB + n * 272 + d0 * 2), q8);
            const f32x4 b0 = *(const LAS f32x4*)(bfp + n * 132 + d0), b1 = *(const LAS f32x4*)(bfp + n * 132 + d0 + 4);
            bn[0] = b0[0]; bn[1] = b0[1]; bn[2] = b0[2]; bn[3] = b0[3]; bn[4] = b1[0]; bn[5] = b1[1]; bn[6] = b1[2]; bn[7] = b1[3];
            if (hasB) { const f32x4 c0 = *(const LAS f32x4*)(bfp + rowB * 132 + d0), c1 = *(const LAS f32x4*)(bfp + rowB * 132 + d0 + 4);
                B8[ks][0] = c0[0]; B8[ks][1] = c0[1]; B8[ks][2] = c0[2]; B8[ks][3] = c0[3]; B8[ks][4] = c1[0]; B8[ks][5] = c1[1]; B8[ks][6] = c1[2]; B8[ks][7] = c1[3]; }
            else {
#pragma unroll
                for (int e = 0; e < 8; ++e) B8[ks][e] = 0.f; }
            float qh[8], qtl[8];
#pragma unroll
            for (int e = 0; e < 8; ++e) { qh[e] = q8[e] * __expf(bn[e] - B8[ks][e]); qtl[e] = q8[e] * __expf(bn[e]); }
            Qh[ks] = f32_to_bf8(qh); Qt[ks] = f32_to_bf8(qtl);
        }
#pragma unroll
        for (int dt = 0; dt < 4; ++dt)
#pragma unroll
            for (int ks = 0; ks < 4; ++ks) {
                const bf16x8 a = *(const LAS bf16x8*)(lds + SC_ST + (dvh * 64 + dt * 16 + fr) * 272 + (32 * ks + 8 * fq) * 2);
                o[dt] = __builtin_amdgcn_mfma_f32_16x16x32_bf16(a, Qt[ks], o[dt], 0, 0, 0);
            }
        f32x4 sc[4];
#pragma unroll
        for (int kr = 0; kr < 4; ++kr) {
            sc[kr] = (f32x4){0.f, 0.f, 0.f, 0.f};
            const bool need = dir == 0 ? (kr <= jr) : (kr >= jr);
            if (need) {
                const int m = 16 * kr + fr;
#pragma unroll
                for (int ks = 0; ks < 4; ++ks) {
                    const int d0 = 32 * ks + 8 * fq;
                    float k8[8], kh[8];
                    bf8_to_f32(*(const LAS bf16x8*)(lds + SC_KB + m * 272 + d0 * 2), k8);
                    const f32x4 b0 = *(const LAS f32x4*)(bfp + m * 132 + d0), b1 = *(const LAS f32x4*)(bfp + m * 132 + d0 + 4);
                    const float bm[8] = {b0[0], b0[1], b0[2], b0[3], b1[0], b1[1], b1[2], b1[3]};
#pragma unroll
                    for (int e = 0; e < 8; ++e) kh[e] = k8[e] * __expf(fminf(B8[ks][e] - bm[e], 60.0f));
                    sc[kr] = __builtin_amdgcn_mfma_f32_16x16x32_bf16(f32_to_bf8(kh), Qh[ks], sc[kr], 0, 0, 0);
                }
                if (kr == jr) {
#pragma unroll
                    for (int j = 0; j < 4; ++j) { const int mm = 4 * fq + j; const bool keep = dir == 0 ? (mm <= fr) : (mm >= fr); if (!keep) sc[kr][j] = 0.f; }
                }
            }
        }
#pragma unroll
        for (int s2 = 0; s2 < 2; ++s2) {
            const bool need = dir == 0 ? (2 * s2 <= jr) : (2 * s2 + 1 >= jr);
            if (need) {
                u32x4 pk; pk.x = cvt_pk_bf16(sc[2 * s2][0], sc[2 * s2][1]); pk.y = cvt_pk_bf16(sc[2 * s2][2], sc[2 * s2][3]);
                pk.z = cvt_pk_bf16(sc[2 * s2 + 1][0], sc[2 * s2 + 1][1]); pk.w = cvt_pk_bf16(sc[2 * s2 + 1][2], sc[2 * s2 + 1][3]);
                const bf16x8 pf = __builtin_bit_cast(bf16x8, pk);
#pragma unroll
                for (int dt = 0; dt < 4; ++dt) {
                    const LAS unsigned char* vp = lds + SC_VT + (dvh * 64 + dt * 16 + fr) * 144 + (32 * s2 + 4 * fq) * 2;
                    const u32x2 lo = *(const LAS u32x2*)vp, hi = *(const LAS u32x2*)(vp + 32);
                    u32x4 vv; vv.x = lo.x; vv.y = lo.y; vv.z = hi.x; vv.w = hi.y;
                    o[dt] = __builtin_amdgcn_mfma_f32_16x16x32_bf16(__builtin_bit_cast(bf16x8, vv), pf, o[dt], 0, 0, 0);
                }
            }
        }
    }
    __syncthreads();
#pragma unroll
    for (int dt = 0; dt < 4; ++dt) *(LAS f32x4*)(bfp + (16 * jr + fr) * 128 + dvh * 64 + dt * 16 + 4 * fq) = o[dt];
    __syncthreads();
    {
        for (int rr = 0; rr < 8; ++rr) {
            const int lr = wid * 8 + rr, r = row0 + lr;
            const float a = bfp[lr * 128 + lane], bq = bfp[lr * 128 + 64 + lane];
            const float* pr = p.P + (long)r * INC;
            const int cc = h * 128 + lane;
            if (MIXER == 0) {
                const float mean = wsum(a + bq) * (1.0f / 128.0f);
                const float da = a - mean, db = bq - mean;
                const float rstd = rsqrtf(wsum(da * da + db * db) * (1.0f / 128.0f) + EPS);
                p.mix[(long)r * D + 512 + cc] = f2bf(siluf(pr[RG + cc]) * (da * rstd * p.ret_gn[l * 512 + cc]));
                p.mix[(long)r * D + 512 + cc + 64] = f2bf(siluf(pr[RG + cc + 64]) * (db * rstd * p.ret_gn[l * 512 + cc + 64]));
            } else {
                const float rs = rsqrtf(wsum(a * a + bq * bq) * (1.0f / 128.0f) + EPS);
                p.mix[(long)r * D + 1536 + cc] = f2bf(siluf(pr[HG + cc]) * (a * rs * p.hgrn_gn[l * 512 + cc]));
                p.mix[(long)r * D + 1536 + cc + 64] = f2bf(siluf(pr[HG + cc + 64]) * (bq * rs * p.hgrn_gn[l * 512 + cc + 64]));
            }
        }
    }
}
__device__ __forceinline__ void ph_scan3(const Params& p, int l, int bid, int nb, LAS unsigned char* lds) {
    constexpr int NU = 2 * 4 * NCHK;
    for (int u = bid; u < 2 * NU; u += nb) {
        if (u < NU) scan_s3<0>(p, l, u, lds); else scan_s3<1>(p, l, u - NU, lds);
    }
}

__device__ __forceinline__ void ph_mixers(const Params& p, int l, int bid, int nb, float* smem, LAS unsigned char* lds) {
    const bool need_ctx = l < DEPTH - 1;
    const float LOG2E = 1.4426950408889634f;
    const float cM = 0.07216878364870323f * LOG2E, cS = 0.08838834764831845f * LOG2E;
    const int role = (nb >= 2) ? (bid & 1) : 0, ridx = (nb >= 2) ? (bid >> 1) : bid, rn = (nb >= 2) ? (nb >> 1) : nb;
    if (role == 0 || nb < 2) {
        for (int u = ridx; u < 128; u += rn) {
            const int b = u >> 6, h = (u >> 4) & 3, qb = u & 15;
            const AttnSrc a{p.Q2b, 768, h * 192, p.Kn, 512, h * 128, p.Krb, 64, p.VtM, R, h * 128, p.mix, D, 1024 + h * 128};
            attn_unit<true>(a, b * T + qb * 256, NLAT + b * LCTX, b * T, 64, false, qb * 256, 0, true, -INFINITY, cM, lds);
        }
    }
    if (role == 1 || nb < 2) {
        for (int u = ridx; u < 128; u += rn) {
            const int b = u >> 6, h = (u >> 4) & 3, qb = u & 15, q0 = qb * 256;
            const int ts = (q0 - 128) < 0 ? 0 : (q0 - 128), te = (q0 + 384) > T ? T : (q0 + 384);
            const AttnSrc a{p.sqb, 512, h * 128, p.skb, 256, (h >> 1) * 128, nullptr, 0, p.svT, R, (h >> 1) * 128, p.mix, D, h * 128};
            attn_unit<false>(a, b * T + q0, NLAT + b * LCTX, b * T + ts, (te - ts) / 64, true, q0, ts, false, p.swa_sink[l * 4 + h] * LOG2E, cS, lds);
        }
        if (need_ctx) {
            for (int u = ridx; u < 16; u += rn) {
                const int v = u & 7, b = v >> 2, h = v & 3;
                const int qrow0 = NLAT + b * LCTX;
                int nl0 = 0; asm volatile("" : "+s"(nl0));
                if (u < 8) { const AttnSrc a{p.Q2b, 768, h * 192, p.Kn, 512, h * 128, p.Krb, 64, p.VtM, R, h * 128, p.mix, D, 1024 + h * 128};
                    attn_unit<true>(a, qrow0, NLAT + b * LCTX, 0, nl0, false, 0, 0, false, -INFINITY, cM, lds); }
                else { const AttnSrc a{p.sqb, 512, h * 128, p.skb, 256, (h >> 1) * 128, nullptr, 0, p.svT, R, (h >> 1) * 128, p.mix, D, h * 128};
                    attn_unit<false>(a, qrow0, NLAT + b * LCTX, 0, nl0, false, 0, 0, false, p.swa_sink[l * 4 + h] * LOG2E, cS, lds); }
            }
        }
        __syncthreads();
        {
            constexpr int NU1 = 16 * NCHK;
            for (int u = ridx; u < 2 * NU1; u += rn) { if (u < NU1) scan_s1<0>(p, l, u, lds); else scan_s1<1>(p, l, u - NU1, lds); }
        }
    }
}

__device__ __forceinline__ void ph_post1(const Params& p, int l, int bid, int nb) {
    const int tid = otid(), lane = tid & 63, wid = tid >> 6;
    const int nrows = (l < DEPTH - 1) ? R : NLAT;
    for (int r = bid * NWV + wid; r < nrows; r += nb * NWV) {
        const float* mv = p.modv + ((long)l * 3 + mod_row(r)) * 6 * D;
        Row x, o; row_load(x, XSRC(p, l, r), lane); row_load(o, p.ob + (long)r * D, lane);
#pragma unroll
        for (int i = 0; i < 8; ++i) {
            const float4 g = ld4(mv + 2 * D + (i * 64 + lane) * 4);
            x.v[i].x = ALPHA * x.v[i].x + g.x * o.v[i].x; x.v[i].y = ALPHA * x.v[i].y + g.y * o.v[i].y;
            x.v[i].z = ALPHA * x.v[i].z + g.z * o.v[i].z; x.v[i].w = ALPHA * x.v[i].w + g.w * o.v[i].w;
        }
        float mean, rstd; row_stats(x, mean, rstd);
        row_affine(x, mean, rstd, p.ln1_g + l * D, p.ln1_b + l * D, lane);
        row_store(x, p.xc + (long)r * D, lane);
        row_stats(x, mean, rstd);
        row_modulate(x, mean, rstd, mv + 3 * D, mv + 4 * D, lane);
        row_store_bf16(x, p.hb + (long)r * D, lane);
        row_store(x, p.ob + (long)r * D, lane);
    }
}

__device__ __forceinline__ void ph_router(const Params& p, int l, int bid, int nb, float* smem) {
    const int tid = otid(), lane = tid & 63, wid = tid >> 6, half = wid >> 2, wq = wid & 3, i = lane & 31, hk = lane >> 5;
    const int nrows = (l < DEPTH - 1) ? R : NLAT;
    const float* wre = p.w_re + (long)l * D * 32;
    const float* wrg = p.w_rg + (long)l * D * 4;
    for (int bu = bid; bu < nrows / 64; bu += nb) {
        const int row0 = bu * 64 + half * 32;
        f32x16 acc0, acc1;
#pragma unroll
        for (int q = 0; q < 16; ++q) { acc0[q] = 0.f; acc1[q] = 0.f; }
        const float* ap = p.ob + (long)(row0 + i) * D + wq * 512 + 4 * hk;
#pragma unroll 2
        for (int g = 0; g < 64; ++g) {
            const float4 a4 = ld4(ap + g * 8);
            const int kb = wq * 512 + g * 8 + 4 * hk;
            float b0[4], b1[4];
#pragma unroll
            for (int j = 0; j < 4; ++j) { b0[j] = wre[(long)(kb + j) * 32 + i]; b1[j] = (i < 4) ? wrg[(long)(kb + j) * 4 + i] : 0.f; }
            acc0 = __builtin_amdgcn_mfma_f32_32x32x2f32(a4.x, b0[0], acc0, 0, 0, 0); acc1 = __builtin_amdgcn_mfma_f32_32x32x2f32(a4.x, b1[0], acc1, 0, 0, 0);
            acc0 = __builtin_amdgcn_mfma_f32_32x32x2f32(a4.y, b0[1], acc0, 0, 0, 0); acc1 = __builtin_amdgcn_mfma_f32_32x32x2f32(a4.y, b1[1], acc1, 0, 0, 0);
            acc0 = __builtin_amdgcn_mfma_f32_32x32x2f32(a4.z, b0[2], acc0, 0, 0, 0); acc1 = __builtin_amdgcn_mfma_f32_32x32x2f32(a4.z, b1[2], acc1, 0, 0, 0);
            acc0 = __builtin_amdgcn_mfma_f32_32x32x2f32(a4.w, b0[3], acc0, 0, 0, 0); acc1 = __builtin_amdgcn_mfma_f32_32x32x2f32(a4.w, b1[3], acc1, 0, 0, 0);
        }
        __syncthreads();
        float* tp = smem + (half * 4 + wq) * (32 * 65);
#pragma unroll
        for (int q = 0; q < 16; ++q) { const int row = (q & 3) + 8 * (q >> 2) + 4 * hk; tp[row * 65 + i] = acc0[q]; tp[row * 65 + 32 + i] = acc1[q]; }
        __syncthreads();
        if (tid < 64) {
            const int hh = tid >> 5, rr = tid & 31, r = bu * 64 + hh * 32 + rr;
            const float* t0 = smem + (hh * 4) * (32 * 65) + rr * 65;
            float lg[4], le[32];
#pragma unroll
            for (int e = 0; e < 32; ++e) le[e] = (t0[e] + t0[32 * 65 + e]) + (t0[2 * 32 * 65 + e] + t0[3 * 32 * 65 + e]);
#pragma unroll
            for (int g = 0; g < 4; ++g) lg[g] = (t0[32 + g] + t0[32 * 65 + 32 + g]) + (t0[2 * 32 * 65 + 32 + g] + t0[3 * 32 * 65 + 32 + g]);
            int grp = 0; float gm = lg[0];
#pragma unroll
            for (int g = 1; g < 4; ++g) if (lg[g] > gm) { gm = lg[g]; grp = g; }
            float zs = 0.f;
#pragma unroll
            for (int g = 0; g < 4; ++g) zs += expf(lg[g] - gm);
            const float pgrp = 1.0f / zs;
            float ev[8];
#pragma unroll
            for (int e = 0; e < 8; ++e) { ev[e] = (grp == 0) ? le[e] : (grp == 1) ? le[8 + e] : (grp == 2) ? le[16 + e] : le[24 + e]; }
            int i0 = 0; float v0 = ev[0];
#pragma unroll
            for (int e = 1; e < 8; ++e) if (ev[e] > v0) { v0 = ev[e]; i0 = e; }
            int i1 = -1; float v1 = -INFINITY;
#pragma unroll
            for (int e = 0; e < 8; ++e) if (e != i0 && ev[e] > v1) { v1 = ev[e]; i1 = e; }
            const float e1 = expf(v1 - v0);
            const float g0 = pgrp / (1.0f + e1), g1 = pgrp * e1 / (1.0f + e1);
            const int ex0 = grp * 8 + i0, ex1 = grp * 8 + i1;
            p.eid[r * 2 + 0] = ex0; p.eid[r * 2 + 1] = ex1;
            p.gate[r * 2 + 0] = g0; p.gate[r * 2 + 1] = g1;
            int mycnt = 0;
#pragma unroll
            for (int e = 0; e < 32; ++e) { const int c_ = __popcll(__ballot(ex0 == e || ex1 == e)); if ((tid & 31) == e) mycnt = c_; }
            if (tid < 32) p.cnt[bu * 32 + tid] = mycnt;
        }
    }
}

__device__ __forceinline__ void ph_assign(const Params& p, int l, int bid, int* smem) {
    const int tid = otid(), lane = tid & 63;
    const int ntok = (l < DEPTH - 1) ? R : NLAT;
    const int nch = ntok / 64;
    if (bid >= nch) return;
    int* cnt = smem;
    int* base = smem + 136 * 32;
    int* tot = base + 32;
    int* pst = tot + 32;
    __syncthreads();
    for (int i = tid; i < nch * 32; i += NTH) cnt[i] = p.cnt[i];
    __syncthreads();
    if (tid < 32) {
        int run = 0, bs = 0;
        for (int c = 0; c < nch; ++c) { if (c == bid) bs = run; run += cnt[c * 32 + tid]; }
        base[tid] = bs; tot[tid] = run;
    }
    __syncthreads();
    if (tid == 0) {
        int ps = 0;
        for (int e = 0; e < 32; ++e) { pst[e] = ps; ps += (tot[e] + 255) / 256 * 256; }
        if (bid == 0) {
            p.tile_e[NTILE] = ps / 256;
            int e = 0;
            for (int b = 0; b < NTILE; ++b) {
                const int s0 = b * 256;
                while (e < 32 && s0 >= pst[e] + (tot[e] + 255) / 256 * 256) ++e;
                p.tile_e[b] = (e < 32) ? e : -1;
            }
        }
    }
    __syncthreads();
    if (tid < 64) {
        const int t = bid * 64 + lane;
        const int e0 = p.eid[t * 2], e1 = p.eid[t * 2 + 1];
        for (int e = 0; e < 32; ++e) {
            const unsigned long long mk = __ballot(e0 == e || e1 == e);
            const int rank = __popcll(mk & ((1ull << lane) - 1ull));
            if (e0 == e || e1 == e) {
                const int slot = pst[e] + base[e] + rank;
                p.slot_tok[slot] = t;
                p.slot_of[t * 2 + (e1 == e ? 1 : 0)] = slot;
            }
        }
    }
    if (bid < 32) {
        const int e = bid, n0 = tot[e], n1 = (tot[e] + 255) / 256 * 256;
        for (int i = n0 + tid; i < n1; i += NTH) p.slot_tok[pst[e] + i] = -1;
    }
}

__device__ __forceinline__ void ph_gather(const Params& p, int bid, int nb) {
    const int tid = otid(), lane = tid & 63, wid = tid >> 6;
    const int nslots = p.tile_e[NTILE] * 256;
    for (int s0 = bid * NWV + wid; s0 < nslots; s0 += nb * NWV) {
        const int src = p.slot_tok[s0];
        u32x4* d = (u32x4*)(p.xs + (long)s0 * D);
        if (src >= 0) { const u32x4* sp = (const u32x4*)(p.hb + (long)src * D);
#pragma unroll
            for (int i = 0; i < 4; ++i) d[i * 64 + lane] = sp[i * 64 + lane]; }
        else { const u32x4 z = {0u, 0u, 0u, 0u};
#pragma unroll
            for (int i = 0; i < 4; ++i) d[i * 64 + lane] = z; }
    }
}

__device__ __forceinline__ void ph_post2(const Params& p, int l, int bid, int nb) {
    const int tid = otid(), lane = tid & 63, wid = tid >> 6;
    const int nrows = (l < DEPTH - 1) ? R : NLAT;
    for (int r = bid * NWV + wid; r < nrows; r += nb * NWV) {
        const float* mv = p.modv + ((long)l * 3 + mod_row(r)) * 6 * D;
        const int s0 = p.slot_of[r * 2], s1 = p.slot_of[r * 2 + 1];
        const float g0 = p.gate[r * 2], g1 = p.gate[r * 2 + 1];
        Row x, y0, y1; row_load(x, p.xc + (long)r * D, lane); row_load(y0, p.Ys + (long)s0 * D, lane); row_load(y1, p.Ys + (long)s1 * D, lane);
#pragma unroll
        for (int i = 0; i < 8; ++i) {
            const float4 g = ld4(mv + 5 * D + (i * 64 + lane) * 4);
            x.v[i].x = ALPHA * x.v[i].x + g.x * (g0 * y0.v[i].x + g1 * y1.v[i].x); x.v[i].y = ALPHA * x.v[i].y + g.y * (g0 * y0.v[i].y + g1 * y1.v[i].y);
            x.v[i].z = ALPHA * x.v[i].z + g.z * (g0 * y0.v[i].z + g1 * y1.v[i].z); x.v[i].w = ALPHA * x.v[i].w + g.w * (g0 * y0.v[i].w + g1 * y1.v[i].w);
        }
        float mean, rstd; row_stats(x, mean, rstd);
        row_affine(x, mean, rstd, p.ln2_g + l * D, p.ln2_b + l * D, lane);
        if (l == DEPTH - 1) row_store(x, p.out + (long)r * D, lane);
        else {
            row_store(x, p.xc + (long)r * D, lane);
            const float* mn = p.modv + ((long)(l + 1) * 3 + mod_row(r)) * 6 * D;
            row_stats(x, mean, rstd);
            row_modulate(x, mean, rstd, mn + 0 * D, mn + 1 * D, lane);
            row_store_bf16(x, p.hb + (long)r * D, lane);
        }
    }
}

constexpr int PH_PER_LAYER = 15, N_PHASES = 1 + DEPTH * PH_PER_LAYER;
constexpr int LDS_MAIN = 128 * 1024, LDS_BYTES = LDS_MAIN + 256;

__global__ void __launch_bounds__(NTH, 2) fwd(Params p) {
    extern __shared__ __attribute__((aligned(16))) unsigned char lds_raw[];
    float* smem = (float*)lds_raw;
    LAS unsigned char* ldsp = (LAS unsigned char*)lds_raw;
    const int bid = blockIdx.x, nb = gridDim.x;
    const int vcu = (nb % 8 == 0) ? (bid % 8) * (nb / 8) + bid / 8 : bid;
#if ONE_LAUNCH
    if (threadIdx.x == 0) *(uint4*)(lds_raw + LDS_MAIN) = make_uint4(0u, 0u, 0u, 0u);
    __syncthreads();
    XcdBarrier bar = xcd_barrier_post(p.bar, (volatile LAS unsigned*)(ldsp + LDS_MAIN));
#define SEAM(k) do { if ((k) + 1 < p.ph_hi) xcd_barrier(bar); } while (0)
#else
#define SEAM(k) do { } while (0)
#endif
#define IN(k) (p.ph_lo <= (k) && (k) < p.ph_hi)
    if (IN(0)) { ph_prologue(p, bid, nb, smem); if (DUPMASK & 1) { __syncthreads(); ph_prologue(p, bid, nb, smem); } SEAM(0); }
    for (int l = 0; l < DEPTH; ++l) {
        const int k0 = 1 + l * PH_PER_LAYER;
        const int mrows = (l < DEPTH - 1) ? R : NLAT;
        if (IN(k0 + 0) && l == 0) { ph_lnmod(p, l, bid, nb); if (DUPMASK & 16) ph_lnmod(p, l, bid, nb); SEAM(k0 + 0); }
        if (IN(k0 + 1)) {
            pg8::Gemm g{p.hb, p.WinT + (long)l * INP * D, R, INP, D}; pg8::StaticOrder S; S.init(R, INP, nb, bid);
            pg8::EpiF32 E{p.P, INC, INC};
            pg8::gemm_phase(ldsp, g, S, E); if (DUPMASK & 2) pg8::gemm_phase(ldsp, g, S, E);
            {
                int sb, snb;
                if (light_deal((R / 256) * (INP / 256), nb, bid, sb, snb)) { if (l == 0) conv_rest(p, sb, snb, smem); else conv_w1(p, l, sb, snb, smem); }
            }
            SEAM(k0 + 1);
        }
        if (IN(k0 + 2)) { ph_prep(p, l, bid, nb); if (DUPMASK & 16) ph_prep(p, l, bid, nb); SEAM(k0 + 2); }
        if (IN(k0 + 3)) {
            { pg8::Gemm g{p.cqn, p.WuqT + (long)l * 768 * 384, R, 768, 384}; pg8::StaticOrder S; S.init(R, 768, nb, bid); pg8::EpiBf16 E{p.Q2b, 768}; pg8::gemm_phase(ldsp, g, S, E); if (DUPMASK & 2) pg8::gemm_phase(ldsp, g, S, E); }
            { pg8::Gemm g{p.ckvn, p.WukvT + (long)l * 1024 * 256, R, 512, 256}; pg8::StaticOrder S; S.init(R, 512, nb, bid); pg8::EpiBf16 E{p.Kn, 512}; pg8::gemm_phase(ldsp, g, S, E); if (DUPMASK & 2) pg8::gemm_phase(ldsp, g, S, E); }
            { pg8::Gemm g{p.WukvT + (long)l * 1024 * 256 + 512 * 256, p.ckvn, 512, R, 256}; pg8::StaticOrder S; S.init(512, R, nb, bid); pg8::EpiBf16 E{p.VtM, R}; pg8::gemm_phase(ldsp, g, S, E); if (DUPMASK & 2) pg8::gemm_phase(ldsp, g, S, E); }
            SEAM(k0 + 3);
        }
        if (IN(k0 + 4)) { ph_mixers(p, l, bid, nb, smem, ldsp); if (DUPMASK & 4) { __syncthreads(); ph_mixers(p, l, bid, nb, smem, ldsp); } SEAM(k0 + 4); }
        if (IN(k0 + 5)) { ph_scan2(p, bid, nb); SEAM(k0 + 5); }
        if (IN(k0 + 6)) { ph_scan3(p, l, bid, nb, ldsp); if (DUPMASK & 8) { __syncthreads(); ph_scan3(p, l, bid, nb, ldsp); }
            { int sb, snb; __syncthreads(); if (light_deal(2 * 2 * 4 * NCHK, nb, bid, sb, snb)) conv_w2(p, l, sb, snb, smem); }
            SEAM(k0 + 6); }
        if (IN(k0 + 7)) {
            pg8::Gemm g{p.mix, p.WoutT + (long)l * D * D, mrows, D, D}; pg8::StaticOrder S; S.init(mrows, D, nb, bid);
            pg8::EpiF32 E{p.ob, D, D};
            pg8::gemm_phase(ldsp, g, S, E); if (DUPMASK & 2) pg8::gemm_phase(ldsp, g, S, E);
            if (l == 0) { int sb, snb; if (light_deal((mrows / 256) * (D / 256), nb, bid, sb, snb)) { conv_w1(p, 0, sb, snb, smem); conv_w3(p, 0, sb, snb, smem); } }
            SEAM(k0 + 7);
        }
        if (IN(k0 + 8)) { ph_post1(p, l, bid, nb); SEAM(k0 + 8); }
        if (IN(k0 + 9)) { ph_router(p, l, bid, nb, smem); if (DUPMASK & 256) { __syncthreads(); ph_router(p, l, bid, nb, smem); } SEAM(k0 + 9); }
        if (IN(k0 + 10)) { ph_assign(p, l, bid, (int*)smem); SEAM(k0 + 10); }
        if (IN(k0 + 11)) { ph_gather(p, bid, nb); if (DUPMASK & 16) ph_gather(p, bid, nb); SEAM(k0 + 11); }
        if (IN(k0 + 12)) {
            pg8::Gemm g{p.xs, p.W13T + (long)l * NEXP * 1024 * D, NSLOT, 1024, D};
            pg8::MoeOrder S{4, p.tile_e[NTILE] * 4, nb, vcu, (size_t)1024 * D * 2, p.tile_e};
            pg8::EpiSwiglu E{p.act, FF};
            pg8::gemm_phase(ldsp, g, S, E); if (DUPMASK & 2) pg8::gemm_phase(ldsp, g, S, E);
            if (l + 1 < DEPTH) { int sb, snb; if (light_deal(p.tile_e[NTILE] * 4, nb, bid, sb, snb)) conv_w3(p, l + 1, sb, snb, smem); }
            SEAM(k0 + 12);
        }
        if (IN(k0 + 13)) {
            pg8::Gemm g{p.act, p.W2T + (long)l * NEXP * D * FF, NSLOT, D, FF};
            pg8::MoeOrder S{8, p.tile_e[NTILE] * 8, nb, vcu, (size_t)D * FF * 2, p.tile_e};
            pg8::EpiF32 E{p.Ys, D, D};
            pg8::gemm_phase(ldsp, g, S, E); if (DUPMASK & 2) pg8::gemm_phase(ldsp, g, S, E); SEAM(k0 + 13);
        }
        if (IN(k0 + 14)) { ph_post2(p, l, bid, nb); SEAM(k0 + 14); }
    }
}

static inline size_t al256(size_t v) { return (v + 255) & ~(size_t)255; }

extern "C" void kernel_launch(void* const* d_in, const int* in_sizes, int n_in, void* d_out, int out_size, void* d_ws, size_t ws_size, hipStream_t stream) {
    static int grid = 0;
    if (grid == 0) {
        int dev = 0, cus = 0, per_cu = 0;
        hipGetDevice(&dev);
        hipDeviceGetAttribute(&cus, hipDeviceAttributeMultiprocessorCount, dev);
        hipFuncSetAttribute((const void*)fwd, hipFuncAttributeMaxDynamicSharedMemorySize, LDS_BYTES);
        hipOccupancyMaxActiveBlocksPerMultiprocessor(&per_cu, (const void*)fwd, NTH, LDS_BYTES);
        (void)hipGetLastError();
        if (cus <= 0) cus = 256;
        grid = cus;
        if (per_cu < 1) fprintf(stderr, "kernel_launch: occupancy query reports %d\n", per_cu);
    }
    Params p{};
    const float* const* in = (const float* const*)d_in;
    p.x = in[0]; p.c = in[1]; p.ctx = in[2]; p.c_ctx = in[3]; p.w_ada = in[4]; p.b_ada = in[5]; p.w_in = in[6]; p.swa_sink = in[7];
    p.ret_s = in[8]; p.ret_gn = in[9]; p.q_norm = in[10]; p.kv_norm = in[11]; p.w_uq = in[12]; p.w_ukv = in[13]; p.lb_logits = in[14];
    p.hgrn_gn = in[15]; p.w_out = in[16]; p.ln1_g = in[17]; p.ln1_b = in[18]; p.w_rg = in[19]; p.w_re = in[20]; p.w1 = in[21]; p.w3 = in[22];
    p.w2 = in[23]; p.ln2_g = in[24]; p.ln2_b = in[25];
    p.out = (float*)d_out;
    unsigned char* ws = (unsigned char*)d_ws; size_t off = 0;
    auto carve = [&](size_t bytes) { unsigned char* q = ws + off; off = al256(off + bytes); return q; };
    p.bar = (unsigned*)carve(XCD_BAR_WORDS * 4);
    p.modv = (float*)carve((size_t)DEPTH * 3 * 6 * D * 4);
    p.xc = (float*)carve((size_t)R * D * 4);
    p.hb = (bf16_t*)carve((size_t)R * D * 2);
    p.P = (float*)carve((size_t)R * INC * 4);
    p.Ys = p.P;
    p.cqn = (bf16_t*)carve((size_t)R * 384 * 2);
    p.ckvn = (bf16_t*)carve((size_t)R * 256 * 2);
    p.Q2b = (bf16_t*)carve((size_t)R * 768 * 2);
    p.Kn = (bf16_t*)carve((size_t)R * 512 * 2);
    p.VtM = (bf16_t*)carve((size_t)512 * R * 2);
    p.Krb = (bf16_t*)carve((size_t)R * 64 * 2);
    p.sqb = (bf16_t*)carve((size_t)R * 512 * 2);
    p.skb = (bf16_t*)carve((size_t)R * 256 * 2);
    p.svT = (bf16_t*)carve((size_t)256 * R * 2);
    p.sst = (float*)carve((size_t)32 * NCHK * 16384 * 4);
    p.sA = (float*)carve((size_t)32 * NCHK * 128 * 4);
    p.mix = (bf16_t*)carve((size_t)R * D * 2);
    p.ob = p.sst;
    p.xs = (bf16_t*)carve((size_t)NSLOT * D * 2);
    p.act = (bf16_t*)carve((size_t)NSLOT * FF * 2);
    p.gate = (float*)carve((size_t)R * 2 * 4);
    p.eid = (int*)carve((size_t)R * 2 * 4);
    p.slot_of = (int*)carve((size_t)R * 2 * 4);
    p.slot_tok = (int*)carve((size_t)NSLOT * 4);
    p.tile_e = (int*)carve((size_t)(NTILE + 1) * 4);
    p.cnt = (int*)carve((size_t)136 * 32 * 4);
    p.WinT = (bf16_t*)carve((size_t)DEPTH * INP * D * 2);
    p.WoutT = (bf16_t*)carve((size_t)DEPTH * D * D * 2);
    p.WuqT = (bf16_t*)carve((size_t)DEPTH * 768 * 384 * 2);
    p.WukvT = (bf16_t*)carve((size_t)DEPTH * 1024 * 256 * 2);
    p.W13T = (bf16_t*)carve((size_t)DEPTH * NEXP * 1024 * D * 2);
    p.W2T = (bf16_t*)carve((size_t)DEPTH * NEXP * D * FF * 2);
    if (off > ws_size) { fprintf(stderr, "kernel_launch: workspace too small: need %zu have %zu\n", off, ws_size); return; }
    hipMemsetAsync(p.bar, 0, XCD_BAR_WORDS * 4, stream);
#if ONE_LAUNCH
    p.ph_lo = 0; p.ph_hi = N_PHASES;
    hipLaunchKernelGGL(fwd, dim3(grid), dim3(NTH), LDS_BYTES, stream, p);
#else
    for (int k = 0; k < N_PHASES; ++k) {
        p.ph_lo = k; p.ph_hi = k + 1;
        hipLaunchKernelGGL(fwd, dim3(grid), dim3(NTH), LDS_BYTES, stream, p);
    }
#endif
}
```
